# Optimizing an MI355X kernel written in HIP

```python
import jax, jax.numpy as jnp
from jax import lax
import numpy as np

D_MODEL = 1024
BATCH = 4
SEQ = 4096
DEPTH = 4

HEAD_DIM = 64
MIX_WIDTH = D_MODEL
N_HEADS = MIX_WIDTH // HEAD_DIM
A_HEADS = (3 * N_HEADS) // 8
B_HEADS = N_HEADS // 4
C_HEADS = N_HEADS - A_HEADS - B_HEADS
A_WIDTH = A_HEADS * HEAD_DIM
B_WIDTH = B_HEADS * HEAD_DIM
C_WIDTH = C_HEADS * HEAD_DIM
DECAY_LORA = 64
ICLR_LORA = 64
A_PROJ = 3 * A_WIDTH + DECAY_LORA + ICLR_LORA
B_PROJ = 3 * B_WIDTH
C_PROJ = 3 * C_WIDTH
GATE_PROJ = MIX_WIDTH
PROJ_WIDTH = A_PROJ + B_PROJ + C_PROJ + GATE_PROJ
MOBA_BLOCK = 256
MOBA_TOPK = 3
MOBA_QBLOCK = 128
DILATED_PAIRS = ((128, 1), (512, 4), (2048, 16))
RMS_EPS = 1e-6
LNX_EPS = HEAD_DIM * 1e-5
ATTN_SCALE = HEAD_DIM ** -0.5

kernel_name = "hymba_rwkv7_moba_dilated_trunk"


def _rmsnorm(t, g):
    t32 = t.astype(jnp.float32)
    return t32 * lax.rsqrt(jnp.mean(t32 * t32, axis=-1, keepdims=True) + RMS_EPS) * g.astype(jnp.float32)


def _delta_scan(r, w, k, v, kk, a):
    bsz, _, nh, n = r.shape

    def step(state, inp):
        r_t, w_t, k_t, v_t, kk_t, a_t = inp
        sa = jnp.einsum('bhvk,bhk->bhv', state, -kk_t)
        state = (state * w_t[:, :, None, :]
                 + sa[..., None] * (kk_t * a_t)[:, :, None, :]
                 + v_t[..., None] * k_t[:, :, None, :])
        return state, jnp.einsum('bhvk,bhk->bhv', state, r_t)

    xs = tuple(jnp.moveaxis(t, 1, 0) for t in (r, w, k, v, kk, a))
    s0 = jnp.zeros((bsz, nh, n, n), jnp.float32)
    _, y = lax.scan(step, s0, xs)
    return jnp.moveaxis(y, 0, 1)


def _rwkv7(pa, mu, w0, w_up, a0, a_up, k_k, k_a, r_k, lnx_g, lnx_b):
    pa = pa.astype(jnp.float32)
    bsz, seq, _ = pa.shape
    prev = jnp.pad(pa, ((0, 0), (1, 0), (0, 0)))[:, :-1]
    pa = pa + (prev - pa) * mu.astype(jnp.float32)
    r, k, v, wd, ad = jnp.split(pa, [A_WIDTH, 2 * A_WIDTH, 3 * A_WIDTH, 3 * A_WIDTH + DECAY_LORA], axis=-1)
    w = -jax.nn.softplus(-(w0.astype(jnp.float32) + jnp.tanh(wd) @ w_up.astype(jnp.float32))) - 0.5
    decay = jnp.exp(-jnp.exp(w))
    a = jax.nn.sigmoid(a0.astype(jnp.float32) + ad @ a_up.astype(jnp.float32))
    heads = lambda t: t.reshape(bsz, seq, A_HEADS, HEAD_DIM)
    kk = heads(k * k_k.astype(jnp.float32))
    kk = kk * lax.rsqrt(jnp.sum(kk * kk, axis=-1, keepdims=True) + 1e-12)
    k = k * (1.0 + (a - 1.0) * k_a.astype(jnp.float32))
    r, k, v, decay, a = (heads(t) for t in (r, k, v, decay, a))
    y = _delta_scan(r, decay, k, v, kk, a)
    mean = jnp.mean(y, axis=-1, keepdims=True)
    var = jnp.mean(jnp.square(y - mean), axis=-1, keepdims=True)
    g_h = lnx_g.astype(jnp.float32).reshape(A_HEADS, HEAD_DIM)
    b_h = lnx_b.astype(jnp.float32).reshape(A_HEADS, HEAD_DIM)
    y = (y - mean) * lax.rsqrt(var + LNX_EPS) * g_h + b_h
    y = y + jnp.sum(r * k * r_k.astype(jnp.float32), axis=-1, keepdims=True) * v
    return y.reshape(bsz, seq, A_WIDTH)


def _split_heads_qk_norm(pq, n_heads, q_g, k_g):
    bsz, seq, _ = pq.shape
    q, k, v = jnp.split(pq.astype(jnp.float32), 3, axis=-1)
    q, k, v = (t.reshape(bsz, seq, n_heads, HEAD_DIM) for t in (q, k, v))
    return _rmsnorm(q, q_g), _rmsnorm(k, k_g), v


def _moba(q, k, v):
    bsz, seq, nh, dh = q.shape
    nb = -(-seq // MOBA_BLOCK)
    sp = nb * MOBA_BLOCK
    pad = ((0, 0), (0, sp - seq), (0, 0), (0, 0))
    q, k, v = (jnp.pad(t, pad) for t in (q, k, v))
    kb = k.reshape(bsz, nb, MOBA_BLOCK, nh, dh).transpose(0, 3, 1, 2, 4)
    vb = v.reshape(bsz, nb, MOBA_BLOCK, nh, dh).transpose(0, 3, 1, 2, 4)
    k_mean = jnp.mean(kb, axis=3)
    n_q = sp // MOBA_QBLOCK
    qc = q.reshape(bsz, n_q, MOBA_QBLOCK, nh, dh).transpose(1, 0, 3, 2, 4)
    top_k = min(MOBA_TOPK, nb - 1)
    bi = jnp.arange(bsz)[:, None, None, None]
    hi = jnp.arange(nh)[None, :, None, None]

    def one_chunk(args):
        ci, qblk = args
        q0 = ci * MOBA_QBLOCK
        b_own = q0 // MOBA_BLOCK
        qpos = q0 + jnp.arange(MOBA_QBLOCK)
        kpos = b_own * MOBA_BLOCK + jnp.arange(MOBA_BLOCK)
        k_own = lax.dynamic_index_in_dim(kb, b_own, axis=2, keepdims=False)
        v_own = lax.dynamic_index_in_dim(vb, b_own, axis=2, keepdims=False)
        s_own = jnp.einsum('bhqd,bhkd->bhqk', qblk, k_own) * ATTN_SCALE
        s_own = jnp.where(kpos[None, :] <= qpos[:, None], s_own, -jnp.inf)
        if top_k > 0:
            gate = jnp.einsum('bhqd,bhnd->bhqn', qblk, k_mean)
            gate = jnp.where(jnp.arange(nb) < b_own, gate, -jnp.inf)
            _, idx = lax.top_k(gate, top_k)
            k_sel = kb[bi, hi, idx]
            v_sel = vb[bi, hi, idx]
            s_sel = jnp.einsum('bhqd,bhqnkd->bhqnk', qblk, k_sel) * ATTN_SCALE
            s_sel = jnp.where((idx < b_own)[..., None], s_sel, -jnp.inf)
            s_all = jnp.concatenate(
                [s_own, s_sel.reshape(bsz, nh, MOBA_QBLOCK, top_k * MOBA_BLOCK)], axis=-1)
            p = jax.nn.softmax(s_all, axis=-1)
            p_own = p[..., :MOBA_BLOCK]
            p_sel = p[..., MOBA_BLOCK:].reshape(bsz, nh, MOBA_QBLOCK, top_k, MOBA_BLOCK)
            return (jnp.einsum('bhqk,bhkd->bhqd', p_own, v_own)
                    + jnp.einsum('bhqnk,bhqnkd->bhqd', p_sel, v_sel))
        p = jax.nn.softmax(s_own, axis=-1)
        return jnp.einsum('bhqk,bhkd->bhqd', p, v_own)

    o = lax.map(one_chunk, (jnp.arange(n_q), qc))
    return o.transpose(1, 0, 3, 2, 4).reshape(bsz, sp, nh, dh)[:, :seq]


def _band_attention(q, k, v, span):
    n, nh, length, dh = q.shape
    nblk = -(-length // span)
    lp = nblk * span
    pad = ((0, 0), (0, 0), (0, lp - length), (0, 0))
    qb, kb, vb = (jnp.pad(t, pad).reshape(n, nh, nblk, span, dh) for t in (q, k, v))
    prev = lambda t: jnp.pad(t, ((0, 0), (0, 0), (1, 0), (0, 0), (0, 0)))[:, :, :-1]
    kw = jnp.concatenate([prev(kb), kb], axis=3)
    vw = jnp.concatenate([prev(vb), vb], axis=3)
    s = jnp.einsum('nhcqd,nhckd->nhcqk', qb, kw) * ATTN_SCALE
    qi = jnp.arange(span)[:, None]
    kj = jnp.arange(2 * span)[None, :] - span
    band = (qi - kj >= 0) & (qi - kj <= span)
    first_ok = (jnp.arange(nblk)[:, None, None] > 0) | (kj[None] >= 0)
    s = jnp.where(band[None] & first_ok, s, -jnp.inf)
    m = jnp.max(s, axis=-1, keepdims=True)
    p = jnp.exp(s - m)
    den = jnp.sum(p, axis=-1)
    o = jnp.einsum('nhcqk,nhckd->nhcqd', p, vw) / den[..., None]
    lse = m[..., 0] + jnp.log(den)
    return (o.reshape(n, nh, lp, dh)[:, :, :length], lse.reshape(n, nh, lp)[:, :, :length])


def _dilated_mixture(q, k, v):
    bsz, seq, nh, dh = q.shape
    outs, lses = [], []
    for window, dil in DILATED_PAIRS:
        length = seq // dil
        to_sub = lambda t: t.reshape(bsz, length, dil, nh, dh).transpose(0, 2, 3, 1, 4).reshape(bsz * dil, nh, length, dh)
        o, lse = _band_attention(to_sub(q), to_sub(k), to_sub(v), window // dil)
        outs.append(o.reshape(bsz, dil, nh, length, dh).transpose(0, 3, 1, 2, 4).reshape(bsz, seq, nh, dh))
        lses.append(lse.reshape(bsz, dil, nh, length).transpose(0, 3, 1, 2).reshape(bsz, seq, nh))
    wts = jax.nn.softmax(jnp.stack(lses), axis=0)
    return jnp.einsum('gbsh,gbshd->bshd', wts, jnp.stack(outs))


def setup_inputs(seed: int = 0) -> dict:
    key = jax.random.key(seed)
    ks = jax.random.split(key, 20)
    f32 = jnp.float32
    nrm = lambda k, shape, s: jax.random.normal(k, shape, f32) * s
    return {
        "x": nrm(ks[0], (BATCH, SEQ, D_MODEL), 1.0),
        "norm_g": 1.0 + nrm(ks[1], (DEPTH, D_MODEL), 0.02),
        "w_in": nrm(ks[2], (DEPTH, D_MODEL, PROJ_WIDTH), D_MODEL ** -0.5),
        "w_out": nrm(ks[3], (DEPTH, MIX_WIDTH, D_MODEL), MIX_WIDTH ** -0.5),
        "tshift_mu": jax.random.uniform(ks[4], (DEPTH, A_PROJ), f32),
        "decay_w0": jax.random.uniform(ks[5], (DEPTH, A_WIDTH), f32, minval=-6.0, maxval=-1.0),
        "decay_up": nrm(ks[6], (DEPTH, DECAY_LORA, A_WIDTH), 0.5 * DECAY_LORA ** -0.5),
        "iclr_a0": nrm(ks[7], (DEPTH, A_WIDTH), 0.1),
        "iclr_up": nrm(ks[8], (DEPTH, ICLR_LORA, A_WIDTH), 0.5 * ICLR_LORA ** -0.5),
        "k_k": 0.85 + nrm(ks[9], (DEPTH, A_WIDTH), 0.05),
        "k_a": 1.0 + nrm(ks[10], (DEPTH, A_WIDTH), 0.05),
        "r_k": nrm(ks[11], (DEPTH, A_HEADS, HEAD_DIM), 0.1),
        "lnx_g": 1.0 + nrm(ks[12], (DEPTH, A_WIDTH), 0.02),
        "lnx_b": nrm(ks[13], (DEPTH, A_WIDTH), 0.02),
        "moba_q_g": 1.0 + nrm(ks[14], (DEPTH, HEAD_DIM), 0.02),
        "moba_k_g": 1.0 + nrm(ks[15], (DEPTH, HEAD_DIM), 0.02),
        "dil_q_g": 1.0 + nrm(ks[16], (DEPTH, HEAD_DIM), 0.02),
        "dil_k_g": 1.0 + nrm(ks[17], (DEPTH, HEAD_DIM), 0.02),
    }


def reference(x, norm_g, w_in, w_out, tshift_mu, decay_w0, decay_up, iclr_a0, iclr_up,
              k_k, k_a, r_k, lnx_g, lnx_b, moba_q_g, moba_k_g, dil_q_g, dil_k_g):
    bsz, seq, _ = x.shape
    cuts = [A_PROJ, A_PROJ + B_PROJ, A_PROJ + B_PROJ + C_PROJ]
    for l in range(DEPTH):
        h = _rmsnorm(x, norm_g[l]).astype(x.dtype)
        p = h @ w_in[l]
        pa, pb, pc, gate = jnp.split(p, cuts, axis=-1)
        y_a = _rwkv7(pa, tshift_mu[l], decay_w0[l], decay_up[l], iclr_a0[l], iclr_up[l],
                     k_k[l], k_a[l], r_k[l], lnx_g[l], lnx_b[l])
        qb, kb, vb = _split_heads_qk_norm(pb, B_HEADS, moba_q_g[l], moba_k_g[l])
        y_b = _moba(qb, kb, vb).reshape(bsz, seq, B_WIDTH)
        qc, kc, vc = _split_heads_qk_norm(pc, C_HEADS, dil_q_g[l], dil_k_g[l])
        y_c = _dilated_mixture(qc, kc, vc).reshape(bsz, seq, C_WIDTH)
        y = jnp.concatenate([y_a, y_b, y_c], axis=-1) * jax.nn.silu(gate.astype(jnp.float32))
        x = x + y.astype(x.dtype) @ w_out[l]
    return x
```

```cpp
#include <hip/hip_runtime.h>
#include <hip/hip_cooperative_groups.h>
#include <cstdio>
namespace cg = cooperative_groups;
__device__ __forceinline__ int tidx() { int t = threadIdx.x; asm volatile("" : "+v"(t)); return t; }
namespace pg8 {
#define PG8_LAS __attribute__((address_space(3)))
typedef unsigned short bf16_t;
typedef short bf16x8 __attribute__((ext_vector_type(8)));
typedef float f32x4 __attribute__((ext_vector_type(4)));
typedef unsigned u32x4 __attribute__((ext_vector_type(4)));
constexpr int BM = 256, BK = 64, HALF = 128, HTB = HALF * BK * 2  , STAGE_BYTES = 8 * HTB, NXCD = 8, WGM = 8;

__host__ __device__ __forceinline__ int lds_byte(int r, int c) { const int st = (r >> 4) * 2 + (c >> 5), rr = r & 15, cc = c & 31, ob = rr * 64 + cc * 2; return st * 1024 + (ob ^ (((ob >> 9) & 1) << 5)); }
__host__ __device__ __forceinline__ void stage_rc(int b, int& R, int& C) { const int st = b / 1024, sb = b % 1024, swz = sb ^ (((sb >> 9) & 1) << 5); R = (st >> 1) * 16 + swz / 64; C = (st & 1) * 32 + (swz % 64) / 2; }
__host__ __device__ __forceinline__ int perm32(int rho) { const int n = rho >> 4, i = rho & 15; return 8 * (i >> 2) + 4 * n + (i & 3); }

struct Unit { int pm, pn; };
struct Gemm { const bf16_t* A; const bf16_t* Bt; int M, N, K; };

struct StaticOrder {
    int nM, nN, nwg, G, c;
    __host__ __device__ void init(int M, int N, int G_, int c_) { nM = M / BM; nN = N / BM; nwg = nM * nN; G = G_; c = c_; }
    __host__ __device__ bool next(int i, Unit& u) const {
        const long L = (long)i * G + c; if (L >= nwg) return false;
        int wgid = (int)L; { const int q = nwg / NXCD, r = nwg % NXCD, xcd = wgid % NXCD, off = wgid / NXCD; wgid = (xcd < r ? xcd * (q + 1) : r * (q + 1) + (xcd - r) * q) + off; }
        const int nig = WGM * nN, gid = wgid / nig, fm = gid * WGM, gsz = (nM - fm) < WGM ? (nM - fm) : WGM;
        u.pm = fm + ((wgid % nig) % gsz); u.pn = (wgid % nig) / gsz; return true;
    }
    __device__ __forceinline__ void a_ready(const Unit&) const {}
    __device__ __forceinline__ void done(const Unit&) const {}
};
__device__ __forceinline__ unsigned cvt_pk_bf16(float lo, float hi) { unsigned r; asm volatile("v_cvt_pk_bf16_f32 %0, %1, %2" : "=v"(r) : "v"(lo), "v"(hi)); return r; }
typedef float f32x2 __attribute__((ext_vector_type(2)));
template <class Epi, class Sched, bool STAMP = false>
__device__ __forceinline__ void gemm_phase(PG8_LAS unsigned char* lds, const Gemm g, const Sched& S, const Epi& E, unsigned long long* stamps) {
    const int tid = tidx(), wid = __builtin_amdgcn_readfirstlane(tid >> 6), lane = tid & 63, wr = wid >> 2, wc = wid & 3, fr = lane & 15, fq = lane >> 4;
    const int K = g.K, nt = K / BK;
    int ts_lo = 0, ts_hi = 0, nts = 0; const unsigned long long rt_entry = STAMP ? (unsigned long long)wall_clock64() : 0ull;
#define PG8_STAMP() do { if (STAMP && wid == 0 && nts < 64) { const unsigned long long _c = (unsigned long long)clock64(); \
        ts_lo = (lane == nts) ? (int)(unsigned)_c : ts_lo; ts_hi = (lane == nts) ? (int)(unsigned)(_c >> 32) : ts_hi; ++nts; } } while (0)
    PG8_STAMP();
    unsigned voffA[2], voffB[2];
#pragma unroll
    for (int i = 0; i < 2; ++i) { int R, C; stage_rc(tid * 16 + i * 8192, R, C); const int Rb = Epi::PERM ? ((R & ~31) + perm32(R & 31)) : R;
        voffA[i] = (unsigned)(R * K + C) * 2u; voffB[i] = (unsigned)(Rb * K + C) * 2u; }
    const size_t kstep = (size_t)(BK * 2);
    const size_t hstep = (size_t)HALF * K * 2;
    const size_t tstep = 2 * hstep;
    const unsigned ldsw = (unsigned)wid * 1024u;
    const int aoff = lds_byte(wr * 64 + fr, fq * 8), boff = lds_byte(wc * 32 + fr, fq * 8);
#define PG8_SA(b, h) (((b) * 2 + (h)) * HTB)
#define PG8_SB(b, h) ((4 + (b) * 2 + (h)) * HTB)
#define PG8_STAGE(bufoff, gbase, voff) do { _Pragma("unroll") for (int _i = 0; _i < 2; ++_i) \
        __builtin_amdgcn_global_load_lds((const unsigned*)((const char*)(gbase) + (voff)[_i]), (PG8_LAS unsigned*)(lds + (bufoff) + ldsw + _i * 8192), 16, 0, 0); } while (0)
#define PG8_LDA(dst, b, h) do { _Pragma("unroll") for (int m = 0; m < 4; ++m) _Pragma("unroll") for (int k = 0; k < 2; ++k) dst[m][k] = *(const PG8_LAS bf16x8*)(lds + PG8_SA(b, h) + aoff + m * 2048 + k * 1024); } while (0)
#define PG8_LDB(dst, b, h) do { _Pragma("unroll") for (int n = 0; n < 2; ++n) _Pragma("unroll") for (int k = 0; k < 2; ++k) dst[n][k] = *(const PG8_LAS bf16x8*)(lds + PG8_SB(b, h) + boff + n * 2048 + k * 1024); } while (0)
#define PG8_MMA(ai, bj, At, Bt) do { __builtin_amdgcn_s_setprio(1); _Pragma("unroll") for (int m = 0; m < 4; ++m) _Pragma("unroll") for (int n = 0; n < 2; ++n) _Pragma("unroll") for (int k = 0; k < 2; ++k) \
        acc[ai][bj][m][n] = __builtin_amdgcn_mfma_f32_16x16x32_bf16(Bt[n][k], At[m][k], acc[ai][bj][m][n], 0, 0, 0); __builtin_amdgcn_s_setprio(0); } while (0)
#define PG8_WAIT_V(n) asm volatile("s_waitcnt vmcnt(" #n ")" ::: "memory")
#define PG8_WAIT_L(n) asm volatile("s_waitcnt lgkmcnt(" #n ")" ::: "memory")
#define PG8_BAR __builtin_amdgcn_s_barrier()
#define PG8_SCHED __builtin_amdgcn_sched_barrier(0)
    Unit cur, nxt; int ui = 0;
    if (!S.next(0, cur)) return;
    f32x4 acc[2][2][4][2];
#pragma unroll
    for (int a = 0; a < 2; ++a)
#pragma unroll
        for (int b = 0; b < 2; ++b)
#pragma unroll
            for (int m = 0; m < 4; ++m)
#pragma unroll
                for (int n = 0; n < 2; ++n) acc[a][b][m][n] = (f32x4){0.f, 0.f, 0.f, 0.f};
    bf16x8 At[4][2], B0[2][2], B1[2][2];
    const char* cA = (const char*)g.A + (size_t)cur.pm * tstep; const char* cB = (const char*)g.Bt + (size_t)cur.pn * tstep;
    S.a_ready(cur);
    PG8_STAGE(PG8_SB(0, 0), cB, voffB); PG8_STAGE(PG8_SA(0, 0), cA, voffA); PG8_STAGE(PG8_SB(0, 1), cB + hstep, voffB); PG8_STAGE(PG8_SA(0, 1), cA + hstep, voffA);
    if (wr == 1) PG8_BAR;
    PG8_WAIT_V(4); PG8_BAR;
    PG8_STAGE(PG8_SB(1, 0), cB + kstep, voffB); PG8_STAGE(PG8_SA(1, 0), cA + kstep, voffA); PG8_STAGE(PG8_SB(1, 1), cB + hstep + kstep, voffB);
    PG8_WAIT_V(6); PG8_BAR;
    PG8_STAMP();
    for (;;) {
        const bool has_next = S.next(ui + 1, nxt);
        const char* nA = has_next ? (const char*)g.A + (size_t)nxt.pm * tstep : cA; const char* nB = has_next ? (const char*)g.Bt + (size_t)nxt.pn * tstep : cB;
        for (int t = 0; t < nt; t += 2) {
            const bool last = (t == nt - 2);
            const char* a1 = cA + (size_t)(t + 1) * kstep;
            const char* a2 = last ? nA : cA + (size_t)(t + 2) * kstep; const char* b2 = last ? nB : cB + (size_t)(t + 2) * kstep;
            const char* a3 = a2 + kstep; const char* b3 = b2 + kstep;
            if (last && has_next) S.a_ready(nxt);
            PG8_LDB(B0, 0, 0); PG8_SCHED; PG8_LDA(At, 0, 0); PG8_STAGE(PG8_SA(1, 1), a1 + hstep, voffA);
            PG8_WAIT_L(8); PG8_BAR; PG8_WAIT_L(0); PG8_MMA(0, 0, At, B0); PG8_BAR; PG8_SCHED;
            PG8_LDB(B1, 0, 1); PG8_STAGE(PG8_SB(0, 0), b2, voffB);
            PG8_BAR; PG8_WAIT_L(0); PG8_MMA(0, 1, At, B1); PG8_BAR;
            PG8_LDA(At, 0, 1); PG8_STAGE(PG8_SA(0, 0), a2, voffA);
            PG8_BAR; PG8_WAIT_L(0); PG8_MMA(1, 0, At, B0); PG8_BAR; PG8_SCHED;
            PG8_STAGE(PG8_SB(0, 1), b2 + hstep, voffB);
            PG8_WAIT_V(6); PG8_BAR; PG8_MMA(1, 1, At, B1); PG8_BAR;
            PG8_LDB(B0, 1, 0); PG8_SCHED; PG8_LDA(At, 1, 0); PG8_STAGE(PG8_SA(0, 1), a2 + hstep, voffA);
            PG8_WAIT_L(8); PG8_BAR; PG8_WAIT_L(0); PG8_MMA(0, 0, At, B0); PG8_BAR; PG8_SCHED;
            PG8_LDB(B1, 1, 1); PG8_STAGE(PG8_SB(1, 0), b3, voffB);
            PG8_BAR; PG8_WAIT_L(0); PG8_MMA(0, 1, At, B1); PG8_BAR;
            PG8_LDA(At, 1, 1); PG8_STAGE(PG8_SA(1, 0), a3, voffA);
            PG8_BAR; PG8_WAIT_L(0); PG8_MMA(1, 0, At, B0); PG8_BAR; PG8_SCHED;
            PG8_STAGE(PG8_SB(1, 1), b3 + hstep, voffB);
            PG8_WAIT_V(6); PG8_BAR; PG8_MMA(1, 1, At, B1); PG8_BAR;
        }
        PG8_STAMP();
        if constexpr (!Epi::AFTER_DRAIN) { E(acc, cur, wr, wc, fr, fq); S.done(cur); }
        PG8_STAMP();
        if (!has_next) break;
#pragma unroll
        for (int a = 0; a < 2; ++a)
#pragma unroll
            for (int b = 0; b < 2; ++b)
#pragma unroll
                for (int m = 0; m < 4; ++m)
#pragma unroll
                    for (int n = 0; n < 2; ++n) acc[a][b][m][n] = (f32x4){0.f, 0.f, 0.f, 0.f};
        cur = nxt; cA = nA; cB = nB; ++ui;
    }
    PG8_WAIT_V(0);
    if (wr == 0) PG8_BAR;
    PG8_BAR;
    if constexpr (Epi::AFTER_DRAIN) { E.fused(acc, cur, wr, wc, fr, fq, lds, wid, lane); S.done(cur); }
    PG8_STAMP();
    if (STAMP && wid == 0) { stamps[lane] = lane < nts ? (((unsigned long long)(unsigned)ts_hi << 32) | (unsigned)ts_lo) : 0ull;
        if (lane == 62) stamps[62] = rt_entry; if (lane == 63) stamps[63] = (unsigned long long)wall_clock64(); }
#undef PG8_STAMP
#undef PG8_SA
#undef PG8_SB
#undef PG8_STAGE
#undef PG8_LDA
#undef PG8_LDB
#undef PG8_MMA
#undef PG8_WAIT_V
#undef PG8_WAIT_L
#undef PG8_BAR
#undef PG8_SCHED
}
}

#define LAS __attribute__((address_space(3)))
typedef unsigned short bf16_t;
typedef short bf16x8 __attribute__((ext_vector_type(8)));
typedef float f32x4 __attribute__((ext_vector_type(4)));
typedef unsigned u32x4 __attribute__((ext_vector_type(4)));
typedef unsigned u32x2 __attribute__((ext_vector_type(2)));

constexpr int T_TOK = 16384, SEQ = 4096, DM = 1024;
constexpr int PWP = 4352, PA_W = 1280, PBC_W = 1920;
constexpr int NTHR = 512;
constexpr int LDS_BYTES = 131072;
constexpr size_t WS_WIN = 0;
constexpr size_t WS_WOUT = WS_WIN + (size_t)PWP * 1024 * 2;
constexpr size_t WS_XB = WS_WOUT + (size_t)1024 * 1024 * 2;
constexpr size_t WS_SSQ = WS_XB + (size_t)T_TOK * 1024 * 2;
constexpr size_t WS_PA = WS_SSQ + (size_t)T_TOK * 16 * 4;
constexpr size_t WS_PBC = WS_PA + (size_t)T_TOK * PA_W * 2;
constexpr size_t WS_GATE = WS_PBC + (size_t)T_TOK * PBC_W * 2;
constexpr size_t WS_RW = WS_GATE + (size_t)T_TOK * 1024 * 2;
constexpr size_t WS_KMEAN = WS_RW + (size_t)T_TOK * 6 * 768;
constexpr size_t WS_END = WS_KMEAN + (size_t)4 * 4 * 16 * 64 * 4;
constexpr size_t WS_YG = WS_PA;
constexpr size_t WS_DILO = WS_XB;
constexpr size_t WS_DILL = WS_XB + (size_t)2 * T_TOK * 384 * 2;

struct Params {
    const float* in[18];
    float* out;
    unsigned char* ws;
    int ph_lo, ph_hi;
};
enum { I_X = 0, I_NORMG, I_WIN, I_WOUT, I_MU, I_W0, I_WUP, I_A0, I_AUP, I_KK, I_KA, I_RK, I_LNG, I_LNB, I_MQG, I_MKG, I_DQG, I_DKG };

__device__ __forceinline__ float bf2f(bf16_t b) { return __uint_as_float(((unsigned)b) << 16); }
__device__ __forceinline__ bf16_t f2bf(float f) { unsigned u = __float_as_uint(f); u += 0x7FFFu + ((u >> 16) & 1u); return (bf16_t)(u >> 16); }
__device__ __forceinline__ unsigned pk2(float lo, float hi) { return (unsigned)f2bf(lo) | ((unsigned)f2bf(hi) << 16); }
__device__ __forceinline__ float bflo(unsigned w) { return __uint_as_float(w << 16); }
__device__ __forceinline__ float bfhi(unsigned w) { return __uint_as_float(w & 0xFFFF0000u); }
__device__ __forceinline__ float wsum64(float v) {
    v += __shfl_xor(v, 1); v += __shfl_xor(v, 2); v += __shfl_xor(v, 4); v += __shfl_xor(v, 8); v += __shfl_xor(v, 16); v += __shfl_xor(v, 32); return v;
}
__device__ __forceinline__ float sum8(float v) { v += __shfl_xor(v, 1); v += __shfl_xor(v, 2); v += __shfl_xor(v, 4); return v; }
template <int CTRL> __device__ __forceinline__ float dppf(float x) { return __int_as_float(__builtin_amdgcn_update_dpp(0, __float_as_int(x), CTRL, 0xF, 0xF, true)); }
__device__ __forceinline__ float dsum8(float v) { v += dppf<0xB1>(v); v += dppf<0x4E>(v); v += dppf<0x141>(v); return v; }

struct EpiIn {
    static constexpr bool PERM = true, AFTER_DRAIN = false;
    bf16_t* pa; bf16_t* pbc; bf16_t* gate; const float* ssq;
    __device__ __forceinline__ void operator()(const f32x4 (&acc)[2][2][4][2], const pg8::Unit& u, int wr, int wc, int fr_, int fq_) const {
        int fr = fr_, fq = fq_; asm volatile("" : "+v"(fr), "+v"(fq));
        const int row0 = u.pm * 256 + wr * 64 + fr;
#pragma unroll
        for (int ai = 0; ai < 2; ++ai)
#pragma unroll
            for (int m = 0; m < 4; ++m) {
                const int row = row0 + ai * 128 + m * 16;
                const f32x4 s4 = *(const f32x4*)(ssq + (size_t)row * 16 + fq * 4);
                float s = (s4[0] + s4[1]) + (s4[2] + s4[3]);
                s += __shfl_xor(s, 16); s += __shfl_xor(s, 32);
                const float rs = rsqrtf(s * (1.0f / 1024.0f) + 1e-6f);
#pragma unroll
                for (int bj = 0; bj < 2; ++bj) {
                    const int c128 = u.pn * 2 + bj;
                    const int col = c128 * 128 + wc * 32 + 8 * fq;
                    f32x4 v0 = acc[ai][bj][m][0] * rs, v1 = acc[ai][bj][m][1] * rs;
                    bf16_t* dst;
                    if (c128 < 10) dst = pa + (size_t)row * PA_W + col;
                    else if (c128 < 25) dst = pbc + (size_t)row * PBC_W + (col - 1280);
                    else if (c128 < 33) {
                        dst = gate + (size_t)row * 1024 + (col - 3200);
#pragma unroll
                        for (int j = 0; j < 4; ++j) { v0[j] = v0[j] / (1.0f + __expf(-v0[j])); v1[j] = v1[j] / (1.0f + __expf(-v1[j])); }
                    } else continue;
                    u32x4 w; w.x = pk2(v0[0], v0[1]); w.y = pk2(v0[2], v0[3]); w.z = pk2(v1[0], v1[1]); w.w = pk2(v1[2], v1[3]);
                    *(u32x4*)dst = w;
                }
            }
    }
};
struct EpiOut {
    static constexpr bool PERM = true, AFTER_DRAIN = false;
    const float* res; float* out; bf16_t* xb; float* ssq;
    __device__ __forceinline__ void operator()(const f32x4 (&acc)[2][2][4][2], const pg8::Unit& u, int wr, int wc, int fr_, int fq_) const {
        int fr = fr_, fq = fq_; asm volatile("" : "+v"(fr), "+v"(fq));
        const int row0 = u.pm * 256 + wr * 64 + fr;
#pragma unroll
        for (int ai = 0; ai < 2; ++ai)
#pragma unroll
            for (int m = 0; m < 4; ++m) {
                const int row = row0 + ai * 128 + m * 16;
                float sq = 0.f;
#pragma unroll
                for (int bj = 0; bj < 2; ++bj) {
                    const int col = u.pn * 256 + bj * 128 + wc * 32 + 8 * fq;
                    const size_t off = (size_t)row * 1024 + col;
                    const f32x4 r0 = *(const f32x4*)(res + off), r1 = *(const f32x4*)(res + off + 4);
                    const f32x4 v0 = acc[ai][bj][m][0] + r0, v1 = acc[ai][bj][m][1] + r1;
                    *(f32x4*)(out + off) = v0; *(f32x4*)(out + off + 4) = v1;
                    u32x4 w; w.x = pk2(v0[0], v0[1]); w.y = pk2(v0[2], v0[3]); w.z = pk2(v1[0], v1[1]); w.w = pk2(v1[2], v1[3]);
                    *(u32x4*)(xb + off) = w;
                    sq += (v0[0] * v0[0] + v0[1] * v0[1]) + (v0[2] * v0[2] + v0[3] * v0[3]) + (v1[0] * v1[0] + v1[1] * v1[1]) + (v1[2] * v1[2] + v1[3] * v1[3]);
                }
                sq += __shfl_xor(sq, 16); sq += __shfl_xor(sq, 32);
                if (fq == 0) ssq[(size_t)row * 16 + u.pn * 4 + wc] = sq;
            }
    }
};

__device__ __forceinline__ void convert_tile(const float* __restrict__ W, int N, int Nvalid, const float* __restrict__ g, bf16_t* __restrict__ Wt, int tk, int tn, LAS unsigned char* lds) {
    LAS float* tl = (LAS float*)lds;
    const int tid = tidx(), r = tid >> 3, c8 = (tid & 7) * 8, n0 = tn * 64, k0 = tk * 64;
    __syncthreads();
    if (n0 < Nvalid) {
        const float* src = W + (size_t)(k0 + r) * N + n0 + c8;
        const f32x4 a = *(const f32x4*)src, b = *(const f32x4*)(src + 4);
        const float gs = g ? g[k0 + r] : 1.0f;
#pragma unroll
        for (int j = 0; j < 4; ++j) { tl[r * 65 + c8 + j] = a[j] * gs; tl[r * 65 + c8 + 4 + j] = b[j] * gs; }
    }
    __syncthreads();
    u32x4 w = {0u, 0u, 0u, 0u};
    if (n0 < Nvalid) {
        float v[8];
#pragma unroll
        for (int j = 0; j < 8; ++j) v[j] = tl[(c8 + j) * 65 + r];
        w.x = pk2(v[0], v[1]); w.y = pk2(v[2], v[3]); w.z = pk2(v[4], v[5]); w.w = pk2(v[6], v[7]);
    }
    *(u32x4*)(Wt + (size_t)(n0 + r) * 1024 + k0 + c8) = w;
}

__device__ __forceinline__ void phase_prologue(const Params& p, LAS unsigned char* lds) {
    const int tid = tidx(), wave = tid >> 6, lane = tid & 63;
    const float* x = p.in[I_X];
    bf16_t* xb = (bf16_t*)(p.ws + WS_XB); float* ssq = (float*)(p.ws + WS_SSQ);
    for (int row = blockIdx.x * 8 + wave; row < T_TOK; row += gridDim.x * 8) {
        const float* xr = x + (size_t)row * 1024;
        float s = 0.f;
#pragma unroll
        for (int i = 0; i < 4; ++i) {
            const f32x4 v = *(const f32x4*)(xr + i * 256 + lane * 4);
            s += (v[0] * v[0] + v[1] * v[1]) + (v[2] * v[2] + v[3] * v[3]);
            u32x2 w; w.x = pk2(v[0], v[1]); w.y = pk2(v[2], v[3]);
            *(u32x2*)(xb + (size_t)row * 1024 + i * 256 + lane * 4) = w;
        }
        s = wsum64(s);
        if (lane < 16) ssq[(size_t)row * 16 + lane] = (lane == 0) ? s : 0.f;
    }
    bf16_t* wint = (bf16_t*)(p.ws + WS_WIN);
    for (int t = blockIdx.x; t < 16 * 68; t += gridDim.x) convert_tile(p.in[I_WIN], 4224, 4224, p.in[I_NORMG], wint, t & 15, t >> 4, lds);
}

constexpr int KS_PITCH = 144;
constexpr int VT_PITCH = 144;
constexpr int AT_KS = 0, AT_VT = 64 * KS_PITCH, AT_KM = AT_VT + 64 * VT_PITCH, AT_SEL = AT_KM + 4096, AT_ANY = AT_SEL + 512;
struct AttnOut { f32x4 o[4]; float m, l; };

template <class TK>
__device__ __forceinline__ void attn_core(const TK& tk, const bf16_t* __restrict__ qbase, const bf16_t* __restrict__ kbase, const bf16_t* __restrict__ vbase,
                                          const float* __restrict__ qg, const float* __restrict__ kg, LAS unsigned char* lds, AttnOut& R) {
    const int tid = tidx(), wave = tid >> 6, lane = tid & 63, qi = lane & 15, g = lane >> 4;
    const int mq = wave * 16 + qi;
    bf16x8 bq[2];
    {
        const bf16_t* qp = qbase + (size_t)tk.q_tok(mq) * PBC_W;
        const u32x4 r0 = *(const u32x4*)(qp + g * 8), r1 = *(const u32x4*)(qp + 32 + g * 8);
        float qf[16];
#pragma unroll
        for (int j = 0; j < 4; ++j) { qf[2 * j] = bflo(r0[j]); qf[2 * j + 1] = bfhi(r0[j]); qf[8 + 2 * j] = bflo(r1[j]); qf[8 + 2 * j + 1] = bfhi(r1[j]); }
        float ss = 0.f;
#pragma unroll
        for (int j = 0; j < 16; ++j) ss += qf[j] * qf[j];
        ss += __shfl_xor(ss, 16); ss += __shfl_xor(ss, 32);
        const float qs = rsqrtf(ss * (1.0f / 64.0f) + 1e-6f) * (0.125f * 1.4426950408889634f);
#pragma unroll
        for (int j = 0; j < 8; ++j) { bq[0][j] = (short)f2bf(qf[j] * qs * qg[g * 8 + j]); bq[1][j] = (short)f2bf(qf[8 + j] * qs * qg[32 + g * 8 + j]); }
    }
    const int kr = tid >> 3, pc = tid & 7;
    const int vr = tid & 63, vpc = tid >> 6;
    float kgv[8];
#pragma unroll
    for (int j = 0; j < 8; ++j) kgv[j] = kg[pc * 8 + j];
#pragma unroll
    for (int mo = 0; mo < 4; ++mo) R.o[mo] = (f32x4){0.f, 0.f, 0.f, 0.f};
    float m_run = -INFINITY, l_run = 0.f;
    const int nt = tk.ntiles();
    int j = 0;
    while (j < nt && !tk.tile_on(j)) ++j;
    u32x4 kreg = {0u, 0u, 0u, 0u}, vreg = {0u, 0u, 0u, 0u};
    if (j < nt) {
        kreg = *(const u32x4*)(kbase + (size_t)tk.k_tok(j, kr) * PBC_W + pc * 8);
        vreg = *(const u32x4*)(vbase + (size_t)tk.k_tok(j, vr) * PBC_W + vpc * 8);
    }
    while (j < nt) {
        __syncthreads();
        {
            float kf[8];
#pragma unroll
            for (int q = 0; q < 4; ++q) { kf[2 * q] = bflo(kreg[q]); kf[2 * q + 1] = bfhi(kreg[q]); }
            float ss = 0.f;
#pragma unroll
            for (int q = 0; q < 8; ++q) ss += kf[q] * kf[q];
            ss = sum8(ss);
            const float ks = rsqrtf(ss * (1.0f / 64.0f) + 1e-6f);
            u32x4 w; w.x = pk2(kf[0] * ks * kgv[0], kf[1] * ks * kgv[1]); w.y = pk2(kf[2] * ks * kgv[2], kf[3] * ks * kgv[3]);
            w.z = pk2(kf[4] * ks * kgv[4], kf[5] * ks * kgv[5]); w.w = pk2(kf[6] * ks * kgv[6], kf[7] * ks * kgv[7]);
            *(LAS u32x4*)(lds + AT_KS + kr * KS_PITCH + pc * 16) = w;
#pragma unroll
            for (int q = 0; q < 4; ++q) {
                *(LAS bf16_t*)(lds + AT_VT + (vpc * 8 + 2 * q) * VT_PITCH + vr * 2) = (bf16_t)(vreg[q] & 0xFFFFu);
                *(LAS bf16_t*)(lds + AT_VT + (vpc * 8 + 2 * q + 1) * VT_PITCH + vr * 2) = (bf16_t)(vreg[q] >> 16);
            }
        }
        int jn = j + 1;
        while (jn < nt && !tk.tile_on(jn)) ++jn;
        if (jn < nt) {
            kreg = *(const u32x4*)(kbase + (size_t)tk.k_tok(jn, kr) * PBC_W + pc * 8);
            vreg = *(const u32x4*)(vbase + (size_t)tk.k_tok(jn, vr) * PBC_W + vpc * 8);
        }
        __syncthreads();
        f32x4 st[4];
#pragma unroll
        for (int mt = 0; mt < 4; ++mt) {
            st[mt] = (f32x4){0.f, 0.f, 0.f, 0.f};
#pragma unroll
            for (int ks = 0; ks < 2; ++ks) {
                const bf16x8 a = *(const LAS bf16x8*)(lds + AT_KS + (mt * 16 + qi) * KS_PITCH + ks * 64 + g * 16);
                st[mt] = __builtin_amdgcn_mfma_f32_16x16x32_bf16(a, bq[ks], st[mt], 0, 0, 0);
            }
        }
        float mx = -INFINITY;
#pragma unroll
        for (int mt = 0; mt < 4; ++mt)
#pragma unroll
            for (int i = 0; i < 4; ++i) {
                const float s = tk.mask(mq, j, mt * 16 + g * 4 + i) ? st[mt][i] : -INFINITY;
                st[mt][i] = s; mx = fmaxf(mx, s);
            }
        mx = fmaxf(mx, __shfl_xor(mx, 16)); mx = fmaxf(mx, __shfl_xor(mx, 32));
        const float m_new = fmaxf(m_run, mx);
        const float m_safe = (m_new == -INFINITY) ? 0.f : m_new;
        const float alpha = __builtin_amdgcn_exp2f(m_run - m_safe);
        m_run = m_new;
        float ps = 0.f;
#pragma unroll
        for (int mt = 0; mt < 4; ++mt)
#pragma unroll
            for (int i = 0; i < 4; ++i) { const float pv = __builtin_amdgcn_exp2f(st[mt][i] - m_safe); st[mt][i] = pv; ps += pv; }
        l_run = l_run * alpha + ps;
#pragma unroll
        for (int mo = 0; mo < 4; ++mo) R.o[mo] *= alpha;
#pragma unroll
        for (int ks = 0; ks < 2; ++ks) {
            bf16x8 pb;
#pragma unroll
            for (int i = 0; i < 4; ++i) { pb[i] = (short)f2bf(st[2 * ks][i]); pb[4 + i] = (short)f2bf(st[2 * ks + 1][i]); }
#pragma unroll
            for (int mo = 0; mo < 4; ++mo) {
                const LAS unsigned char* vp = lds + AT_VT + (mo * 16 + qi) * VT_PITCH + ks * 64 + g * 8;
                const u32x2 lo = *(const LAS u32x2*)vp, hi = *(const LAS u32x2*)(vp + 32);
                u32x4 av; av.x = lo.x; av.y = lo.y; av.z = hi.x; av.w = hi.y;
                R.o[mo] = __builtin_amdgcn_mfma_f32_16x16x32_bf16(__builtin_bit_cast(bf16x8, av), pb, R.o[mo], 0, 0, 0);
            }
        }
        j = jn;
    }
    l_run += __shfl_xor(l_run, 16); l_run += __shfl_xor(l_run, 32);
    R.m = m_run; R.l = l_run;
}

struct DilTask {
    int tokbase, d, rho, c;
    __device__ __forceinline__ int q_tok(int m) const { return tokbase + (c * 128 + m) * d + rho; }
    __device__ __forceinline__ int ntiles() const { return 4; }
    __device__ __forceinline__ bool tile_on(int j) const { return !(c == 0 && j < 2); }
    __device__ __forceinline__ int k_tok(int j, int n) const { return tokbase + ((c - 1) * 128 + j * 64 + n) * d + rho; }
    __device__ __forceinline__ bool mask(int m, int j, int n) const { const int diff = 128 + m - j * 64 - n; return diff >= 0 && diff <= 128; }
};
__device__ __forceinline__ void dil_task(const Params& p, int l, int gi, int r, LAS unsigned char* lds) {
    const int d = (gi == 0) ? 1 : (gi == 1 ? 4 : 16), nblk = 32 / d;
    const int b = r / 192, r2 = r % 192, hC = r2 / 32, r3 = r2 % 32;
    DilTask tk; tk.tokbase = b * SEQ; tk.d = d; tk.rho = r3 / nblk; tk.c = r3 % nblk;
    const bf16_t* pbc = (const bf16_t*)(p.ws + WS_PBC);
    AttnOut R;
    attn_core(tk, pbc + 768 + hC * 64, pbc + 1152 + hC * 64, pbc + 1536 + hC * 64, p.in[I_DQG] + l * 64, p.in[I_DKG] + l * 64, lds, R);
    const int tid = tidx(), wave = tid >> 6, lane = tid & 63, qi = lane & 15, g = lane >> 4;
    const int tok = tk.q_tok(wave * 16 + qi);
    const float inv = 1.0f / R.l;
    const float L = R.m + __builtin_amdgcn_logf(R.l);
    bf16_t* dilo = (bf16_t*)(p.ws + WS_DILO); float* dill = (float*)(p.ws + WS_DILL);
    if (gi < 2) {
#pragma unroll
        for (int mo = 0; mo < 4; ++mo) {
            u32x2 w; w.x = pk2(R.o[mo][0] * inv, R.o[mo][1] * inv); w.y = pk2(R.o[mo][2] * inv, R.o[mo][3] * inv);
            *(u32x2*)(dilo + ((size_t)gi * T_TOK + tok) * 384 + hC * 64 + mo * 16 + g * 4) = w;
        }
        if (g == 0) dill[((size_t)gi * T_TOK + tok) * 6 + hC] = L;
    } else {
        const float L0 = dill[(size_t)tok * 6 + hC], L1 = dill[((size_t)T_TOK + tok) * 6 + hC];
        const float M = fmaxf(L, fmaxf(L0, L1));
        const float w0 = __builtin_amdgcn_exp2f(L0 - M), w1 = __builtin_amdgcn_exp2f(L1 - M), w2 = __builtin_amdgcn_exp2f(L - M);
        const float wi = 1.0f / (w0 + w1 + w2);
        const float a0 = w0 * wi, a1 = w1 * wi, a2 = w2 * wi * inv;
        const bf16_t* sg = (const bf16_t*)(p.ws + WS_GATE) + (size_t)tok * 1024 + 640 + hC * 64;
        bf16_t* yg = (bf16_t*)(p.ws + WS_YG) + (size_t)tok * 1024 + 640 + hC * 64;
#pragma unroll
        for (int mo = 0; mo < 4; ++mo) {
            const int dh = mo * 16 + g * 4;
            const u32x2 o0 = *(const u32x2*)(dilo + (size_t)tok * 384 + hC * 64 + dh), o1 = *(const u32x2*)(dilo + ((size_t)T_TOK + tok) * 384 + hC * 64 + dh);
            const u32x2 gt = *(const u32x2*)(sg + dh);
            float y0 = a0 * bflo(o0.x) + a1 * bflo(o1.x) + a2 * R.o[mo][0];
            float y1 = a0 * bfhi(o0.x) + a1 * bfhi(o1.x) + a2 * R.o[mo][1];
            float y2 = a0 * bflo(o0.y) + a1 * bflo(o1.y) + a2 * R.o[mo][2];
            float y3 = a0 * bfhi(o0.y) + a1 * bfhi(o1.y) + a2 * R.o[mo][3];
            u32x2 w; w.x = pk2(y0 * bflo(gt.x), y1 * bfhi(gt.x)); w.y = pk2(y2 * bflo(gt.y), y3 * bfhi(gt.y));
            *(u32x2*)(yg + dh) = w;
        }
    }
}

struct MobaTask {
    int tokbase, q0, b_own, nown; unsigned anysel, mysel;
    __device__ __forceinline__ int q_tok(int m) const { return tokbase + q0 + m; }
    __device__ __forceinline__ int ntiles() const { return 4 * (b_own + 1); }
    __device__ __forceinline__ bool tile_on(int j) const { return (j < 4) ? (j < nown) : (((anysel >> ((j >> 2) - 1)) & 1u) != 0u); }
    __device__ __forceinline__ int k_tok(int j, int n) const { const int blk = (j < 4) ? b_own : ((j >> 2) - 1); return tokbase + blk * 256 + (j & 3) * 64 + n; }
    __device__ __forceinline__ bool mask(int m, int j, int n) const {
        return (j < 4) ? (b_own * 256 + j * 64 + n <= q0 + m) : (((mysel >> ((j >> 2) - 1)) & 1u) != 0u);
    }
};
__device__ __forceinline__ void moba_task(const Params& p, int l, int task, LAS unsigned char* lds) {
    const int b = task / 128, r = task % 128, hB = r / 32, ci = r % 32;
    const int tid = tidx(), wave = tid >> 6, lane = tid & 63, qi = lane & 15, g = lane >> 4;
    const bf16_t* pbc = (const bf16_t*)(p.ws + WS_PBC);
    const float* kmean = (const float*)(p.ws + WS_KMEAN) + (size_t)(b * 4 + hB) * 1024;
    LAS float* km = (LAS float*)(lds + AT_KM); LAS unsigned* sel = (LAS unsigned*)(lds + AT_SEL); LAS unsigned* any = (LAS unsigned*)(lds + AT_ANY);
    MobaTask tk; tk.tokbase = b * SEQ; tk.q0 = ci * 128; tk.b_own = ci >> 1; tk.nown = (ci & 1) ? 4 : 2;
    __syncthreads();
    for (int i = tid; i < 1024; i += NTHR) km[i] = kmean[i];
    if (tid == 0) *any = 0u;
    __syncthreads();
    {
        const int q = tid >> 2, part = tid & 3;
        const bf16_t* qp = pbc + (size_t)(tk.tokbase + tk.q0 + q) * PBC_W + hB * 64 + part * 16;
        const u32x4 r0 = *(const u32x4*)qp, r1 = *(const u32x4*)(qp + 8);
        float qf[16];
#pragma unroll
        for (int j = 0; j < 4; ++j) { qf[2 * j] = bflo(r0[j]); qf[2 * j + 1] = bfhi(r0[j]); qf[8 + 2 * j] = bflo(r1[j]); qf[8 + 2 * j + 1] = bfhi(r1[j]); }
        float ss = 0.f;
#pragma unroll
        for (int j = 0; j < 16; ++j) ss += qf[j] * qf[j];
        ss += __shfl_xor(ss, 1); ss += __shfl_xor(ss, 2);
        const float qs = rsqrtf(ss * (1.0f / 64.0f) + 1e-6f);
        const float* qg = p.in[I_MQG] + l * 64 + part * 16;
#pragma unroll
        for (int j = 0; j < 16; ++j) qf[j] *= qs * qg[j];
        float v1 = -INFINITY, v2 = -INFINITY, v3 = -INFINITY; int i1 = -1, i2 = -1, i3 = -1;
        for (int n = 0; n < tk.b_own; ++n) {
            float s = 0.f;
#pragma unroll
            for (int j = 0; j < 16; ++j) s += qf[j] * km[n * 64 + part * 16 + j];
            s += __shfl_xor(s, 1); s += __shfl_xor(s, 2);
            if (s > v1) { v3 = v2; i3 = i2; v2 = v1; i2 = i1; v1 = s; i1 = n; }
            else if (s > v2) { v3 = v2; i3 = i2; v2 = s; i2 = n; }
            else if (s > v3) { v3 = s; i3 = n; }
        }
        unsigned mk = 0u;
        if (i1 >= 0) mk |= 1u << i1;
        if (i2 >= 0) mk |= 1u << i2;
        if (i3 >= 0) mk |= 1u << i3;
        if (part == 0) { sel[q] = mk; atomicOr((unsigned*)any, mk); }
    }
    __syncthreads();
    tk.anysel = *any; tk.mysel = sel[wave * 16 + qi];
    AttnOut R;
    attn_core(tk, pbc + hB * 64, pbc + 256 + hB * 64, pbc + 512 + hB * 64, p.in[I_MQG] + l * 64, p.in[I_MKG] + l * 64, lds, R);
    const int tok = tk.q_tok(wave * 16 + qi);
    const float inv = 1.0f / R.l;
    const bf16_t* sg = (const bf16_t*)(p.ws + WS_GATE) + (size_t)tok * 1024 + 384 + hB * 64;
    bf16_t* yg = (bf16_t*)(p.ws + WS_YG) + (size_t)tok * 1024 + 384 + hB * 64;
#pragma unroll
    for (int mo = 0; mo < 4; ++mo) {
        const int dh = mo * 16 + g * 4;
        const u32x2 gt = *(const u32x2*)(sg + dh);
        u32x2 w; w.x = pk2(R.o[mo][0] * inv * bflo(gt.x), R.o[mo][1] * inv * bfhi(gt.x)); w.y = pk2(R.o[mo][2] * inv * bflo(gt.y), R.o[mo][3] * inv * bfhi(gt.y));
        *(u32x2*)(yg + dh) = w;
    }
}

__device__ __forceinline__ void kmean_task(const Params& p, int l, int task, LAS unsigned char* lds) {
    const int b = task / 64, r = task % 64, hB = r / 16, n = r % 16;
    const int tid = tidx(), kr = tid >> 3, pc = tid & 7;
    const bf16_t* kb = (const bf16_t*)(p.ws + WS_PBC) + 256 + hB * 64 + pc * 8;
    const float* kg = p.in[I_MKG] + l * 64 + pc * 8;
    float acc[8];
#pragma unroll
    for (int j = 0; j < 8; ++j) acc[j] = 0.f;
#pragma unroll
    for (int it = 0; it < 4; ++it) {
        const u32x4 rw = *(const u32x4*)(kb + (size_t)(b * SEQ + n * 256 + it * 64 + kr) * PBC_W);
        float kf[8];
#pragma unroll
        for (int q = 0; q < 4; ++q) { kf[2 * q] = bflo(rw[q]); kf[2 * q + 1] = bfhi(rw[q]); }
        float ss = 0.f;
#pragma unroll
        for (int q = 0; q < 8; ++q) ss += kf[q] * kf[q];
        ss = sum8(ss);
        const float ks = rsqrtf(ss * (1.0f / 64.0f) + 1e-6f);
#pragma unroll
        for (int q = 0; q < 8; ++q) acc[q] += bf2f(f2bf(kf[q] * ks * kg[q]));
    }
    LAS float* red = (LAS float*)lds;
    __syncthreads();
#pragma unroll
    for (int q = 0; q < 8; ++q) red[kr * 64 + pc * 8 + q] = acc[q];
    __syncthreads();
    if (tid < 64) {
        float s = 0.f;
        for (int i = 0; i < 64; ++i) s += red[i * 64 + tid];
        ((float*)(p.ws + WS_KMEAN))[(size_t)((b * 4 + hB) * 16 + n) * 64 + tid] = s * (1.0f / 256.0f);
    }
}

__device__ __forceinline__ void rwkv_prep(const Params& p, int l, int task, LAS unsigned char* lds) {
    const int bh = task / 64, ch = task % 64, b = bh / 6, h = bh % 6;
    const int tid = tidx(), tl = tid >> 3, pc = tid & 7;
    const int s = ch * 64 + tl, tok = b * SEQ + s;
    LAS float* sh = (LAS float*)lds;
    LAS float* wup = sh + 5 * 4096;
    LAS float* aup = wup + 4096;
    const bf16_t* pa = (const bf16_t*)(p.ws + WS_PA);
    const float* mu = p.in[I_MU] + l * 1280;
    __syncthreads();
#pragma unroll
    for (int gi = 0; gi < 5; ++gi) {
        const int cb = (gi < 3 ? gi * 384 + h * 64 : (gi == 3 ? 1152 : 1216)) + pc * 8;
        const u32x4 cur = *(const u32x4*)(pa + (size_t)tok * PA_W + cb);
        u32x4 prv = {0u, 0u, 0u, 0u};
        if (s > 0) prv = *(const u32x4*)(pa + (size_t)(tok - 1) * PA_W + cb);
#pragma unroll
        for (int q = 0; q < 4; ++q) {
            const float c0 = bflo(cur[q]), c1 = bfhi(cur[q]), p0 = bflo(prv[q]), p1 = bfhi(prv[q]);
            float v0 = c0 + (p0 - c0) * mu[cb + 2 * q], v1 = c1 + (p1 - c1) * mu[cb + 2 * q + 1];
            if (gi == 3) { v0 = tanhf(v0); v1 = tanhf(v1); }
            sh[gi * 4096 + tl * 64 + pc * 8 + 2 * q] = v0; sh[gi * 4096 + tl * 64 + pc * 8 + 2 * q + 1] = v1;
        }
    }
    {
        const float* wsrc = p.in[I_WUP] + (size_t)l * 64 * 384 + (size_t)tl * 384 + h * 64 + pc * 8;
        const float* asrc = p.in[I_AUP] + (size_t)l * 64 * 384 + (size_t)tl * 384 + h * 64 + pc * 8;
        *(LAS f32x4*)(wup + tl * 64 + pc * 8) = *(const f32x4*)wsrc; *(LAS f32x4*)(wup + tl * 64 + pc * 8 + 4) = *(const f32x4*)(wsrc + 4);
        *(LAS f32x4*)(aup + tl * 64 + pc * 8) = *(const f32x4*)asrc; *(LAS f32x4*)(aup + tl * 64 + pc * 8 + 4) = *(const f32x4*)(asrc + 4);
    }
    __syncthreads();
    const int cbase = l * 384 + h * 64 + pc * 8;
    float wa[8], aa[8];
#pragma unroll
    for (int j = 0; j < 8; ++j) { wa[j] = p.in[I_W0][cbase + j]; aa[j] = p.in[I_A0][cbase + j]; }
#pragma unroll 4
    for (int i = 0; i < 64; ++i) {
        const float tw = sh[3 * 4096 + tl * 64 + i], ad = sh[4 * 4096 + tl * 64 + i];
        const f32x4 w0 = *(const LAS f32x4*)(wup + i * 64 + pc * 8), w1 = *(const LAS f32x4*)(wup + i * 64 + pc * 8 + 4);
        const f32x4 a0 = *(const LAS f32x4*)(aup + i * 64 + pc * 8), a1 = *(const LAS f32x4*)(aup + i * 64 + pc * 8 + 4);
#pragma unroll
        for (int j = 0; j < 4; ++j) { wa[j] += tw * w0[j]; wa[4 + j] += tw * w1[j]; aa[j] += ad * a0[j]; aa[4 + j] += ad * a1[j]; }
    }
    float x1m[8], av[8], kkv[8], kp[8];
    float ssq = 0.f;
#pragma unroll
    for (int j = 0; j < 8; ++j) {
        const float z = -wa[j];
        const float sp = fmaxf(z, 0.f) + log1pf(expf(-fabsf(z)));
        const float w = -sp - 0.5f;
        x1m[j] = -expm1f(-expf(w));
        av[j] = 1.0f / (1.0f + expf(-aa[j]));
        const float kraw = sh[1 * 4096 + tl * 64 + pc * 8 + j];
        kkv[j] = kraw * p.in[I_KK][cbase + j];
        ssq += kkv[j] * kkv[j];
        kp[j] = kraw * (1.0f + (av[j] - 1.0f) * p.in[I_KA][cbase + j]);
    }
    ssq = sum8(ssq);
    const float inv = rsqrtf(ssq + 1e-12f);
    bf16_t* dst = (bf16_t*)(p.ws + WS_RW) + ((size_t)bh * SEQ + s) * 384 + pc * 8;
    u32x4 w;
#define PK8(expr) do { float _t[8]; _Pragma("unroll") for (int j = 0; j < 8; ++j) _t[j] = (expr); w.x = pk2(_t[0], _t[1]); w.y = pk2(_t[2], _t[3]); w.z = pk2(_t[4], _t[5]); w.w = pk2(_t[6], _t[7]); } while (0)
    PK8(x1m[j]); *(u32x4*)(dst) = w;
    PK8(kkv[j] * inv); *(u32x4*)(dst + 64) = w;
    PK8(kkv[j] * inv * av[j]); *(u32x4*)(dst + 128) = w;
    PK8(kp[j]); *(u32x4*)(dst + 192) = w;
    PK8(sh[0 * 4096 + tl * 64 + pc * 8 + j]); *(u32x4*)(dst + 256) = w;
    PK8(sh[2 * 4096 + tl * 64 + pc * 8 + j]); *(u32x4*)(dst + 320) = w;
#undef PK8
}

constexpr int SC_CH = 32;
constexpr int SC_BUF = SC_CH * 384 * 2;
__device__ __forceinline__ void scan_task(const Params& p, int l, int bh, LAS unsigned char* lds) {
    const int b = bh / 6, h = bh % 6;
    const int tid = tidx(), wave = tid >> 6, lane = tid & 63, row = tid >> 3, kq = tid & 7;
    const bf16_t* rw = (const bf16_t*)(p.ws + WS_RW) + (size_t)bh * SEQ * 384;
    LAS float* ylds = (LAS float*)(lds + 2 * SC_BUF);
    const float lng = p.in[I_LNG][l * 384 + h * 64 + lane], lnb = p.in[I_LNB][l * 384 + h * 64 + lane], rk = p.in[I_RK][l * 384 + h * 64 + lane];
    const bf16_t* sg = (const bf16_t*)(p.ws + WS_GATE) + (size_t)b * SEQ * 1024 + h * 64 + lane;
    bf16_t* yg = (bf16_t*)(p.ws + WS_YG) + (size_t)b * SEQ * 1024 + h * 64 + lane;
    float S[8];
#pragma unroll
    for (int j = 0; j < 8; ++j) S[j] = 0.f;
    u32x4 st[3];
    __syncthreads();
#pragma unroll
    for (int i = 0; i < 3; ++i) st[i] = *(const u32x4*)(rw + (size_t)(tid + i * NTHR) * 8);
#pragma unroll
    for (int i = 0; i < 3; ++i) *(LAS u32x4*)(lds + (tid + i * NTHR) * 16) = st[i];
    __syncthreads();
    constexpr int NCH = SEQ / SC_CH;
    for (int c = 0; c < NCH; ++c) {
        const LAS unsigned char* cur = lds + (c & 1) * SC_BUF;
        if (c + 1 < NCH) {
#pragma unroll
            for (int i = 0; i < 3; ++i) st[i] = *(const u32x4*)(rw + (size_t)(c + 1) * SC_CH * 384 + (size_t)(tid + i * NTHR) * 8);
        }
        u32x4 nx = *(const LAS u32x4*)(cur + kq * 16), nkk = *(const LAS u32x4*)(cur + 128 + kq * 16), nbb = *(const LAS u32x4*)(cur + 256 + kq * 16),
              nk = *(const LAS u32x4*)(cur + 384 + kq * 16), nr = *(const LAS u32x4*)(cur + 512 + kq * 16);
        float nv = bf2f(*(const LAS bf16_t*)(cur + 640 + row * 2));
        for (int t = 0; t < SC_CH; ++t) {
            const u32x4 x = nx, kk = nkk, bb = nbb, k = nk, r = nr; const float v = nv;
            if (t + 1 < SC_CH) {
                const LAS unsigned char* nb = cur + (t + 1) * 768;
                nx = *(const LAS u32x4*)(nb + kq * 16); nkk = *(const LAS u32x4*)(nb + 128 + kq * 16); nbb = *(const LAS u32x4*)(nb + 256 + kq * 16);
                nk = *(const LAS u32x4*)(nb + 384 + kq * 16); nr = *(const LAS u32x4*)(nb + 512 + kq * 16);
                nv = bf2f(*(const LAS bf16_t*)(nb + 640 + row * 2));
            }
            float sa = 0.f;
#pragma unroll
            for (int q = 0; q < 4; ++q) sa += S[2 * q] * bflo(kk[q]) + S[2 * q + 1] * bfhi(kk[q]);
            sa = -dsum8(sa);
            float y = 0.f;
#pragma unroll
            for (int q = 0; q < 4; ++q) {
                float s0 = S[2 * q], s1 = S[2 * q + 1];
                s0 = s0 - s0 * bflo(x[q]) + sa * bflo(bb[q]) + v * bflo(k[q]);
                s1 = s1 - s1 * bfhi(x[q]) + sa * bfhi(bb[q]) + v * bfhi(k[q]);
                S[2 * q] = s0; S[2 * q + 1] = s1;
                y += s0 * bflo(r[q]) + s1 * bfhi(r[q]);
            }
            y = dsum8(y);
            if (kq == 0) ylds[t * 64 + row] = y;
        }
        __syncthreads();
#pragma unroll
        for (int tt = 0; tt < 4; ++tt) {
            const int t = wave * 4 + tt;
            const size_t srow = (size_t)(c * SC_CH + t) * 1024;
            const float yv = ylds[t * 64 + lane];
            const float mean = wsum64(yv) * (1.0f / 64.0f);
            const float dv = yv - mean;
            const float var = wsum64(dv * dv) * (1.0f / 64.0f);
            float yn = dv * rsqrtf(var + 64e-5f) * lng + lnb;
            const float rr = bf2f(*(const LAS bf16_t*)(cur + t * 768 + 512 + lane * 2)), kk2 = bf2f(*(const LAS bf16_t*)(cur + t * 768 + 384 + lane * 2)),
                        vv = bf2f(*(const LAS bf16_t*)(cur + t * 768 + 640 + lane * 2));
            const float bonus = wsum64(rr * kk2 * rk);
            yn += bonus * vv;
            yg[srow] = f2bf(yn * bf2f(sg[srow]));
        }
        if (c + 1 < NCH) {
#pragma unroll
            for (int i = 0; i < 3; ++i) *(LAS u32x4*)(lds + ((c + 1) & 1) * SC_BUF + (tid + i * NTHR) * 16) = st[i];
        }
        __syncthreads();
    }
}

__global__ void __launch_bounds__(512, 2) hymba_fwd(Params p) {
    extern __shared__ __attribute__((aligned(16))) unsigned char shm[];
    LAS unsigned char* lds = (LAS unsigned char*)shm;
    cg::grid_group grid = cg::this_grid();
    for (int ph = p.ph_lo; ph < p.ph_hi; ++ph) {
        if (ph > p.ph_lo) grid.sync();
#ifndef NO_P0
        if (ph == 0) { phase_prologue(p, lds); continue; }
#endif
        const int l = (ph - 1) >> 2, sub = (ph - 1) & 3;
        if (sub == 0) {
            pg8::Gemm g; g.A = (const bf16_t*)(p.ws + WS_XB); g.Bt = (const bf16_t*)(p.ws + WS_WIN); g.M = T_TOK; g.N = PWP; g.K = 1024;
            pg8::StaticOrder S; S.init(g.M, g.N, (int)gridDim.x, (int)blockIdx.x);
            EpiIn E; E.pa = (bf16_t*)(p.ws + WS_PA); E.pbc = (bf16_t*)(p.ws + WS_PBC); E.gate = (bf16_t*)(p.ws + WS_GATE); E.ssq = (const float*)(p.ws + WS_SSQ);
#ifndef NO_G1
            pg8::gemm_phase<EpiIn, pg8::StaticOrder, false>(lds, g, S, E, nullptr);
#endif
            for (int t = blockIdx.x; t < 256; t += gridDim.x) convert_tile(p.in[I_WOUT] + (size_t)l * 1024 * 1024, 1024, 1024, nullptr, (bf16_t*)(p.ws + WS_WOUT), t & 15, t >> 4, lds);
        } else if (sub == 1) {
            const int ntask = 1536 + 1536 + 256 + (l < 3 ? 16 * 68 : 0);
            for (int t = blockIdx.x; t < ntask; t += gridDim.x) {
#ifndef NO_DIL
                if (t < 1536) dil_task(p, l, t / 768, t % 768, lds); else
#endif
#ifndef NO_PREP
                if (t < 3072) rwkv_prep(p, l, t - 1536, lds); else
#endif
#ifndef NO_KM
                if (t < 3328) kmean_task(p, l, t - 3072, lds); else
#endif
                if (t < 3328) {}
                else { const int u = t - 3328; convert_tile(p.in[I_WIN] + (size_t)(l + 1) * 1024 * 4224, 4224, 4224, p.in[I_NORMG] + (l + 1) * 1024, (bf16_t*)(p.ws + WS_WIN), u & 15, u >> 4, lds); }
            }
        } else if (sub == 2) {
#ifndef NO_SCAN
            if (blockIdx.x < 24) scan_task(p, l, blockIdx.x, lds);
#else
            if (blockIdx.x < 24) {}
#endif
            else for (int t = blockIdx.x - 24; t < 512 + 768; t += gridDim.x - 24) {
#ifndef NO_MOBA
                if (t < 512) moba_task(p, l, t, lds); else
#endif
#ifndef NO_DIL
                dil_task(p, l, 2, t - 512, lds);
#else
                {}
#endif
            }
        } else {
            pg8::Gemm g; g.A = (const bf16_t*)(p.ws + WS_YG); g.Bt = (const bf16_t*)(p.ws + WS_WOUT); g.M = T_TOK; g.N = 1024; g.K = 1024;
            pg8::StaticOrder S; S.init(g.M, g.N, (int)gridDim.x, (int)blockIdx.x);
            EpiOut E; E.res = (l == 0) ? p.in[I_X] : p.out; E.out = p.out; E.xb = (bf16_t*)(p.ws + WS_XB); E.ssq = (float*)(p.ws + WS_SSQ);
#ifndef NO_G2
            pg8::gemm_phase<EpiOut, pg8::StaticOrder, false>(lds, g, S, E, nullptr);
#endif
        }
    }
}

#ifndef MK_MULTI
#define MK_MULTI 1
#endif
extern "C" void kernel_launch(void* const* d_in, const int* in_sizes, int n_in, void* d_out, int out_size, void* d_ws, size_t ws_size, hipStream_t stream) {
    static int grid = 0;
    if (grid == 0) {
        int dev = 0, cus = 0, per_cu = 0;
        hipGetDevice(&dev);
        hipDeviceGetAttribute(&cus, hipDeviceAttributeMultiprocessorCount, dev);
        if (hipFuncSetAttribute((const void*)hymba_fwd, hipFuncAttributeMaxDynamicSharedMemorySize, LDS_BYTES) != hipSuccess) fprintf(stderr, "kernel_launch: hipFuncSetAttribute failed\n");
        if (hipOccupancyMaxActiveBlocksPerMultiprocessor(&per_cu, (const void*)hymba_fwd, NTHR, LDS_BYTES) != hipSuccess || per_cu < 1) { fprintf(stderr, "kernel_launch: occupancy query gave %d\n", per_cu); per_cu = 1; }
        (void)hipGetLastError();
        if (cus <= 0) cus = 256;
        grid = cus;
        if (ws_size < WS_END) fprintf(stderr, "kernel_launch: workspace too small: %zu < %zu\n", ws_size, (size_t)WS_END);
    }
    Params p{};
    for (int i = 0; i < 18; ++i) p.in[i] = (const float*)d_in[i];
    p.out = (float*)d_out; p.ws = (unsigned char*)d_ws;
#if MK_MULTI
    for (int ph = 0; ph < 17; ++ph) {
        p.ph_lo = ph; p.ph_hi = ph + 1;
        hipLaunchKernelGGL(hymba_fwd, dim3(grid), dim3(NTHR), LDS_BYTES, stream, p);
    }
#else
    p.ph_lo = 0; p.ph_hi = 17;
    void* args[] = {&p};
    hipError_t e = hipLaunchCooperativeKernel((const void*)hymba_fwd, dim3(grid), dim3(NTHR), args, LDS_BYTES, stream);
    if (e != hipSuccess) fprintf(stderr, "cooperative launch failed: %s (grid %d)\n", hipGetErrorString(e), grid);
#endif
}
```

```cpp
#include <hip/hip_runtime.h>
#include <hip/hip_cooperative_groups.h>
#include <cstdio>
namespace cg = cooperative_groups;
__device__ __forceinline__ int tidx() { int t = threadIdx.x; asm volatile("" : "+v"(t)); return t; }
namespace pg8 {
#define PG8_LAS __attribute__((address_space(3)))
typedef unsigned short bf16_t;
typedef short bf16x8 __attribute__((ext_vector_type(8)));
typedef float f32x4 __attribute__((ext_vector_type(4)));
typedef unsigned u32x4 __attribute__((ext_vector_type(4)));
constexpr int BM = 256, BK = 64, HALF = 128, HTB = HALF * BK * 2  , STAGE_BYTES = 8 * HTB, NXCD = 8, WGM = 8;

__host__ __device__ __forceinline__ int lds_byte(int r, int c) { const int st = (r >> 4) * 2 + (c >> 5), rr = r & 15, cc = c & 31, ob = rr * 64 + cc * 2; return st * 1024 + (ob ^ (((ob >> 9) & 1) << 5)); }
__host__ __device__ __forceinline__ void stage_rc(int b, int& R, int& C) { const int st = b / 1024, sb = b % 1024, swz = sb ^ (((sb >> 9) & 1) << 5); R = (st >> 1) * 16 + swz / 64; C = (st & 1) * 32 + (swz % 64) / 2; }
__host__ __device__ __forceinline__ int perm32(int rho) { const int n = rho >> 4, i = rho & 15; return 8 * (i >> 2) + 4 * n + (i & 3); }

struct Unit { int pm, pn; };
struct Gemm { const bf16_t* A; const bf16_t* Bt; int M, N, K; };

struct StaticOrder {
    int nM, nN, nwg, G, c;
    __host__ __device__ void init(int M, int N, int G_, int c_) { nM = M / BM; nN = N / BM; nwg = nM * nN; G = G_; c = c_; }
    __host__ __device__ bool next(int i, Unit& u) const {
        const long L = (long)i * G + c; if (L >= nwg) return false;
        int wgid = (int)L; { const int q = nwg / NXCD, r = nwg % NXCD, xcd = wgid % NXCD, off = wgid / NXCD; wgid = (xcd < r ? xcd * (q + 1) : r * (q + 1) + (xcd - r) * q) + off; }
        const int nig = WGM * nN, gid = wgid / nig, fm = gid * WGM, gsz = (nM - fm) < WGM ? (nM - fm) : WGM;
        u.pm = fm + ((wgid % nig) % gsz); u.pn = (wgid % nig) / gsz; return true;
    }
    __device__ __forceinline__ void a_ready(const Unit&) const {}
    __device__ __forceinline__ void done(const Unit&) const {}
};
__device__ __forceinline__ unsigned cvt_pk_bf16(float lo, float hi) { unsigned r; asm volatile("v_cvt_pk_bf16_f32 %0, %1, %2" : "=v"(r) : "v"(lo), "v"(hi)); return r; }
typedef float f32x2 __attribute__((ext_vector_type(2)));
template <class Epi, class Sched, bool STAMP = false>
__device__ __forceinline__ void gemm_phase(PG8_LAS unsigned char* lds, const Gemm g, const Sched& S, const Epi& E, unsigned long long* stamps) {
    const int tid = tidx(), wid = __builtin_amdgcn_readfirstlane(tid >> 6), lane = tid & 63, wr = wid >> 2, wc = wid & 3, fr = lane & 15, fq = lane >> 4;
    const int K = g.K, nt = K / BK;
    int ts_lo = 0, ts_hi = 0, nts = 0; const unsigned long long rt_entry = STAMP ? (unsigned long long)wall_clock64() : 0ull;
#define PG8_STAMP() do { if (STAMP && wid == 0 && nts < 64) { const unsigned long long _c = (unsigned long long)clock64(); \
        ts_lo = (lane == nts) ? (int)(unsigned)_c : ts_lo; ts_hi = (lane == nts) ? (int)(unsigned)(_c >> 32) : ts_hi; ++nts; } } while (0)
    PG8_STAMP();
    unsigned voffA[2], voffB[2];
#pragma unroll
    for (int i = 0; i < 2; ++i) { int R, C; stage_rc(tid * 16 + i * 8192, R, C); const int Rb = Epi::PERM ? ((R & ~31) + perm32(R & 31)) : R;
        voffA[i] = (unsigned)(R * K + C) * 2u; voffB[i] = (unsigned)(Rb * K + C) * 2u; }
    const size_t kstep = (size_t)(BK * 2);
    const size_t hstep = (size_t)HALF * K * 2;
    const size_t tstep = 2 * hstep;
    const unsigned ldsw = (unsigned)wid * 1024u;
    const int aoff = lds_byte(wr * 64 + fr, fq * 8), boff = lds_byte(wc * 32 + fr, fq * 8);
#define PG8_SA(b, h) (((b) * 2 + (h)) * HTB)
#define PG8_SB(b, h) ((4 + (b) * 2 + (h)) * HTB)
#define PG8_STAGE(bufoff, gbase, voff) do { _Pragma("unroll") for (int _i = 0; _i < 2; ++_i) \
        __builtin_amdgcn_global_load_lds((const unsigned*)((const char*)(gbase) + (voff)[_i]), (PG8_LAS unsigned*)(lds + (bufoff) + ldsw + _i * 8192), 16, 0, 0); } while (0)
#define PG8_LDA(dst, b, h) do { _Pragma("unroll") for (int m = 0; m < 4; ++m) _Pragma("unroll") for (int k = 0; k < 2; ++k) dst[m][k] = *(const PG8_LAS bf16x8*)(lds + PG8_SA(b, h) + aoff + m * 2048 + k * 1024); } while (0)
#define PG8_LDB(dst, b, h) do { _Pragma("unroll") for (int n = 0; n < 2; ++n) _Pragma("unroll") for (int k = 0; k < 2; ++k) dst[n][k] = *(const PG8_LAS bf16x8*)(lds + PG8_SB(b, h) + boff + n * 2048 + k * 1024); } while (0)
#define PG8_MMA(ai, bj, At, Bt) do { __builtin_amdgcn_s_setprio(1); _Pragma("unroll") for (int m = 0; m < 4; ++m) _Pragma("unroll") for (int n = 0; n < 2; ++n) _Pragma("unroll") for (int k = 0; k < 2; ++k) \
        acc[ai][bj][m][n] = __builtin_amdgcn_mfma_f32_16x16x32_bf16(Bt[n][k], At[m][k], acc[ai][bj][m][n], 0, 0, 0); __builtin_amdgcn_s_setprio(0); } while (0)
#define PG8_WAIT_V(n) asm volatile("s_waitcnt vmcnt(" #n ")" ::: "memory")
#define PG8_WAIT_L(n) asm volatile("s_waitcnt lgkmcnt(" #n ")" ::: "memory")
#define PG8_BAR __builtin_amdgcn_s_barrier()
#define PG8_SCHED __builtin_amdgcn_sched_barrier(0)
    Unit cur, nxt; int ui = 0;
    if (!S.next(0, cur)) return;
    f32x4 acc[2][2][4][2];
#pragma unroll
    for (int a = 0; a < 2; ++a)
#pragma unroll
        for (int b = 0; b < 2; ++b)
#pragma unroll
            for (int m = 0; m < 4; ++m)
#pragma unroll
                for (int n = 0; n < 2; ++n) acc[a][b][m][n] = (f32x4){0.f, 0.f, 0.f, 0.f};
    bf16x8 At[4][2], B0[2][2], B1[2][2];
    const char* cA = (const char*)g.A + (size_t)cur.pm * tstep; const char* cB = (const char*)g.Bt + (size_t)cur.pn * tstep;
    S.a_ready(cur);
    PG8_STAGE(PG8_SB(0, 0), cB, voffB); PG8_STAGE(PG8_SA(0, 0), cA, voffA); PG8_STAGE(PG8_SB(0, 1), cB + hstep, voffB); PG8_STAGE(PG8_SA(0, 1), cA + hstep, voffA);
    if (wr == 1) PG8_BAR;
    PG8_WAIT_V(4); PG8_BAR;
    PG8_STAGE(PG8_SB(1, 0), cB + kstep, voffB); PG8_STAGE(PG8_SA(1, 0), cA + kstep, voffA); PG8_STAGE(PG8_SB(1, 1), cB + hstep + kstep, voffB);
    PG8_WAIT_V(6); PG8_BAR;
    PG8_STAMP();
    for (;;) {
        const bool has_next = S.next(ui + 1, nxt);
        const char* nA = has_next ? (const char*)g.A + (size_t)nxt.pm * tstep : cA; const char* nB = has_next ? (const char*)g.Bt + (size_t)nxt.pn * tstep : cB;
        for (int t = 0; t < nt; t += 2) {
            const bool last = (t == nt - 2);
            const char* a1 = cA + (size_t)(t + 1) * kstep;
            const char* a2 = last ? nA : cA + (size_t)(t + 2) * kstep; const char* b2 = last ? nB : cB + (size_t)(t + 2) * kstep;
            const char* a3 = a2 + kstep; const char* b3 = b2 + kstep;
            if (last && has_next) S.a_ready(nxt);
            PG8_LDB(B0, 0, 0); PG8_SCHED; PG8_LDA(At, 0, 0); PG8_STAGE(PG8_SA(1, 1), a1 + hstep, voffA);
            PG8_WAIT_L(8); PG8_BAR; PG8_WAIT_L(0); PG8_MMA(0, 0, At, B0); PG8_BAR; PG8_SCHED;
            PG8_LDB(B1, 0, 1); PG8_STAGE(PG8_SB(0, 0), b2, voffB);
            PG8_BAR; PG8_WAIT_L(0); PG8_MMA(0, 1, At, B1); PG8_BAR;
            PG8_LDA(At, 0, 1); PG8_STAGE(PG8_SA(0, 0), a2, voffA);
            PG8_BAR; PG8_WAIT_L(0); PG8_MMA(1, 0, At, B0); PG8_BAR; PG8_SCHED;
            PG8_STAGE(PG8_SB(0, 1), b2 + hstep, voffB);
            PG8_WAIT_V(6); PG8_BAR; PG8_MMA(1, 1, At, B1); PG8_BAR;
            PG8_LDB(B0, 1, 0); PG8_SCHED; PG8_LDA(At, 1, 0); PG8_STAGE(PG8_SA(0, 1), a2 + hstep, voffA);
            PG8_WAIT_L(8); PG8_BAR; PG8_WAIT_L(0); PG8_MMA(0, 0, At, B0); PG8_BAR; PG8_SCHED;
            PG8_LDB(B1, 1, 1); PG8_STAGE(PG8_SB(1, 0), b3, voffB);
            PG8_BAR; PG8_WAIT_L(0); PG8_MMA(0, 1, At, B1); PG8_BAR;
            PG8_LDA(At, 1, 1); PG8_STAGE(PG8_SA(1, 0), a3, voffA);
            PG8_BAR; PG8_WAIT_L(0); PG8_MMA(1, 0, At, B0); PG8_BAR; PG8_SCHED;
            PG8_STAGE(PG8_SB(1, 1), b3 + hstep, voffB);
            PG8_WAIT_V(6); PG8_BAR; PG8_MMA(1, 1, At, B1); PG8_BAR;
        }
        PG8_STAMP();
        if constexpr (!Epi::AFTER_DRAIN) { E(acc, cur, wr, wc, fr, fq); S.done(cur); }
        PG8_STAMP();
        if (!has_next) break;
#pragma unroll
        for (int a = 0; a < 2; ++a)
#pragma unroll
            for (int b = 0; b < 2; ++b)
#pragma unroll
                for (int m = 0; m < 4; ++m)
#pragma unroll
                    for (int n = 0; n < 2; ++n) acc[a][b][m][n] = (f32x4){0.f, 0.f, 0.f, 0.f};
        cur = nxt; cA = nA; cB = nB; ++ui;
    }
    PG8_WAIT_V(0);
    if (wr == 0) PG8_BAR;
    PG8_BAR;
    if constexpr (Epi::AFTER_DRAIN) { E.fused(acc, cur, wr, wc, fr, fq, lds, wid, lane); S.done(cur); }
    PG8_STAMP();
    if (STAMP && wid == 0) { stamps[lane] = lane < nts ? (((unsigned long long)(unsigned)ts_hi << 32) | (unsigned)ts_lo) : 0ull;
        if (lane == 62) stamps[62] = rt_entry; if (lane == 63) stamps[63] = (unsigned long long)wall_clock64(); }
#undef PG8_STAMP
#undef PG8_SA
#undef PG8_SB
#undef PG8_STAGE
#undef PG8_LDA
#undef PG8_LDB
#undef PG8_MMA
#undef PG8_WAIT_V
#undef PG8_WAIT_L
#undef PG8_BAR
#undef PG8_SCHED
}
}

#define LAS __attribute__((address_space(3)))
typedef unsigned short bf16_t;
typedef short bf16x8 __attribute__((ext_vector_type(8)));
typedef float f32x4 __attribute__((ext_vector_type(4)));
typedef unsigned u32x4 __attribute__((ext_vector_type(4)));
typedef unsigned u32x2 __attribute__((ext_vector_type(2)));
typedef short s16x4 __attribute__((ext_vector_type(4)));

constexpr int T_TOK = 16384, SEQ = 4096, DM = 1024;
constexpr int PWP = 4352, PA_W = 1280, PBC_W = 1920;
constexpr int NTHR = 512;
constexpr int XCD_BAR_WORDS_C = 3456;
constexpr int LDS_BYTES = 131072 + 16 + 1024;
constexpr size_t WS_WIN = 0;
constexpr size_t WS_WOUT = WS_WIN + (size_t)PWP * 1024 * 2;
constexpr size_t WS_XB = WS_WOUT + (size_t)1024 * 1024 * 2;
constexpr size_t WS_SSQ = WS_XB + (size_t)T_TOK * 1024 * 2;
constexpr size_t WS_PA = WS_SSQ + (size_t)T_TOK * 16 * 4;
constexpr size_t WS_PBC = WS_PA + (size_t)T_TOK * PA_W * 2;
constexpr size_t WS_GATE = WS_PBC + (size_t)T_TOK * PBC_W * 2;
constexpr size_t WS_GT = WS_GATE + (size_t)T_TOK * 1024 * 2;
constexpr size_t WS_HM = WS_GT + (size_t)1536 * 4096 * 2;
constexpr size_t WS_QQ = WS_HM + (size_t)1536 * 4096 * 2;
constexpr size_t WS_Y0 = WS_QQ + (size_t)1536 * 4096 * 2;
constexpr size_t WS_BV = WS_Y0 + (size_t)1536 * 4096 * 2;
constexpr size_t WS_SC = WS_BV + (size_t)1536 * 4096 * 2;
constexpr size_t WS_KMEAN = WS_SC + (size_t)1536 * 4096 * 2;
constexpr size_t WS_BAR = WS_KMEAN + (size_t)4 * 4 * 16 * 64 * 4;
constexpr size_t WS_FLAG = WS_BAR + (size_t)XCD_BAR_WORDS_C * 4;
constexpr size_t WS_CNT = WS_FLAG + 256;
constexpr size_t WS_KMC = WS_CNT + 4096;
constexpr size_t WS_WIN1 = WS_KMC + 256;
constexpr size_t WS_END = WS_WIN1 + (size_t)PWP * 1024 * 2;
constexpr size_t WS_YG = WS_PA;

struct Params {
    const float* in[18];
    float* out;
    unsigned char* ws;
    unsigned* bar;
    int ph_lo, ph_hi;
};
enum { I_X = 0, I_NORMG, I_WIN, I_WOUT, I_MU, I_W0, I_WUP, I_A0, I_AUP, I_KK, I_KA, I_RK, I_LNG, I_LNB, I_MQG, I_MKG, I_DQG, I_DKG };

__device__ __forceinline__ float bf2f(bf16_t b) { return __uint_as_float(((unsigned)b) << 16); }
__device__ __forceinline__ bf16_t f2bf(float f) { unsigned u = __float_as_uint(f); u += 0x7FFFu + ((u >> 16) & 1u); return (bf16_t)(u >> 16); }
__device__ __forceinline__ unsigned pk2(float lo, float hi) { unsigned r; asm("v_cvt_pk_bf16_f32 %0, %1, %2" : "=v"(r) : "v"(lo), "v"(hi)); return r; }
__device__ __forceinline__ float bflo(unsigned w) { return __uint_as_float(w << 16); }
__device__ __forceinline__ float bfhi(unsigned w) { return __uint_as_float(w & 0xFFFF0000u); }
__device__ __forceinline__ float wsum64(float v) {
    v += __shfl_xor(v, 1); v += __shfl_xor(v, 2); v += __shfl_xor(v, 4); v += __shfl_xor(v, 8); v += __shfl_xor(v, 16); v += __shfl_xor(v, 32); return v;
}
__device__ __forceinline__ float sum8(float v) { v += __shfl_xor(v, 1); v += __shfl_xor(v, 2); v += __shfl_xor(v, 4); return v; }
template <int CTRL> __device__ __forceinline__ float dppf(float x) { return __int_as_float(__builtin_amdgcn_update_dpp(0, __float_as_int(x), CTRL, 0xF, 0xF, true)); }
__device__ __forceinline__ float dsum8(float v) { v += dppf<0xB1>(v); v += dppf<0x4E>(v); v += dppf<0x141>(v); return v; }

struct EpiIn {
    static constexpr bool PERM = true, AFTER_DRAIN = false;
    bf16_t* pa; bf16_t* pbc; bf16_t* gate; const LAS float* rsl;
    __device__ __forceinline__ void operator()(const f32x4 (&acc)[2][2][4][2], const pg8::Unit& u, int wr, int wc, int fr_, int fq_) const {
        int fr = fr_, fq = fq_; asm volatile("" : "+v"(fr), "+v"(fq));
        const int row0 = u.pm * 256 + wr * 64 + fr;
#pragma unroll
        for (int ai = 0; ai < 2; ++ai)
#pragma unroll
            for (int m = 0; m < 4; ++m) {
                const int row = row0 + ai * 128 + m * 16;
                const float rs = rsl[row & 255];
#pragma unroll
                for (int bj = 0; bj < 2; ++bj) {
                    const int c128 = u.pn * 2 + bj;
                    const int col = c128 * 128 + wc * 32 + 8 * fq;
                    f32x4 v0 = acc[ai][bj][m][0] * rs, v1 = acc[ai][bj][m][1] * rs;
                    bf16_t* dst;
                    if (c128 < 10) dst = pa + (size_t)row * PA_W + col;
                    else if (c128 < 25) dst = pbc + (size_t)row * PBC_W + (col - 1280);
                    else if (c128 < 33) {
                        dst = gate + (size_t)row * 1024 + (col - 3200);
#pragma unroll
                        for (int j = 0; j < 4; ++j) { v0[j] = v0[j] * __builtin_amdgcn_rcpf(1.0f + __expf(-v0[j])); v1[j] = v1[j] * __builtin_amdgcn_rcpf(1.0f + __expf(-v1[j])); }
                    } else continue;
                    u32x4 w; w.x = pk2(v0[0], v0[1]); w.y = pk2(v0[2], v0[3]); w.z = pk2(v1[0], v1[1]); w.w = pk2(v1[2], v1[3]);
                    *(u32x4*)dst = w;
                }
            }
    }
};
struct EpiOut {
    static constexpr bool PERM = true, AFTER_DRAIN = false;
    float* out; bf16_t* xb; float* ssq; int last;
    __device__ __forceinline__ void operator()(const f32x4 (&acc)[2][2][4][2], const pg8::Unit& u, int wr, int wc, int fr_, int fq_) const {
        int fr = fr_, fq = fq_; asm volatile("" : "+v"(fr), "+v"(fq));
        const int row0 = u.pm * 256 + wr * 64 + fr;
#pragma unroll
        for (int ai = 0; ai < 2; ++ai)
#pragma unroll
            for (int m = 0; m < 4; ++m) {
                const int row = row0 + ai * 128 + m * 16;
                float sq = 0.f;
#pragma unroll
                for (int bj = 0; bj < 2; ++bj) {
                    const int col = u.pn * 256 + bj * 128 + wc * 32 + 8 * fq;
                    const size_t off = (size_t)row * 1024 + col;
                    const u32x4 r = *(const u32x4*)(xb + off);
                    const f32x4 v0 = acc[ai][bj][m][0] + (f32x4){bflo(r.x), bfhi(r.x), bflo(r.y), bfhi(r.y)}, v1 = acc[ai][bj][m][1] + (f32x4){bflo(r.z), bfhi(r.z), bflo(r.w), bfhi(r.w)};
                    if (last) { *(f32x4*)(out + off) = v0; *(f32x4*)(out + off + 4) = v1; }
                    else {
                        u32x4 w; w.x = pk2(v0[0], v0[1]); w.y = pk2(v0[2], v0[3]); w.z = pk2(v1[0], v1[1]); w.w = pk2(v1[2], v1[3]);
                        *(u32x4*)(xb + off) = w;
                        sq += (v0[0] * v0[0] + v0[1] * v0[1]) + (v0[2] * v0[2] + v0[3] * v0[3]) + (v1[0] * v1[0] + v1[1] * v1[1]) + (v1[2] * v1[2] + v1[3] * v1[3]);
                    }
                }
                if (!last) {
                    sq += __shfl_xor(sq, 16); sq += __shfl_xor(sq, 32);
                    if (fq == 0) ssq[(size_t)row * 16 + u.pn * 4 + wc] = sq;
                }
            }
    }
};

__device__ __forceinline__ void convert_tile(const float* __restrict__ W, int N, int Nvalid, const float* __restrict__ g, bf16_t* __restrict__ Wt, int tk, int tn, LAS unsigned char* lds) {
    LAS float* tl = (LAS float*)lds;
    const int tid = tidx(), r = tid >> 3, c8 = (tid & 7) * 8, n0 = tn * 64, k0 = tk * 64;
    __syncthreads();
    if (n0 < Nvalid) {
        const float* src = W + (size_t)(k0 + r) * N + n0 + c8;
        const f32x4 a = *(const f32x4*)src, b = *(const f32x4*)(src + 4);
        const float gs = g ? g[k0 + r] : 1.0f;
#pragma unroll
        for (int j = 0; j < 4; ++j) { tl[r * 65 + c8 + j] = a[j] * gs; tl[r * 65 + c8 + 4 + j] = b[j] * gs; }
    }
    __syncthreads();
    u32x4 w = {0u, 0u, 0u, 0u};
    if (n0 < Nvalid) {
        float v[8];
#pragma unroll
        for (int j = 0; j < 8; ++j) v[j] = tl[(c8 + j) * 65 + r];
        w.x = pk2(v[0], v[1]); w.y = pk2(v[2], v[3]); w.z = pk2(v[4], v[5]); w.w = pk2(v[6], v[7]);
    }
    *(u32x4*)(Wt + (size_t)(n0 + r) * 1024 + k0 + c8) = w;
}

__device__ __forceinline__ void convert_strip4(const float* __restrict__ W, int N, int Nvalid, const float* __restrict__ g, bf16_t* __restrict__ Wt, int tk0, int tn, LAS unsigned char* lds) {
    LAS float* tl = (LAS float*)lds;
    const int tid = tidx(), r = tid >> 3, c8 = (tid & 7) * 8, n0 = tn * 64;
    const bool valid = n0 < Nvalid;
    __syncthreads();
    if (valid) {
        f32x4 a[4], b[4]; float gs[4];
#pragma unroll
        for (int i = 0; i < 4; ++i) {
            const float* src = W + (size_t)((tk0 + i) * 64 + r) * N + n0 + c8;
            a[i] = *(const f32x4*)src; b[i] = *(const f32x4*)(src + 4);
            gs[i] = g ? g[(tk0 + i) * 64 + r] : 1.0f;
        }
#pragma unroll
        for (int i = 0; i < 4; ++i)
#pragma unroll
            for (int j = 0; j < 4; ++j) { tl[i * 4160 + r * 65 + c8 + j] = a[i][j] * gs[i]; tl[i * 4160 + r * 65 + c8 + 4 + j] = b[i][j] * gs[i]; }
    }
    __syncthreads();
#pragma unroll
    for (int i = 0; i < 4; ++i) {
        u32x4 w = {0u, 0u, 0u, 0u};
        if (valid) {
            float v[8];
#pragma unroll
            for (int j = 0; j < 8; ++j) v[j] = tl[i * 4160 + (c8 + j) * 65 + r];
            w.x = pk2(v[0], v[1]); w.y = pk2(v[2], v[3]); w.z = pk2(v[4], v[5]); w.w = pk2(v[6], v[7]);
        }
        *(u32x4*)(Wt + (size_t)(n0 + r) * 1024 + (tk0 + i) * 64 + c8) = w;
    }
}

__device__ __forceinline__ void phase_prologue(const Params& p, LAS unsigned char* lds) {
    const int tid = tidx(), wave = tid >> 6, lane = tid & 63;
    const float* x = p.in[I_X];
    bf16_t* xb = (bf16_t*)(p.ws + WS_XB); float* ssq = (float*)(p.ws + WS_SSQ);
    for (int row = blockIdx.x * 8 + wave; row < T_TOK; row += gridDim.x * 8) {
        const float* xr = x + (size_t)row * 1024;
        float s = 0.f;
#pragma unroll
        for (int i = 0; i < 4; ++i) {
            const f32x4 v = *(const f32x4*)(xr + i * 256 + lane * 4);
            s += (v[0] * v[0] + v[1] * v[1]) + (v[2] * v[2] + v[3] * v[3]);
            u32x2 w; w.x = pk2(v[0], v[1]); w.y = pk2(v[2], v[3]);
            *(u32x2*)(xb + (size_t)row * 1024 + i * 256 + lane * 4) = w;
        }
        s = wsum64(s);
        if (lane < 16) ssq[(size_t)row * 16 + lane] = (lane == 0) ? s : 0.f;
    }
    bf16_t* wint = (bf16_t*)(p.ws + WS_WIN);
    for (int t = blockIdx.x; t < 4 * 68; t += gridDim.x) convert_strip4(p.in[I_WIN], 4224, 4224, p.in[I_NORMG], wint, (t & 3) * 4, t >> 2, lds);
}

constexpr int KS_PITCH = 144;
constexpr int VT_PITCH = 144;
constexpr int AT_BUF = 64 * KS_PITCH + 64 * VT_PITCH;
constexpr int AT_KM = 2 * AT_BUF, AT_SEL = AT_KM + 4096, AT_ANY = AT_SEL + 512;
struct AttnOut { f32x4 o[4]; float m, l; };
constexpr size_t DO_LIST = (size_t)26 << 20;
constexpr size_t DO_PB = (size_t)28 << 20;
constexpr size_t DO_PL = (size_t)53 << 20;

template <class TK>
__device__ __forceinline__ void attn_core(const TK& tk, const bf16_t* __restrict__ qbase, const bf16_t* __restrict__ kbase, const bf16_t* __restrict__ vbase,
                                          const float* __restrict__ qg, const float* __restrict__ kg, LAS unsigned char* lds, AttnOut& R) {
    const int tid = tidx(), wave = tid >> 6, lane = tid & 63, qi = lane & 15, g = lane >> 4;
    const int mq = wave * 16 + qi;
    bf16x8 bq[2];
    const int kr = tid >> 3, pc = tid & 7;
    float kgv[8];
#pragma unroll
    for (int j = 0; j < 8; ++j) kgv[j] = kg[pc * 8 + j];
#pragma unroll
    for (int mo = 0; mo < 4; ++mo) R.o[mo] = (f32x4){0.f, 0.f, 0.f, 0.f};
    float l_run = 0.f;
    const int nt = tk.ntiles();
    auto next_on = [&](int j) { int jn = j + 1; while (jn < nt && !tk.tile_on(jn)) ++jn; return jn; };
    auto load_t = [&](int jj, u32x4& kreg, u32x4& vreg) {
        kreg = *(const u32x4*)(kbase + (size_t)tk.k_tok(jj, kr) * PBC_W + pc * 8);
        vreg = *(const u32x4*)(vbase + (size_t)tk.k_tok(jj, kr) * PBC_W + pc * 8);
    };
    auto store_t = [&](int buf, const u32x4& kreg, const u32x4& vreg) {
        LAS unsigned char* B = lds + buf * AT_BUF;
        float kf[8];
#pragma unroll
        for (int q = 0; q < 4; ++q) { kf[2 * q] = bflo(kreg[q]); kf[2 * q + 1] = bfhi(kreg[q]); }
        float ss = 0.f;
#pragma unroll
        for (int q = 0; q < 8; ++q) ss += kf[q] * kf[q];
        ss = dsum8(ss);
        const float ks = rsqrtf(ss * (1.0f / 64.0f) + 1e-6f);
        u32x4 w; w.x = pk2(kf[0] * ks * kgv[0], kf[1] * ks * kgv[1]); w.y = pk2(kf[2] * ks * kgv[2], kf[3] * ks * kgv[3]);
        w.z = pk2(kf[4] * ks * kgv[4], kf[5] * ks * kgv[5]); w.w = pk2(kf[6] * ks * kgv[6], kf[7] * ks * kgv[7]);
        *(LAS u32x4*)(B + kr * KS_PITCH + pc * 16) = w;
        *(LAS u32x4*)(B + 64 * KS_PITCH + kr * VT_PITCH + pc * 16) = vreg;
    };
    auto compute_t = [&](int buf, int j) {
        if (!tk.wave_on(wave, j)) return;
        const LAS unsigned char* B = lds + buf * AT_BUF;
        f32x4 st[4];
#pragma unroll
        for (int mt = 0; mt < 4; ++mt) {
            st[mt] = (f32x4){0.f, 0.f, 0.f, 0.f};
#pragma unroll
            for (int ks = 0; ks < 2; ++ks) {
                const bf16x8 a = *(const LAS bf16x8*)(B + (mt * 16 + qi) * KS_PITCH + ks * 64 + g * 16);
                st[mt] = __builtin_amdgcn_mfma_f32_16x16x32_bf16(a, bq[ks], st[mt], 0, 0, 0);
            }
        }
        float ps = 0.f;
#pragma unroll
        for (int mt = 0; mt < 4; ++mt)
#pragma unroll
            for (int i = 0; i < 4; ++i) {
                const float pv = tk.mask(mq, j, mt * 16 + g * 4 + i) ? __builtin_amdgcn_exp2f(st[mt][i]) : 0.f;
                st[mt][i] = pv; ps += pv;
            }
        l_run += ps;
#pragma unroll
        for (int ks = 0; ks < 2; ++ks) {
            u32x4 pbw; pbw.x = pk2(st[2 * ks][0], st[2 * ks][1]); pbw.y = pk2(st[2 * ks][2], st[2 * ks][3]); pbw.z = pk2(st[2 * ks + 1][0], st[2 * ks + 1][1]); pbw.w = pk2(st[2 * ks + 1][2], st[2 * ks + 1][3]);
            const bf16x8 pb = __builtin_bit_cast(bf16x8, pbw);
#pragma unroll
            for (int mo = 0; mo < 4; ++mo) {
                const LAS unsigned char* vp = B + 64 * KS_PITCH + (ks * 32 + 4 * g + (qi >> 2)) * VT_PITCH + (mo * 16 + 4 * (qi & 3)) * 2;
                const s16x4 lo = __builtin_amdgcn_ds_read_tr16_b64_v4i16((LAS s16x4*)vp), hi = __builtin_amdgcn_ds_read_tr16_b64_v4i16((LAS s16x4*)(vp + 16 * VT_PITCH));
                bf16x8 av; av[0] = lo[0]; av[1] = lo[1]; av[2] = lo[2]; av[3] = lo[3]; av[4] = hi[0]; av[5] = hi[1]; av[6] = hi[2]; av[7] = hi[3];
                R.o[mo] = __builtin_amdgcn_mfma_f32_16x16x32_bf16(av, pb, R.o[mo], 0, 0, 0);
            }
        }
    };
    int j0 = -1; j0 = next_on(j0);
    int j1 = (j0 < nt) ? next_on(j0) : nt, j2 = (j1 < nt) ? next_on(j1) : nt;
    u32x4 kA = {0u, 0u, 0u, 0u}, vA = kA, kB = kA, vB = kA;
    if (j0 < nt) load_t(j0, kA, vA);
    if (j1 < nt) load_t(j1, kB, vB);
    {
        const bf16_t* qp = qbase + (size_t)tk.q_tok(mq) * PBC_W;
        const u32x4 r0 = *(const u32x4*)(qp + g * 8), r1 = *(const u32x4*)(qp + 32 + g * 8);
        float qf[16];
#pragma unroll
        for (int j = 0; j < 4; ++j) { qf[2 * j] = bflo(r0[j]); qf[2 * j + 1] = bfhi(r0[j]); qf[8 + 2 * j] = bflo(r1[j]); qf[8 + 2 * j + 1] = bfhi(r1[j]); }
        float ss = 0.f;
#pragma unroll
        for (int j = 0; j < 16; ++j) ss += qf[j] * qf[j];
        ss += __shfl_xor(ss, 16); ss += __shfl_xor(ss, 32);
        const float qs = rsqrtf(ss * (1.0f / 64.0f) + 1e-6f) * (0.125f * 1.4426950408889634f);
        u32x4 b0, b1;
#pragma unroll
        for (int j = 0; j < 4; ++j) {
            b0[j] = pk2(qf[2 * j] * qs * qg[g * 8 + 2 * j], qf[2 * j + 1] * qs * qg[g * 8 + 2 * j + 1]);
            b1[j] = pk2(qf[8 + 2 * j] * qs * qg[32 + g * 8 + 2 * j], qf[8 + 2 * j + 1] * qs * qg[32 + g * 8 + 2 * j + 1]);
        }
        bq[0] = __builtin_bit_cast(bf16x8, b0); bq[1] = __builtin_bit_cast(bf16x8, b1);
    }
    __syncthreads();
    if (j0 < nt) store_t(0, kA, vA);
    if (j2 < nt) load_t(j2, kA, vA);
    __syncthreads();
    while (j0 < nt) {
        compute_t(0, j0);
        int j3 = (j2 < nt) ? next_on(j2) : nt;
        if (j1 < nt) store_t(1, kB, vB);
        if (j3 < nt) load_t(j3, kB, vB);
        __syncthreads();
        j0 = j1; j1 = j2; j2 = j3;
        if (j0 >= nt) break;
        compute_t(1, j0);
        j3 = (j2 < nt) ? next_on(j2) : nt;
        if (j1 < nt) store_t(0, kA, vA);
        if (j3 < nt) load_t(j3, kA, vA);
        __syncthreads();
        j0 = j1; j1 = j2; j2 = j3;
    }
    l_run += __shfl_xor(l_run, 16); l_run += __shfl_xor(l_run, 32);
    R.m = 0.f; R.l = l_run;
}

struct DilTask {
    int tokbase, d, rho, c;
    __device__ __forceinline__ int q_tok(int m) const { return tokbase + (c * 128 + m) * d + rho; }
    __device__ __forceinline__ int ntiles() const { return 4; }
    __device__ __forceinline__ bool tile_on(int j) const { return !(c == 0 && j < 2); }
    __device__ __forceinline__ int k_tok(int j, int n) const { return tokbase + ((c - 1) * 128 + j * 64 + n) * d + rho; }
    __device__ __forceinline__ bool mask(int m, int j, int n) const { const int diff = 128 + m - j * 64 - n; return diff >= 0 && diff <= 128; }
    __device__ __forceinline__ bool wave_on(int w, int j) const { return (w < 4) ? (j < 3) : (j > 0); }
};
__device__ __forceinline__ void dil_epilogue(const Params& p, int gi, int hC, int tok, int g, const f32x4 (&o)[4], float lsum) {
    const float inv = 1.0f / lsum;
    const float L = __builtin_amdgcn_logf(lsum);
    bf16_t* dilo = (bf16_t*)p.out; float* dill = (float*)((unsigned char*)p.out + (size_t)2 * T_TOK * 384 * 2);
    if (gi < 2) {
#pragma unroll
        for (int mo = 0; mo < 4; ++mo) {
            u32x2 w; w.x = pk2(o[mo][0] * inv, o[mo][1] * inv); w.y = pk2(o[mo][2] * inv, o[mo][3] * inv);
            *(u32x2*)(dilo + ((size_t)gi * T_TOK + tok) * 384 + hC * 64 + mo * 16 + g * 4) = w;
        }
        if (g == 0) dill[((size_t)gi * T_TOK + tok) * 6 + hC] = L;
    } else {
        const float L0 = dill[(size_t)tok * 6 + hC], L1 = dill[((size_t)T_TOK + tok) * 6 + hC];
        const float M = fmaxf(L, fmaxf(L0, L1));
        const float w0 = __builtin_amdgcn_exp2f(L0 - M), w1 = __builtin_amdgcn_exp2f(L1 - M), w2 = __builtin_amdgcn_exp2f(L - M);
        const float wi = 1.0f / (w0 + w1 + w2);
        const float a0 = w0 * wi, a1 = w1 * wi, a2 = w2 * wi * inv;
        const bf16_t* sg = (const bf16_t*)(p.ws + WS_GATE) + (size_t)tok * 1024 + 640 + hC * 64;
        bf16_t* yg = (bf16_t*)(p.ws + WS_YG) + (size_t)tok * 1024 + 640 + hC * 64;
#pragma unroll
        for (int mo = 0; mo < 4; ++mo) {
            const int dh = mo * 16 + g * 4;
            const u32x2 o0 = *(const u32x2*)(dilo + (size_t)tok * 384 + hC * 64 + dh), o1 = *(const u32x2*)(dilo + ((size_t)T_TOK + tok) * 384 + hC * 64 + dh);
            const u32x2 gt = *(const u32x2*)(sg + dh);
            const float y0 = a0 * bflo(o0.x) + a1 * bflo(o1.x) + a2 * o[mo][0];
            const float y1 = a0 * bfhi(o0.x) + a1 * bfhi(o1.x) + a2 * o[mo][1];
            const float y2 = a0 * bflo(o0.y) + a1 * bflo(o1.y) + a2 * o[mo][2];
            const float y3 = a0 * bfhi(o0.y) + a1 * bfhi(o1.y) + a2 * o[mo][3];
            u32x2 w; w.x = pk2(y0 * bflo(gt.x), y1 * bfhi(gt.x)); w.y = pk2(y2 * bflo(gt.y), y3 * bfhi(gt.y));
            *(u32x2*)(yg + dh) = w;
        }
    }
}
__device__ __forceinline__ void dil_run(const Params& p, int l, int gi, int r, LAS unsigned char* lds) {
    const int d = (gi == 0) ? 1 : (gi == 1 ? 4 : 16), npair = 16 / d;
    const int b = r / 96, r2 = r % 96, hC = r2 / 16, r3 = r2 % 16, rho = r3 / npair, cp = r3 % npair;
    const int tid = tidx(), wave = tid >> 6, lane = tid & 63, qi = lane & 15, g = lane >> 4;
    const int kr = tid >> 3, pc = tid & 7, m = wave * 16 + qi;
    const bf16_t* pbc = (const bf16_t*)(p.ws + WS_PBC);
    const bf16_t* qbase = pbc + 768 + hC * 64; const bf16_t* kbase = pbc + 1152 + hC * 64; const bf16_t* vbase = pbc + 1536 + hC * 64;
    const float* qg = p.in[I_DQG] + l * 64; const float* kg = p.in[I_DKG] + l * 64;
    const int tokbase = b * SEQ, ksub0 = (2 * cp - 1) * 128;
    const int jt0 = (cp == 0) ? 2 : 0;
    u32x4 qr[2][2]; int qtok[2];
#pragma unroll
    for (int qb = 0; qb < 2; ++qb) {
        qtok[qb] = tokbase + ((2 * cp + qb) * 128 + m) * d + rho;
        qr[qb][0] = *(const u32x4*)(qbase + (size_t)qtok[qb] * PBC_W + g * 8); qr[qb][1] = *(const u32x4*)(qbase + (size_t)qtok[qb] * PBC_W + 32 + g * 8);
    }
    u32x4 kreg[6], vreg[6];
#pragma unroll
    for (int jt = 0; jt < 6; ++jt) {
        kreg[jt] = (u32x4){0u, 0u, 0u, 0u}; vreg[jt] = (u32x4){0u, 0u, 0u, 0u};
        if (jt >= jt0) {
            const size_t ktok = (size_t)(tokbase + (ksub0 + jt * 64 + kr) * d + rho);
            kreg[jt] = *(const u32x4*)(kbase + ktok * PBC_W + pc * 8); vreg[jt] = *(const u32x4*)(vbase + ktok * PBC_W + pc * 8);
        }
    }
    float kgv[8];
#pragma unroll
    for (int j = 0; j < 8; ++j) kgv[j] = kg[pc * 8 + j];
    __syncthreads();
#pragma unroll
    for (int jt = 0; jt < 6; ++jt) {
        if (jt >= jt0) {
            LAS unsigned char* B = lds + jt * AT_BUF;
            float kf[8];
#pragma unroll
            for (int q = 0; q < 4; ++q) { kf[2 * q] = bflo(kreg[jt][q]); kf[2 * q + 1] = bfhi(kreg[jt][q]); }
            float ss = 0.f;
#pragma unroll
            for (int q = 0; q < 8; ++q) ss += kf[q] * kf[q];
            ss = dsum8(ss);
            const float ks = rsqrtf(ss * (1.0f / 64.0f) + 1e-6f);
            u32x4 w; w.x = pk2(kf[0] * ks * kgv[0], kf[1] * ks * kgv[1]); w.y = pk2(kf[2] * ks * kgv[2], kf[3] * ks * kgv[3]);
            w.z = pk2(kf[4] * ks * kgv[4], kf[5] * ks * kgv[5]); w.w = pk2(kf[6] * ks * kgv[6], kf[7] * ks * kgv[7]);
            *(LAS u32x4*)(B + kr * KS_PITCH + pc * 16) = w;
            *(LAS u32x4*)(B + 64 * KS_PITCH + kr * VT_PITCH + pc * 16) = vreg[jt];
        }
    }
    __syncthreads();
#pragma unroll
    for (int qb = 0; qb < 2; ++qb) {
        bf16x8 bq[2];
        {
            float qf[16];
#pragma unroll
            for (int j = 0; j < 4; ++j) { qf[2 * j] = bflo(qr[qb][0][j]); qf[2 * j + 1] = bfhi(qr[qb][0][j]); qf[8 + 2 * j] = bflo(qr[qb][1][j]); qf[8 + 2 * j + 1] = bfhi(qr[qb][1][j]); }
            float ss = 0.f;
#pragma unroll
            for (int j = 0; j < 16; ++j) ss += qf[j] * qf[j];
            ss += __shfl_xor(ss, 16); ss += __shfl_xor(ss, 32);
            const float qs = rsqrtf(ss * (1.0f / 64.0f) + 1e-6f) * (0.125f * 1.4426950408889634f);
            u32x4 b0, b1;
#pragma unroll
            for (int j = 0; j < 4; ++j) {
                b0[j] = pk2(qf[2 * j] * qs * qg[g * 8 + 2 * j], qf[2 * j + 1] * qs * qg[g * 8 + 2 * j + 1]);
                b1[j] = pk2(qf[8 + 2 * j] * qs * qg[32 + g * 8 + 2 * j], qf[8 + 2 * j + 1] * qs * qg[32 + g * 8 + 2 * j + 1]);
            }
            bq[0] = __builtin_bit_cast(bf16x8, b0); bq[1] = __builtin_bit_cast(bf16x8, b1);
        }
        f32x4 o[4];
#pragma unroll
        for (int mo = 0; mo < 4; ++mo) o[mo] = (f32x4){0.f, 0.f, 0.f, 0.f};
        float l_run = 0.f;
#pragma unroll 2
        for (int j = 0; j < 4; ++j) {
            if (2 * qb + j < jt0 || !((wave < 4) ? (j < 3) : (j > 0))) continue;
            const LAS unsigned char* B = lds + (2 * qb + j) * AT_BUF;
            f32x4 st[4];
#pragma unroll
            for (int mt = 0; mt < 4; ++mt) {
                st[mt] = (f32x4){0.f, 0.f, 0.f, 0.f};
#pragma unroll
                for (int ks = 0; ks < 2; ++ks) {
                    const bf16x8 a = *(const LAS bf16x8*)(B + (mt * 16 + qi) * KS_PITCH + ks * 64 + g * 16);
                    st[mt] = __builtin_amdgcn_mfma_f32_16x16x32_bf16(a, bq[ks], st[mt], 0, 0, 0);
                }
            }
            float ps = 0.f;
#pragma unroll
            for (int mt = 0; mt < 4; ++mt)
#pragma unroll
                for (int ii = 0; ii < 4; ++ii) {
                    const int diff = 128 + m - j * 64 - (mt * 16 + g * 4 + ii);
                    const float pv = (diff >= 0 && diff <= 128) ? __builtin_amdgcn_exp2f(st[mt][ii]) : 0.f;
                    st[mt][ii] = pv; ps += pv;
                }
            l_run += ps;
#pragma unroll
            for (int ks = 0; ks < 2; ++ks) {
                u32x4 pbw; pbw.x = pk2(st[2 * ks][0], st[2 * ks][1]); pbw.y = pk2(st[2 * ks][2], st[2 * ks][3]); pbw.z = pk2(st[2 * ks + 1][0], st[2 * ks + 1][1]); pbw.w = pk2(st[2 * ks + 1][2], st[2 * ks + 1][3]);
                const bf16x8 pb = __builtin_bit_cast(bf16x8, pbw);
#pragma unroll
                for (int mo = 0; mo < 4; ++mo) {
                    const LAS unsigned char* vp = B + 64 * KS_PITCH + (ks * 32 + 4 * g + (qi >> 2)) * VT_PITCH + (mo * 16 + 4 * (qi & 3)) * 2;
                    const s16x4 lo = __builtin_amdgcn_ds_read_tr16_b64_v4i16((LAS s16x4*)vp), hi = __builtin_amdgcn_ds_read_tr16_b64_v4i16((LAS s16x4*)(vp + 16 * VT_PITCH));
                    bf16x8 av; av[0] = lo[0]; av[1] = lo[1]; av[2] = lo[2]; av[3] = lo[3]; av[4] = hi[0]; av[5] = hi[1]; av[6] = hi[2]; av[7] = hi[3];
                    o[mo] = __builtin_amdgcn_mfma_f32_16x16x32_bf16(av, pb, o[mo], 0, 0, 0);
                }
            }
        }
        l_run += __shfl_xor(l_run, 16); l_run += __shfl_xor(l_run, 32);
        dil_epilogue(p, gi, hC, qtok[qb], g, o, l_run);
    }
}

struct MobaTask {
    int tokbase, q0, b_own, nown; unsigned anysel, mysel;
    __device__ __forceinline__ int q_tok(int m) const { return tokbase + q0 + m; }
    __device__ __forceinline__ int ntiles() const { return 4 * (b_own + 1); }
    __device__ __forceinline__ bool tile_on(int j) const { return (j < 4) ? (j < nown) : (((anysel >> ((j >> 2) - 1)) & 1u) != 0u); }
    __device__ __forceinline__ int k_tok(int j, int n) const { const int blk = (j < 4) ? b_own : ((j >> 2) - 1); return tokbase + blk * 256 + (j & 3) * 64 + n; }
    __device__ __forceinline__ bool mask(int m, int j, int n) const {
        return (j < 4) ? (b_own * 256 + j * 64 + n <= q0 + m) : (((mysel >> ((j >> 2) - 1)) & 1u) != 0u);
    }
    __device__ __forceinline__ bool wave_on(int w, int j) const { return (j < 4) ? (b_own * 256 + j * 64 <= q0 + w * 16 + 15) : true; }
};
__device__ __forceinline__ void moba_route_task(const Params& p, int l, int task, LAS unsigned char* lds) {
    const int b = task >> 6, hB = (task >> 4) & 3, b_own = task & 15;
    if (b_own == 0) return;
    const int tid = tidx();
    const int bh16 = b * 4 + hB;
    const bf16_t* pbc = (const bf16_t*)(p.ws + WS_PBC);
    const float* kmean = (const float*)(p.ws + WS_KMEAN) + (size_t)bh16 * 1024;
    LAS float* km = (LAS float*)(lds + AT_KM);
    const int q = tid >> 1, part = tid & 1;
    const bf16_t* qp = pbc + (size_t)(b * SEQ + b_own * 256 + q) * PBC_W + hB * 64 + part * 32;
    const u32x4 r0 = *(const u32x4*)qp, r1 = *(const u32x4*)(qp + 8), r2 = *(const u32x4*)(qp + 16), r3 = *(const u32x4*)(qp + 24);
    __syncthreads();
    if (threadIdx.x == 0) {
        const unsigned* kc = (const unsigned*)(p.ws + WS_KMC) + bh16; unsigned spins = 0;
        while (__hip_atomic_load(kc, __ATOMIC_RELAXED, __HIP_MEMORY_SCOPE_AGENT) < 16u * (unsigned)(l + 1)) { __builtin_amdgcn_s_sleep(2); if (++spins > (1u << 22)) break; }
        __builtin_amdgcn_fence(__ATOMIC_ACQUIRE, "agent");
        asm volatile("s_waitcnt vmcnt(0)" ::: "memory");
    }
    __syncthreads();
    for (int i = tid; i < 1024; i += NTHR) km[i] = kmean[i];
    __syncthreads();
    float qf[32];
#pragma unroll
    for (int j = 0; j < 4; ++j) {
        qf[2 * j] = bflo(r0[j]); qf[2 * j + 1] = bfhi(r0[j]); qf[8 + 2 * j] = bflo(r1[j]); qf[8 + 2 * j + 1] = bfhi(r1[j]);
        qf[16 + 2 * j] = bflo(r2[j]); qf[16 + 2 * j + 1] = bfhi(r2[j]); qf[24 + 2 * j] = bflo(r3[j]); qf[24 + 2 * j + 1] = bfhi(r3[j]);
    }
    float ss = 0.f;
#pragma unroll
    for (int j = 0; j < 32; ++j) ss += qf[j] * qf[j];
    ss += __shfl_xor(ss, 1);
    const float qs = rsqrtf(ss * (1.0f / 64.0f) + 1e-6f);
    const float* qg = p.in[I_MQG] + l * 64 + part * 32;
#pragma unroll
    for (int j = 0; j < 32; ++j) qf[j] *= qs * qg[j];
    float v1 = -INFINITY, v2 = -INFINITY, v3 = -INFINITY; int i1 = -1, i2 = -1, i3 = -1;
    for (int n = 0; n < b_own; ++n) {
        float sc = 0.f;
#pragma unroll
        for (int j = 0; j < 32; ++j) sc += qf[j] * km[n * 64 + part * 32 + j];
        sc += __shfl_xor(sc, 1);
        if (sc > v1) { v3 = v2; i3 = i2; v2 = v1; i2 = i1; v1 = sc; i1 = n; }
        else if (sc > v2) { v3 = v2; i3 = i2; v2 = sc; i2 = n; }
        else if (sc > v3) { v3 = sc; i3 = n; }
    }
    LAS unsigned* lcnt = (LAS unsigned*)(lds + AT_SEL); LAS unsigned* lbase = lcnt + 16;
    if (tid < 16) lcnt[tid] = 0u;
    __syncthreads();
    unsigned rk1 = 0u, rk2 = 0u, rk3 = 0u;
    if (part == 0) {
        if (i1 >= 0) rk1 = atomicAdd((unsigned*)(lcnt + i1), 1u);
        if (i2 >= 0) rk2 = atomicAdd((unsigned*)(lcnt + i2), 1u);
        if (i3 >= 0) rk3 = atomicAdd((unsigned*)(lcnt + i3), 1u);
    }
    __syncthreads();
    if (tid < 16) { const unsigned c = lcnt[tid]; lbase[tid] = c ? __hip_atomic_fetch_add((unsigned*)(p.ws + WS_CNT) + (l * 16 + bh16) * 16 + tid, c, __ATOMIC_RELAXED, __HIP_MEMORY_SCOPE_AGENT) : 0u; }
    __syncthreads();
    if (part == 0) {
        unsigned short* list = (unsigned short*)((unsigned char*)p.out + DO_LIST) + (size_t)bh16 * 16 * 4096;
        const unsigned qpos = (unsigned)(b_own * 256 + q);
        if (i1 >= 0) list[(size_t)i1 * 4096 + lbase[i1] + rk1] = (unsigned short)(qpos | (0u << 12));
        if (i2 >= 0) list[(size_t)i2 * 4096 + lbase[i2] + rk2] = (unsigned short)(qpos | (1u << 12));
        if (i3 >= 0) list[(size_t)i3 * 4096 + lbase[i3] + rk3] = (unsigned short)(qpos | (2u << 12));
    }
}

struct GatherTask {
    int tokbase, keytok, nvalid; unsigned mye;
    __device__ __forceinline__ int q_tok(int) const { return tokbase + (int)(mye & 0xFFFu); }
    __device__ __forceinline__ int ntiles() const { return 4; }
    __device__ __forceinline__ bool tile_on(int) const { return true; }
    __device__ __forceinline__ int k_tok(int j, int n) const { return keytok + j * 64 + n; }
    __device__ __forceinline__ bool mask(int, int, int) const { return true; }
    __device__ __forceinline__ bool wave_on(int w, int) const { return w * 16 < nvalid; }
};
__device__ __forceinline__ unsigned moba_gather_entry(const Params& p, int bh16, int n, int i, int count) {
    const int tid = tidx(), m = (tid >> 6) * 16 + (tid & 15);
    const int nvalid = (count - i * 128 < 128) ? (count - i * 128) : 128;
    const unsigned short* ent = (const unsigned short*)((const unsigned char*)p.out + DO_LIST) + ((size_t)bh16 * 16 + n) * 4096 + (size_t)i * 128;
    return ent[m < nvalid ? m : nvalid - 1];
}
__device__ __forceinline__ void moba_gather_task(const Params& p, int l, int bh16, int n, int i, int count, unsigned mye, LAS unsigned char* lds) {
    const int b = bh16 >> 2, hB = bh16 & 3;
    const int tid = tidx(), wave = tid >> 6, lane = tid & 63, qi = lane & 15, g = lane >> 4;
    const bf16_t* pbc = (const bf16_t*)(p.ws + WS_PBC);
    GatherTask tk; tk.tokbase = b * SEQ; tk.keytok = b * SEQ + n * 256; tk.nvalid = (count - i * 128 < 128) ? (count - i * 128) : 128; tk.mye = mye;
    AttnOut R;
    attn_core(tk, pbc + hB * 64, pbc + 256 + hB * 64, pbc + 512 + hB * 64, p.in[I_MQG] + l * 64, p.in[I_MKG] + l * 64, lds, R);
    const int m = wave * 16 + qi;
    if (m < tk.nvalid) {
        const unsigned e = tk.mye;
        const size_t row = ((size_t)(tk.tokbase + (int)(e & 0xFFFu)) * 4 + hB) * 3 + (e >> 12);
        const float inv = 1.0f / R.l;
        bf16_t* pb = (bf16_t*)((unsigned char*)p.out + DO_PB) + row * 64;
#pragma unroll
        for (int mo = 0; mo < 4; ++mo) {
            u32x2 w; w.x = pk2(R.o[mo][0] * inv, R.o[mo][1] * inv); w.y = pk2(R.o[mo][2] * inv, R.o[mo][3] * inv);
            *(u32x2*)(pb + mo * 16 + g * 4) = w;
        }
        if (g == 0) ((float*)((unsigned char*)p.out + DO_PL))[row] = R.l;
    }
}

__device__ __forceinline__ void moba_gather_run(const Params& p, int l, int e, int i0, int i1, int count, LAS unsigned char* lds) {
    const int bh16 = e >> 4, n = e & 15, b = bh16 >> 2, hB = bh16 & 3;
    const int tid = tidx(), wave = tid >> 6, lane = tid & 63, qi = lane & 15, g = lane >> 4;
    const int kr = tid >> 3, pc = tid & 7, m = wave * 16 + qi;
    const bf16_t* pbc = (const bf16_t*)(p.ws + WS_PBC);
    const bf16_t* qbase = pbc + hB * 64; const bf16_t* kbase = pbc + 256 + hB * 64; const bf16_t* vbase = pbc + 512 + hB * 64;
    const float* qg = p.in[I_MQG] + l * 64; const float* kg = p.in[I_MKG] + l * 64;
    const int tokbase = b * SEQ, keytok = b * SEQ + n * 256;
    const unsigned short* ent = (const unsigned short*)((const unsigned char*)p.out + DO_LIST) + ((size_t)bh16 * 16 + n) * 4096;
    auto entry_of = [&](int i) { const int nv = (count - i * 128 < 128) ? (count - i * 128) : 128; return (unsigned)ent[(size_t)i * 128 + (m < nv ? m : nv - 1)]; };
    u32x4 kreg[4], vreg[4];
#pragma unroll
    for (int j = 0; j < 4; ++j) {
        kreg[j] = *(const u32x4*)(kbase + (size_t)(keytok + j * 64 + kr) * PBC_W + pc * 8);
        vreg[j] = *(const u32x4*)(vbase + (size_t)(keytok + j * 64 + kr) * PBC_W + pc * 8);
    }
    unsigned e_cur = entry_of(i0);
    float kgv[8];
#pragma unroll
    for (int j = 0; j < 8; ++j) kgv[j] = kg[pc * 8 + j];
    __syncthreads();
#pragma unroll
    for (int j = 0; j < 4; ++j) {
        LAS unsigned char* B = lds + j * AT_BUF;
        float kf[8];
#pragma unroll
        for (int q = 0; q < 4; ++q) { kf[2 * q] = bflo(kreg[j][q]); kf[2 * q + 1] = bfhi(kreg[j][q]); }
        float ss = 0.f;
#pragma unroll
        for (int q = 0; q < 8; ++q) ss += kf[q] * kf[q];
        ss = dsum8(ss);
        const float ks = rsqrtf(ss * (1.0f / 64.0f) + 1e-6f);
        u32x4 w; w.x = pk2(kf[0] * ks * kgv[0], kf[1] * ks * kgv[1]); w.y = pk2(kf[2] * ks * kgv[2], kf[3] * ks * kgv[3]);
        w.z = pk2(kf[4] * ks * kgv[4], kf[5] * ks * kgv[5]); w.w = pk2(kf[6] * ks * kgv[6], kf[7] * ks * kgv[7]);
        *(LAS u32x4*)(B + kr * KS_PITCH + pc * 16) = w;
        *(LAS u32x4*)(B + 64 * KS_PITCH + kr * VT_PITCH + pc * 16) = vreg[j];
    }
    u32x4 r0 = *(const u32x4*)(qbase + (size_t)(tokbase + (int)(e_cur & 0xFFFu)) * PBC_W + g * 8), r1 = *(const u32x4*)(qbase + (size_t)(tokbase + (int)(e_cur & 0xFFFu)) * PBC_W + 32 + g * 8);
    unsigned e_nxt = (i0 + 1 < i1) ? entry_of(i0 + 1) : e_cur;
    __syncthreads();
    for (int i = i0; i < i1; ++i) {
        const int nvalid = (count - i * 128 < 128) ? (count - i * 128) : 128;
        u32x4 rn0 = r0, rn1 = r1; unsigned e_nn = e_nxt;
        if (i + 1 < i1) {
            const bf16_t* qn = qbase + (size_t)(tokbase + (int)(e_nxt & 0xFFFu)) * PBC_W;
            rn0 = *(const u32x4*)(qn + g * 8); rn1 = *(const u32x4*)(qn + 32 + g * 8);
            if (i + 2 < i1) e_nn = entry_of(i + 2);
        }
        if (wave * 16 < nvalid) {
            bf16x8 bq[2];
            {
                float qf[16];
#pragma unroll
                for (int j = 0; j < 4; ++j) { qf[2 * j] = bflo(r0[j]); qf[2 * j + 1] = bfhi(r0[j]); qf[8 + 2 * j] = bflo(r1[j]); qf[8 + 2 * j + 1] = bfhi(r1[j]); }
                float ss = 0.f;
#pragma unroll
                for (int j = 0; j < 16; ++j) ss += qf[j] * qf[j];
                ss += __shfl_xor(ss, 16); ss += __shfl_xor(ss, 32);
                const float qs = rsqrtf(ss * (1.0f / 64.0f) + 1e-6f) * (0.125f * 1.4426950408889634f);
                u32x4 b0, b1;
#pragma unroll
                for (int j = 0; j < 4; ++j) {
                    b0[j] = pk2(qf[2 * j] * qs * qg[g * 8 + 2 * j], qf[2 * j + 1] * qs * qg[g * 8 + 2 * j + 1]);
                    b1[j] = pk2(qf[8 + 2 * j] * qs * qg[32 + g * 8 + 2 * j], qf[8 + 2 * j + 1] * qs * qg[32 + g * 8 + 2 * j + 1]);
                }
                bq[0] = __builtin_bit_cast(bf16x8, b0); bq[1] = __builtin_bit_cast(bf16x8, b1);
            }
            f32x4 o[4];
#pragma unroll
            for (int mo = 0; mo < 4; ++mo) o[mo] = (f32x4){0.f, 0.f, 0.f, 0.f};
            float l_run = 0.f;
#pragma unroll 1
            for (int j = 0; j < 4; ++j) {
                const LAS unsigned char* B = lds + j * AT_BUF;
                f32x4 st[4];
#pragma unroll
                for (int mt = 0; mt < 4; ++mt) {
                    st[mt] = (f32x4){0.f, 0.f, 0.f, 0.f};
#pragma unroll
                    for (int ks = 0; ks < 2; ++ks) {
                        const bf16x8 a = *(const LAS bf16x8*)(B + (mt * 16 + qi) * KS_PITCH + ks * 64 + g * 16);
                        st[mt] = __builtin_amdgcn_mfma_f32_16x16x32_bf16(a, bq[ks], st[mt], 0, 0, 0);
                    }
                }
                float ps = 0.f;
#pragma unroll
                for (int mt = 0; mt < 4; ++mt)
#pragma unroll
                    for (int ii = 0; ii < 4; ++ii) { const float pv = __builtin_amdgcn_exp2f(st[mt][ii]); st[mt][ii] = pv; ps += pv; }
                l_run += ps;
#pragma unroll
                for (int ks = 0; ks < 2; ++ks) {
                    u32x4 pbw; pbw.x = pk2(st[2 * ks][0], st[2 * ks][1]); pbw.y = pk2(st[2 * ks][2], st[2 * ks][3]); pbw.z = pk2(st[2 * ks + 1][0], st[2 * ks + 1][1]); pbw.w = pk2(st[2 * ks + 1][2], st[2 * ks + 1][3]);
                    const bf16x8 pb = __builtin_bit_cast(bf16x8, pbw);
#pragma unroll
                    for (int mo = 0; mo < 4; ++mo) {
                        const LAS unsigned char* vp = B + 64 * KS_PITCH + (ks * 32 + 4 * g + (qi >> 2)) * VT_PITCH + (mo * 16 + 4 * (qi & 3)) * 2;
                        const s16x4 lo = __builtin_amdgcn_ds_read_tr16_b64_v4i16((LAS s16x4*)vp), hi = __builtin_amdgcn_ds_read_tr16_b64_v4i16((LAS s16x4*)(vp + 16 * VT_PITCH));
                        bf16x8 av; av[0] = lo[0]; av[1] = lo[1]; av[2] = lo[2]; av[3] = lo[3]; av[4] = hi[0]; av[5] = hi[1]; av[6] = hi[2]; av[7] = hi[3];
                        o[mo] = __builtin_amdgcn_mfma_f32_16x16x32_bf16(av, pb, o[mo], 0, 0, 0);
                    }
                }
            }
            l_run += __shfl_xor(l_run, 16); l_run += __shfl_xor(l_run, 32);
            if (m < nvalid) {
                const size_t row = ((size_t)(tokbase + (int)(e_cur & 0xFFFu)) * 4 + hB) * 3 + (e_cur >> 12);
                const float inv = 1.0f / l_run;
                bf16_t* pb = (bf16_t*)((unsigned char*)p.out + DO_PB) + row * 64;
#pragma unroll
                for (int mo = 0; mo < 4; ++mo) {
                    u32x2 w; w.x = pk2(o[mo][0] * inv, o[mo][1] * inv); w.y = pk2(o[mo][2] * inv, o[mo][3] * inv);
                    *(u32x2*)(pb + mo * 16 + g * 4) = w;
                }
                if (g == 0) ((float*)((unsigned char*)p.out + DO_PL))[row] = l_run;
            }
        }
        r0 = rn0; r1 = rn1; e_cur = e_nxt; e_nxt = e_nn;
    }
}

__device__ __forceinline__ void moba_own_task(const Params& p, int l, int task, LAS unsigned char* lds) {
    const int b = task >> 7, hB = (task >> 5) & 3, ci = task & 31;
    const int tid = tidx(), wave = tid >> 6, lane = tid & 63, qi = lane & 15, g = lane >> 4;
    const bf16_t* pbc = (const bf16_t*)(p.ws + WS_PBC);
    MobaTask tk; tk.tokbase = b * SEQ; tk.q0 = ci * 128; tk.b_own = ci >> 1; tk.nown = (ci & 1) ? 4 : 2; tk.anysel = 0u; tk.mysel = 0u;
    const int tok = tk.q_tok(wave * 16 + qi);
    const int nsel = tk.b_own < 3 ? tk.b_own : 3;
    const size_t row0 = ((size_t)tok * 4 + hB) * 3;
    const bf16_t* pb = (const bf16_t*)((const unsigned char*)p.out + DO_PB) + row0 * 64;
    const float* pl = (const float*)((const unsigned char*)p.out + DO_PL) + row0;
    float pw[3]; u32x2 po[3][4];
#pragma unroll
    for (int sidx = 0; sidx < 3; ++sidx) {
        pw[sidx] = 0.f;
#pragma unroll
        for (int mo = 0; mo < 4; ++mo) po[sidx][mo] = (u32x2){0u, 0u};
        if (sidx < nsel) {
            pw[sidx] = pl[sidx];
#pragma unroll
            for (int mo = 0; mo < 4; ++mo) po[sidx][mo] = *(const u32x2*)(pb + sidx * 64 + mo * 16 + g * 4);
        }
    }
    AttnOut R;
    attn_core(tk, pbc + hB * 64, pbc + 256 + hB * 64, pbc + 512 + hB * 64, p.in[I_MQG] + l * 64, p.in[I_MKG] + l * 64, lds, R);
    float tot = R.l;
#pragma unroll
    for (int sidx = 0; sidx < 3; ++sidx) {
        const float w = pw[sidx];
        tot += w;
#pragma unroll
        for (int mo = 0; mo < 4; ++mo) {
            const u32x2 o = po[sidx][mo];
            R.o[mo][0] += w * bflo(o.x); R.o[mo][1] += w * bfhi(o.x); R.o[mo][2] += w * bflo(o.y); R.o[mo][3] += w * bfhi(o.y);
        }
    }
    const float inv = 1.0f / tot;
    const bf16_t* sg = (const bf16_t*)(p.ws + WS_GATE) + (size_t)tok * 1024 + 384 + hB * 64;
    bf16_t* yg = (bf16_t*)(p.ws + WS_YG) + (size_t)tok * 1024 + 384 + hB * 64;
#pragma unroll
    for (int mo = 0; mo < 4; ++mo) {
        const int dh = mo * 16 + g * 4;
        const u32x2 gt = *(const u32x2*)(sg + dh);
        u32x2 w; w.x = pk2(R.o[mo][0] * inv * bflo(gt.x), R.o[mo][1] * inv * bfhi(gt.x)); w.y = pk2(R.o[mo][2] * inv * bflo(gt.y), R.o[mo][3] * inv * bfhi(gt.y));
        *(u32x2*)(yg + dh) = w;
    }
}

__device__ __forceinline__ void moba_own_run(const Params& p, int l, int task, LAS unsigned char* lds) {
    const int b = task >> 6, hB = (task >> 4) & 3, blk = task & 15;
    const int tid = tidx(), wave = tid >> 6, lane = tid & 63, qi = lane & 15, g = lane >> 4;
    const int kr = tid >> 3, pc = tid & 7, m = wave * 16 + qi;
    const bf16_t* pbc = (const bf16_t*)(p.ws + WS_PBC);
    const bf16_t* qbase = pbc + hB * 64; const bf16_t* kbase = pbc + 256 + hB * 64; const bf16_t* vbase = pbc + 512 + hB * 64;
    const float* qg = p.in[I_MQG] + l * 64; const float* kg = p.in[I_MKG] + l * 64;
    const int keytok = b * SEQ + blk * 256;
    u32x4 qr[2][2]; int qtok[2];
#pragma unroll
    for (int qb = 0; qb < 2; ++qb) {
        qtok[qb] = keytok + qb * 128 + m;
        qr[qb][0] = *(const u32x4*)(qbase + (size_t)qtok[qb] * PBC_W + g * 8); qr[qb][1] = *(const u32x4*)(qbase + (size_t)qtok[qb] * PBC_W + 32 + g * 8);
    }
    u32x4 kreg[4], vreg[4];
#pragma unroll
    for (int j = 0; j < 4; ++j) {
        kreg[j] = *(const u32x4*)(kbase + (size_t)(keytok + j * 64 + kr) * PBC_W + pc * 8);
        vreg[j] = *(const u32x4*)(vbase + (size_t)(keytok + j * 64 + kr) * PBC_W + pc * 8);
    }
    float kgv[8];
#pragma unroll
    for (int j = 0; j < 8; ++j) kgv[j] = kg[pc * 8 + j];
    __syncthreads();
#pragma unroll
    for (int j = 0; j < 4; ++j) {
        LAS unsigned char* B = lds + j * AT_BUF;
        float kf[8];
#pragma unroll
        for (int q = 0; q < 4; ++q) { kf[2 * q] = bflo(kreg[j][q]); kf[2 * q + 1] = bfhi(kreg[j][q]); }
        float ss = 0.f;
#pragma unroll
        for (int q = 0; q < 8; ++q) ss += kf[q] * kf[q];
        ss = dsum8(ss);
        const float ks = rsqrtf(ss * (1.0f / 64.0f) + 1e-6f);
        u32x4 w; w.x = pk2(kf[0] * ks * kgv[0], kf[1] * ks * kgv[1]); w.y = pk2(kf[2] * ks * kgv[2], kf[3] * ks * kgv[3]);
        w.z = pk2(kf[4] * ks * kgv[4], kf[5] * ks * kgv[5]); w.w = pk2(kf[6] * ks * kgv[6], kf[7] * ks * kgv[7]);
        *(LAS u32x4*)(B + kr * KS_PITCH + pc * 16) = w;
        *(LAS u32x4*)(B + 64 * KS_PITCH + kr * VT_PITCH + pc * 16) = vreg[j];
    }
    __syncthreads();
    const int nsel = blk < 3 ? blk : 3;
#pragma unroll
    for (int qb = 0; qb < 2; ++qb) {
        const int tok = qtok[qb];
        const size_t row0 = ((size_t)tok * 4 + hB) * 3;
        const bf16_t* pbp = (const bf16_t*)((const unsigned char*)p.out + DO_PB) + row0 * 64;
        const float* plp = (const float*)((const unsigned char*)p.out + DO_PL) + row0;
        float pw[3]; u32x2 po[3][4];
#pragma unroll
        for (int sidx = 0; sidx < 3; ++sidx) {
            pw[sidx] = 0.f;
#pragma unroll
            for (int mo = 0; mo < 4; ++mo) po[sidx][mo] = (u32x2){0u, 0u};
            if (sidx < nsel) {
                pw[sidx] = plp[sidx];
#pragma unroll
                for (int mo = 0; mo < 4; ++mo) po[sidx][mo] = *(const u32x2*)(pbp + sidx * 64 + mo * 16 + g * 4);
            }
        }
        const u32x2 gt0 = *(const u32x2*)((const bf16_t*)(p.ws + WS_GATE) + (size_t)tok * 1024 + 384 + hB * 64 + g * 4);
        bf16x8 bq[2];
        {
            float qf[16];
#pragma unroll
            for (int j = 0; j < 4; ++j) { qf[2 * j] = bflo(qr[qb][0][j]); qf[2 * j + 1] = bfhi(qr[qb][0][j]); qf[8 + 2 * j] = bflo(qr[qb][1][j]); qf[8 + 2 * j + 1] = bfhi(qr[qb][1][j]); }
            float ss = 0.f;
#pragma unroll
            for (int j = 0; j < 16; ++j) ss += qf[j] * qf[j];
            ss += __shfl_xor(ss, 16); ss += __shfl_xor(ss, 32);
            const float qs = rsqrtf(ss * (1.0f / 64.0f) + 1e-6f) * (0.125f * 1.4426950408889634f);
            u32x4 b0, b1;
#pragma unroll
            for (int j = 0; j < 4; ++j) {
                b0[j] = pk2(qf[2 * j] * qs * qg[g * 8 + 2 * j], qf[2 * j + 1] * qs * qg[g * 8 + 2 * j + 1]);
                b1[j] = pk2(qf[8 + 2 * j] * qs * qg[32 + g * 8 + 2 * j], qf[8 + 2 * j + 1] * qs * qg[32 + g * 8 + 2 * j + 1]);
            }
            bq[0] = __builtin_bit_cast(bf16x8, b0); bq[1] = __builtin_bit_cast(bf16x8, b1);
        }
        f32x4 o[4];
#pragma unroll
        for (int mo = 0; mo < 4; ++mo) o[mo] = (f32x4){0.f, 0.f, 0.f, 0.f};
        float l_run = 0.f;
        const int qpos = qb * 128 + m;
#pragma unroll 1
        for (int j = 0; j < 4; ++j) {
            if (j * 64 > qb * 128 + wave * 16 + 15) continue;
            const LAS unsigned char* B = lds + j * AT_BUF;
            f32x4 st[4];
#pragma unroll
            for (int mt = 0; mt < 4; ++mt) {
                st[mt] = (f32x4){0.f, 0.f, 0.f, 0.f};
#pragma unroll
                for (int ks = 0; ks < 2; ++ks) {
                    const bf16x8 a = *(const LAS bf16x8*)(B + (mt * 16 + qi) * KS_PITCH + ks * 64 + g * 16);
                    st[mt] = __builtin_amdgcn_mfma_f32_16x16x32_bf16(a, bq[ks], st[mt], 0, 0, 0);
                }
            }
            float ps = 0.f;
#pragma unroll
            for (int mt = 0; mt < 4; ++mt)
#pragma unroll
                for (int ii = 0; ii < 4; ++ii) {
                    const float pv = (j * 64 + mt * 16 + g * 4 + ii <= qpos) ? __builtin_amdgcn_exp2f(st[mt][ii]) : 0.f;
                    st[mt][ii] = pv; ps += pv;
                }
            l_run += ps;
#pragma unroll
            for (int ks = 0; ks < 2; ++ks) {
                u32x4 pbw; pbw.x = pk2(st[2 * ks][0], st[2 * ks][1]); pbw.y = pk2(st[2 * ks][2], st[2 * ks][3]); pbw.z = pk2(st[2 * ks + 1][0], st[2 * ks + 1][1]); pbw.w = pk2(st[2 * ks + 1][2], st[2 * ks + 1][3]);
                const bf16x8 pb = __builtin_bit_cast(bf16x8, pbw);
#pragma unroll
                for (int mo = 0; mo < 4; ++mo) {
                    const LAS unsigned char* vp = B + 64 * KS_PITCH + (ks * 32 + 4 * g + (qi >> 2)) * VT_PITCH + (mo * 16 + 4 * (qi & 3)) * 2;
                    const s16x4 lo = __builtin_amdgcn_ds_read_tr16_b64_v4i16((LAS s16x4*)vp), hi = __builtin_amdgcn_ds_read_tr16_b64_v4i16((LAS s16x4*)(vp + 16 * VT_PITCH));
                    bf16x8 av; av[0] = lo[0]; av[1] = lo[1]; av[2] = lo[2]; av[3] = lo[3]; av[4] = hi[0]; av[5] = hi[1]; av[6] = hi[2]; av[7] = hi[3];
                    o[mo] = __builtin_amdgcn_mfma_f32_16x16x32_bf16(av, pb, o[mo], 0, 0, 0);
                }
            }
        }
        l_run += __shfl_xor(l_run, 16); l_run += __shfl_xor(l_run, 32);
        float tot = l_run;
#pragma unroll
        for (int sidx = 0; sidx < 3; ++sidx) {
            const float w = pw[sidx];
            tot += w;
#pragma unroll
            for (int mo = 0; mo < 4; ++mo) {
                const u32x2 oo = po[sidx][mo];
                o[mo][0] += w * bflo(oo.x); o[mo][1] += w * bfhi(oo.x); o[mo][2] += w * bflo(oo.y); o[mo][3] += w * bfhi(oo.y);
            }
        }
        const float inv = 1.0f / tot;
        const bf16_t* sg = (const bf16_t*)(p.ws + WS_GATE) + (size_t)tok * 1024 + 384 + hB * 64;
        bf16_t* yg = (bf16_t*)(p.ws + WS_YG) + (size_t)tok * 1024 + 384 + hB * 64;
#pragma unroll
        for (int mo = 0; mo < 4; ++mo) {
            const int dh = mo * 16 + g * 4;
            const u32x2 gt = (mo == 0) ? gt0 : *(const u32x2*)(sg + dh);
            u32x2 w; w.x = pk2(o[mo][0] * inv * bflo(gt.x), o[mo][1] * inv * bfhi(gt.x)); w.y = pk2(o[mo][2] * inv * bflo(gt.y), o[mo][3] * inv * bfhi(gt.y));
            *(u32x2*)(yg + dh) = w;
        }
    }
}

__device__ __forceinline__ void kmean_task(const Params& p, int l, int task, LAS unsigned char* lds) {
    const int b = task / 64, r = task % 64, hB = r / 16, n = r % 16;
    const int tid = tidx(), kr = tid >> 3, pc = tid & 7;
    const bf16_t* kb = (const bf16_t*)(p.ws + WS_PBC) + 256 + hB * 64 + pc * 8;
    const float* kg = p.in[I_MKG] + l * 64 + pc * 8;
    float acc[8];
#pragma unroll
    for (int j = 0; j < 8; ++j) acc[j] = 0.f;
#pragma unroll
    for (int it = 0; it < 4; ++it) {
        const u32x4 rw = *(const u32x4*)(kb + (size_t)(b * SEQ + n * 256 + it * 64 + kr) * PBC_W);
        float kf[8];
#pragma unroll
        for (int q = 0; q < 4; ++q) { kf[2 * q] = bflo(rw[q]); kf[2 * q + 1] = bfhi(rw[q]); }
        float ss = 0.f;
#pragma unroll
        for (int q = 0; q < 8; ++q) ss += kf[q] * kf[q];
        ss = sum8(ss);
        const float ks = rsqrtf(ss * (1.0f / 64.0f) + 1e-6f);
#pragma unroll
        for (int q = 0; q < 8; ++q) acc[q] += bf2f(f2bf(kf[q] * ks * kg[q]));
    }
    LAS float* red = (LAS float*)lds;
    __syncthreads();
#pragma unroll
    for (int q = 0; q < 8; ++q) red[kr * 64 + pc * 8 + q] = acc[q];
    __syncthreads();
    if (tid < 64) {
        float s = 0.f;
        for (int i = 0; i < 64; ++i) s += red[i * 64 + tid];
        ((float*)(p.ws + WS_KMEAN))[(size_t)((b * 4 + hB) * 16 + n) * 64 + tid] = s * (1.0f / 256.0f);
    }
    asm volatile("s_waitcnt vmcnt(0)" ::: "memory");
    __syncthreads();
    if (threadIdx.x == 0) {
        __builtin_amdgcn_fence(__ATOMIC_RELEASE, "agent");
        asm volatile("s_waitcnt vmcnt(0)" ::: "memory");
        __hip_atomic_fetch_add((unsigned*)(p.ws + WS_KMC) + (b * 4 + hB), 1u, __ATOMIC_RELAXED, __HIP_MEMORY_SCOPE_AGENT);
    }
}

typedef float f32x2 __attribute__((ext_vector_type(2)));
constexpr size_t CH_ELEMS = 4096;
struct ChunkPre { u32x4 cur[5]; };
__device__ __forceinline__ void rwkv_chunk_load(const Params& p, int task, ChunkPre& P) {
    const int bh = task / 64, ch = task % 64, b = bh / 6, h = bh % 6;
    const int tid = tidx(), tl = tid >> 3, pc = tid & 7;
    const int s = ch * 64 + tl, tok = b * SEQ + s;
    const bf16_t* pa = (const bf16_t*)(p.ws + WS_PA);
#pragma unroll
    for (int gi = 0; gi < 5; ++gi) {
        const int cb = (gi < 3 ? gi * 384 + h * 64 : (gi == 3 ? 1152 : 1216)) + pc * 8;
        P.cur[gi] = *(const u32x4*)(pa + (size_t)tok * PA_W + cb);
    }
}
__device__ __forceinline__ void rwkv_chunk_task(const Params& p, int l, int task, int task_next, ChunkPre& P, LAS unsigned char* lds) {
    const int bh = task / 64, ch = task % 64, b = bh / 6, h = bh % 6;
    const int tid = tidx(), tl = tid >> 3, pc = tid & 7;
    const int s = ch * 64 + tl, tok = b * SEQ + s;
    LAS float* sh = (LAS float*)lds;
    LAS float* ops = (LAS float*)lds;
    LAS float* vimg = (LAS float*)(lds + 81920);
    LAS float* y0l = (LAS float*)(lds + 98304);
    LAS bf16_t* qlds = (LAS bf16_t*)(lds + 114688);
    const float* mu = p.in[I_MU] + l * 1280;
    __syncthreads();
    LAS unsigned char* a34 = lds + 49152; LAS unsigned char* wat = lds + 67584; LAS float* lres = (LAS float*)(lds + 86016);
#pragma unroll
    for (int gi = 0; gi < 5; ++gi) {
        const int cb = (gi < 3 ? gi * 384 + h * 64 : (gi == 3 ? 1152 : 1216)) + pc * 8;
        const u32x4 cur = P.cur[gi];
        u32x4 prv = {0u, 0u, 0u, 0u};
        if (s > 0) prv = *(const u32x4*)((const bf16_t*)(p.ws + WS_PA) + (size_t)(tok - 1) * PA_W + cb);
        float vals[8];
#pragma unroll
        for (int q = 0; q < 4; ++q) {
            const float c0 = bflo(cur[q]), c1 = bfhi(cur[q]), p0 = bflo(prv[q]), p1 = bfhi(prv[q]);
            float v0 = c0 + (p0 - c0) * mu[cb + 2 * q], v1 = c1 + (p1 - c1) * mu[cb + 2 * q + 1];
            if (gi == 3) { v0 = 1.0f - 2.0f * __builtin_amdgcn_rcpf(1.0f + __expf(2.0f * v0)); v1 = 1.0f - 2.0f * __builtin_amdgcn_rcpf(1.0f + __expf(2.0f * v1)); }
            vals[2 * q] = v0; vals[2 * q + 1] = v1;
        }
        if (gi < 3) {
#pragma unroll
            for (int q = 0; q < 8; ++q) sh[gi * 4096 + tl * 64 + pc * 8 + q] = vals[q];
        } else {
            u32x4 w; w.x = pk2(vals[0], vals[1]); w.y = pk2(vals[2], vals[3]); w.z = pk2(vals[4], vals[5]); w.w = pk2(vals[6], vals[7]);
            *(LAS u32x4*)(a34 + (gi - 3) * 9216 + tl * 144 + pc * 16) = w;
        }
    }
    {
        const float* wsrc = p.in[I_WUP] + (size_t)l * 64 * 384 + (size_t)tl * 384 + h * 64 + pc * 8;
        const float* asrc = p.in[I_AUP] + (size_t)l * 64 * 384 + (size_t)tl * 384 + h * 64 + pc * 8;
        const f32x4 w0 = *(const f32x4*)wsrc, w1 = *(const f32x4*)(wsrc + 4), a0 = *(const f32x4*)asrc, a1 = *(const f32x4*)(asrc + 4);
#pragma unroll
        for (int q = 0; q < 4; ++q) {
            *(LAS bf16_t*)(wat + (pc * 8 + q) * 144 + tl * 2) = (bf16_t)(pk2(w0[q], 0.f) & 0xFFFFu); *(LAS bf16_t*)(wat + (pc * 8 + 4 + q) * 144 + tl * 2) = (bf16_t)(pk2(w1[q], 0.f) & 0xFFFFu);
            *(LAS bf16_t*)(wat + 9216 + (pc * 8 + q) * 144 + tl * 2) = (bf16_t)(pk2(a0[q], 0.f) & 0xFFFFu); *(LAS bf16_t*)(wat + 9216 + (pc * 8 + 4 + q) * 144 + tl * 2) = (bf16_t)(pk2(a1[q], 0.f) & 0xFFFFu);
        }
    }
    __syncthreads();
    if (task_next >= 0) rwkv_chunk_load(p, task_next, P);
    {
        const int wave = tid >> 6, lane = tid & 63, lq = lane & 15, g = lane >> 4, mat = wave >> 2, mt = wave & 3;
        const LAS unsigned char* Am = a34 + mat * 9216; const LAS unsigned char* Bm = wat + mat * 9216;
        const bf16x8 x0 = *(const LAS bf16x8*)(Am + (16 * mt + lq) * 144 + g * 16), x1 = *(const LAS bf16x8*)(Am + (16 * mt + lq) * 144 + 64 + g * 16);
#pragma unroll
        for (int nt = 0; nt < 4; ++nt) {
            const bf16x8 y0 = *(const LAS bf16x8*)(Bm + (16 * nt + lq) * 144 + g * 16), y1 = *(const LAS bf16x8*)(Bm + (16 * nt + lq) * 144 + 64 + g * 16);
            f32x4 D = {0.f, 0.f, 0.f, 0.f};
            D = __builtin_amdgcn_mfma_f32_16x16x32_bf16(x0, y0, D, 0, 0, 0);
            D = __builtin_amdgcn_mfma_f32_16x16x32_bf16(x1, y1, D, 0, 0, 0);
#pragma unroll
            for (int i = 0; i < 4; ++i) lres[mat * 4096 + (16 * mt + 4 * g + i) * 64 + 16 * nt + lq] = D[i];
        }
    }
    __syncthreads();
    const int cbase = l * 384 + h * 64 + pc * 8;
    float wa[8], aa[8];
#pragma unroll
    for (int j = 0; j < 8; ++j) { wa[j] = p.in[I_W0][cbase + j] + lres[tl * 64 + pc * 8 + j]; aa[j] = p.in[I_A0][cbase + j] + lres[4096 + tl * 64 + pc * 8 + j]; }
    __syncthreads();
    {
        float wv[8], av[8], kkv[8], kp[8], rv[8], vv[8];
        float ssq = 0.f, bon = 0.f;
#pragma unroll
        for (int j = 0; j < 8; ++j) {
            const float z = -wa[j];
            const float sp = fmaxf(z, 0.f) + __logf(1.0f + __expf(-fabsf(z)));
            wv[j] = __expf(-__expf(-sp - 0.5f));
            av[j] = __builtin_amdgcn_rcpf(1.0f + __expf(-aa[j]));
            const float kraw = sh[1 * 4096 + tl * 64 + pc * 8 + j];
            kkv[j] = kraw * p.in[I_KK][cbase + j];
            ssq += kkv[j] * kkv[j];
            kp[j] = kraw * (1.0f + (av[j] - 1.0f) * p.in[I_KA][cbase + j]);
            rv[j] = sh[0 * 4096 + tl * 64 + pc * 8 + j]; vv[j] = sh[2 * 4096 + tl * 64 + pc * 8 + j];
            bon += rv[j] * kp[j] * p.in[I_RK][cbase + j];
        }
        ssq = sum8(ssq); bon = sum8(bon);
        const float inv = rsqrtf(ssq + 1e-12f);
        __syncthreads();
        LAS float* ob = ops + tl * 320 + pc * 8;
#pragma unroll
        for (int j = 0; j < 8; ++j) {
            const float kk = kkv[j] * inv;
            ob[j] = wv[j]; ob[64 + j] = kk; ob[128 + j] = kk * av[j]; ob[192 + j] = rv[j]; ob[256 + j] = kp[j];
            vimg[tl * 64 + pc * 8 + j] = vv[j];
        }
        u32x4 w; w.x = pk2(bon * vv[0], bon * vv[1]); w.y = pk2(bon * vv[2], bon * vv[3]); w.z = pk2(bon * vv[4], bon * vv[5]); w.w = pk2(bon * vv[6], bon * vv[7]);
        *(u32x4*)((bf16_t*)(p.ws + WS_BV) + (size_t)task * CH_ELEMS + tl * 64 + pc * 8) = w;
    }
    __syncthreads();
    const int rp = tid >> 3, kq = tid & 7;
    const bool isH = rp < 32;
    const int rowA = isH ? 2 * rp : 2 * (rp - 32);
    const int posA = ((rowA >> 2) & 3) * 16 + (rowA >> 4) * 4 + (rowA & 3);
    f32x2 S0[4], S1[4];
#pragma unroll
    for (int q = 0; q < 4; ++q) {
        S0[q] = (f32x2){0.f, 0.f}; S1[q] = (f32x2){0.f, 0.f};
        if (!isH) {
            S0[q].x = (8 * kq + 2 * q == rowA) ? 1.f : 0.f; S0[q].y = (8 * kq + 2 * q + 1 == rowA) ? 1.f : 0.f;
            S1[q].x = (8 * kq + 2 * q == rowA + 1) ? 1.f : 0.f; S1[q].y = (8 * kq + 2 * q + 1 == rowA + 1) ? 1.f : 0.f;
        }
    }
    const LAS float* o_b = ops + kq * 8; const LAS float* o_v = vimg + rowA;
    struct Ops { f32x4 w0, w1, kk0, kk1, bb0, bb1, k0, k1, r0, r1; f32x2 v; };
#define CK_LOAD(O, t, HASV) do { const LAS float* _b = o_b + (t) * 320; O.w0 = *(const LAS f32x4*)(_b); O.w1 = *(const LAS f32x4*)(_b + 4); O.kk0 = *(const LAS f32x4*)(_b + 64); O.kk1 = *(const LAS f32x4*)(_b + 68); \
        O.bb0 = *(const LAS f32x4*)(_b + 128); O.bb1 = *(const LAS f32x4*)(_b + 132); O.r0 = *(const LAS f32x4*)(_b + 192); O.r1 = *(const LAS f32x4*)(_b + 196); \
        if (HASV) { O.k0 = *(const LAS f32x4*)(_b + 256); O.k1 = *(const LAS f32x4*)(_b + 260); O.v = *(const LAS f32x2*)(o_v + (t) * 64); } } while (0)
#define CK_P(X, q) ((f32x2){X##0[(q) * 2 & 3], X##0[((q) * 2 & 3) + 1]})
#define CK_STEP(O, t, HASV) do { \
        const f32x2 w_0 = {O.w0[0], O.w0[1]}, w_1 = {O.w0[2], O.w0[3]}, w_2 = {O.w1[0], O.w1[1]}, w_3 = {O.w1[2], O.w1[3]}; \
        const f32x2 kk_0 = {O.kk0[0], O.kk0[1]}, kk_1 = {O.kk0[2], O.kk0[3]}, kk_2 = {O.kk1[0], O.kk1[1]}, kk_3 = {O.kk1[2], O.kk1[3]}; \
        const f32x2 bb_0 = {O.bb0[0], O.bb0[1]}, bb_1 = {O.bb0[2], O.bb0[3]}, bb_2 = {O.bb1[0], O.bb1[1]}, bb_3 = {O.bb1[2], O.bb1[3]}; \
        const f32x2 r_0 = {O.r0[0], O.r0[1]}, r_1 = {O.r0[2], O.r0[3]}, r_2 = {O.r1[0], O.r1[1]}, r_3 = {O.r1[2], O.r1[3]}; \
        f32x2 a0 = S0[0] * kk_0, a1 = S1[0] * kk_0; a0 = S0[1] * kk_1 + a0; a1 = S1[1] * kk_1 + a1; a0 = S0[2] * kk_2 + a0; a1 = S1[2] * kk_2 + a1; a0 = S0[3] * kk_3 + a0; a1 = S1[3] * kk_3 + a1; \
        float sa0 = a0.x + a0.y, sa1 = a1.x + a1.y; \
        sa0 += dppf<0xB1>(sa0); sa1 += dppf<0xB1>(sa1); sa0 += dppf<0x4E>(sa0); sa1 += dppf<0x4E>(sa1); sa0 = -(sa0 + dppf<0x141>(sa0)); sa1 = -(sa1 + dppf<0x141>(sa1)); \
        if (HASV) { const f32x2 k_0 = {O.k0[0], O.k0[1]}, k_1 = {O.k0[2], O.k0[3]}, k_2 = {O.k1[0], O.k1[1]}, k_3 = {O.k1[2], O.k1[3]}; const float v0 = O.v.x, v1 = O.v.y; \
            S0[0] = S0[0] * w_0 + (bb_0 * sa0 + k_0 * v0); S1[0] = S1[0] * w_0 + (bb_0 * sa1 + k_0 * v1); S0[1] = S0[1] * w_1 + (bb_1 * sa0 + k_1 * v0); S1[1] = S1[1] * w_1 + (bb_1 * sa1 + k_1 * v1); \
            S0[2] = S0[2] * w_2 + (bb_2 * sa0 + k_2 * v0); S1[2] = S1[2] * w_2 + (bb_2 * sa1 + k_2 * v1); S0[3] = S0[3] * w_3 + (bb_3 * sa0 + k_3 * v0); S1[3] = S1[3] * w_3 + (bb_3 * sa1 + k_3 * v1); \
        } else { \
            S0[0] = S0[0] * w_0 + bb_0 * sa0; S1[0] = S1[0] * w_0 + bb_0 * sa1; S0[1] = S0[1] * w_1 + bb_1 * sa0; S1[1] = S1[1] * w_1 + bb_1 * sa1; \
            S0[2] = S0[2] * w_2 + bb_2 * sa0; S1[2] = S1[2] * w_2 + bb_2 * sa1; S0[3] = S0[3] * w_3 + bb_3 * sa0; S1[3] = S1[3] * w_3 + bb_3 * sa1; } \
        f32x2 y0 = S0[0] * r_0, y1 = S1[0] * r_0; y0 = S0[1] * r_1 + y0; y1 = S1[1] * r_1 + y1; y0 = S0[2] * r_2 + y0; y1 = S1[2] * r_2 + y1; y0 = S0[3] * r_3 + y0; y1 = S1[3] * r_3 + y1; \
        float ya = y0.x + y0.y, yb = y1.x + y1.y; \
        ya += dppf<0xB1>(ya); yb += dppf<0xB1>(yb); ya += dppf<0x4E>(ya); yb += dppf<0x4E>(yb); ya += dppf<0x141>(ya); yb += dppf<0x141>(yb); \
        { if (HASV) *(LAS f32x2*)(y0l + (t) * 64 + rowA) = (f32x2){ya, yb}; else *(LAS unsigned*)(qlds + (t) * 64 + posA) = pk2(ya, yb); } } while (0)
    Ops OA, OB;
    if (isH) {
        CK_LOAD(OA, 0, true);
        for (int t = 0; t < 64; t += 4) { CK_LOAD(OB, t + 1, true); CK_STEP(OA, t, true); CK_LOAD(OA, t + 2, true); CK_STEP(OB, t + 1, true); CK_LOAD(OB, t + 3, true); CK_STEP(OA, t + 2, true); if (t + 4 < 64) CK_LOAD(OA, t + 4, true); CK_STEP(OB, t + 3, true); }
    } else {
        CK_LOAD(OA, 0, false);
        for (int t = 0; t < 64; t += 4) { CK_LOAD(OB, t + 1, false); CK_STEP(OA, t, false); CK_LOAD(OA, t + 2, false); CK_STEP(OB, t + 1, false); CK_LOAD(OB, t + 3, false); CK_STEP(OA, t + 2, false); if (t + 4 < 64) CK_LOAD(OA, t + 4, false); CK_STEP(OB, t + 3, false); }
    }
#undef CK_LOAD
#undef CK_P
#undef CK_STEP
    if (isH) {
        bf16_t* hm = (bf16_t*)(p.ws + WS_HM) + (size_t)task * CH_ELEMS + ((kq & 1) * 2) * 16 + (kq >> 1) * 4;
        u32x2 w; w.x = pk2(S0[0].x, S0[0].y); w.y = pk2(S0[1].x, S0[1].y); *(u32x2*)(hm + (size_t)rowA * 64) = w;
        w.x = pk2(S0[2].x, S0[2].y); w.y = pk2(S0[3].x, S0[3].y); *(u32x2*)(hm + (size_t)rowA * 64 + 16) = w;
        w.x = pk2(S1[0].x, S1[0].y); w.y = pk2(S1[1].x, S1[1].y); *(u32x2*)(hm + (size_t)(rowA + 1) * 64) = w;
        w.x = pk2(S1[2].x, S1[2].y); w.y = pk2(S1[3].x, S1[3].y); *(u32x2*)(hm + (size_t)(rowA + 1) * 64 + 16) = w;
    } else {
        bf16_t* gt = (bf16_t*)(p.ws + WS_GT) + (size_t)task * CH_ELEMS + posA;
#pragma unroll
        for (int q = 0; q < 4; ++q) {
            *(unsigned*)(gt + (size_t)(8 * kq + 2 * q) * 64) = pk2(S0[q].x, S1[q].x);
            *(unsigned*)(gt + (size_t)(8 * kq + 2 * q + 1) * 64) = pk2(S0[q].y, S1[q].y);
        }
    }
    __syncthreads();
    {
        *(u32x4*)((bf16_t*)(p.ws + WS_QQ) + (size_t)task * CH_ELEMS + tid * 8) = *(const LAS u32x4*)(qlds + tid * 8);
        const f32x4 ya = *(const LAS f32x4*)(y0l + tid * 8), yb = *(const LAS f32x4*)(y0l + tid * 8 + 4);
        u32x4 w; w.x = pk2(ya[0], ya[1]); w.y = pk2(ya[2], ya[3]); w.z = pk2(yb[0], yb[1]); w.w = pk2(yb[2], yb[3]);
        *(u32x4*)((bf16_t*)(p.ws + WS_Y0) + (size_t)task * CH_ELEMS + tid * 8) = w;
    }
}

constexpr int RC_PITCH = 144, RC_IMG = 64 * RC_PITCH, RC_SLOT = 2 * RC_IMG;
__device__ __forceinline__ void recur_task(const Params& p, int l, int bh, LAS unsigned char* lds) {
    const int tid = tidx(), wave = tid >> 6, lane = tid & 63, lq = lane & 15, g = lane >> 4;
    const int v = (wave & 3) * 16 + lq;
    const bf16_t* GT = (const bf16_t*)(p.ws + WS_GT) + (size_t)bh * 64 * CH_ELEMS;
    const bf16_t* HM = (const bf16_t*)(p.ws + WS_HM) + (size_t)bh * 64 * CH_ELEMS;
    bf16_t* SC = (bf16_t*)(p.ws + WS_SC) + (size_t)bh * 64 * CH_ELEMS;
    const int srow = tid >> 3, spc = tid & 7;
    const int soff = srow * RC_PITCH + spc * 16;
    f32x4 sacc[4];
#pragma unroll
    for (int mt = 0; mt < 4; ++mt) sacc[mt] = (f32x4){0.f, 0.f, 0.f, 0.f};
    u32x4 bS[2] = {{0u, 0u, 0u, 0u}, {0u, 0u, 0u, 0u}};
    u32x4 sgA[4], shA[4], sgB[4], shB[4];
#define RC_LD(SG, SH, grpi) do { _Pragma("unroll") for (int i = 0; i < 4; ++i) { SG[i] = *(const u32x4*)(GT + (size_t)((grpi) * 4 + i) * CH_ELEMS + tid * 8); SH[i] = *(const u32x4*)(HM + (size_t)((grpi) * 4 + i) * CH_ELEMS + tid * 8); } } while (0)
#define RC_ST(SG, SH) do { _Pragma("unroll") for (int i = 0; i < 4; ++i) { *(LAS u32x4*)(lds + i * RC_SLOT + soff) = SG[i]; *(LAS u32x4*)(lds + i * RC_SLOT + RC_IMG + soff) = SH[i]; } } while (0)
    RC_LD(sgA, shA, 0); RC_LD(sgB, shB, 1);
    __syncthreads();
    for (int grp = 0; grp < 16; ++grp) {
        if (grp & 1) { RC_ST(sgB, shB); if (grp + 2 < 16) RC_LD(sgB, shB, grp + 2); }
        else         { RC_ST(sgA, shA); if (grp + 2 < 16) RC_LD(sgA, shA, grp + 2); }
        __syncthreads();
        if (wave < 4) {
#pragma unroll 1
            for (int i = 0; i < 4; ++i) {
                const int c = grp * 4 + i;
                const LAS unsigned char* G = lds + i * RC_SLOT;
                u32x4 w0, w1;
                w0.x = pk2(sacc[0][0], sacc[0][1]); w0.y = pk2(sacc[0][2], sacc[0][3]); w0.z = pk2(sacc[1][0], sacc[1][1]); w0.w = pk2(sacc[1][2], sacc[1][3]);
                w1.x = pk2(sacc[2][0], sacc[2][1]); w1.y = pk2(sacc[2][2], sacc[2][3]); w1.z = pk2(sacc[3][0], sacc[3][1]); w1.w = pk2(sacc[3][2], sacc[3][3]);
                *(u32x4*)(SC + (size_t)c * CH_ELEMS + v * 64 + 16 * g) = w0; *(u32x4*)(SC + (size_t)c * CH_ELEMS + v * 64 + 16 * g + 8) = w1;
                const u32x4 h0 = *(const LAS u32x4*)(G + RC_IMG + v * RC_PITCH + g * 32), h1 = *(const LAS u32x4*)(G + RC_IMG + v * RC_PITCH + g * 32 + 16);
                f32x4 D[4];
                D[0] = (f32x4){bflo(h0.x), bfhi(h0.x), bflo(h0.y), bfhi(h0.y)}; D[1] = (f32x4){bflo(h0.z), bfhi(h0.z), bflo(h0.w), bfhi(h0.w)};
                D[2] = (f32x4){bflo(h1.x), bfhi(h1.x), bflo(h1.y), bfhi(h1.y)}; D[3] = (f32x4){bflo(h1.z), bfhi(h1.z), bflo(h1.w), bfhi(h1.w)};
#pragma unroll
                for (int mt = 0; mt < 4; ++mt)
#pragma unroll
                    for (int ks = 0; ks < 2; ++ks) {
                        const bf16x8 a = *(const LAS bf16x8*)(G + (16 * mt + lq) * RC_PITCH + g * 32 + ks * 16);
                        D[mt] = __builtin_amdgcn_mfma_f32_16x16x32_bf16(a, __builtin_bit_cast(bf16x8, bS[ks]), D[mt], 0, 0, 0);
                    }
#pragma unroll
                for (int mt = 0; mt < 4; ++mt) sacc[mt] = D[mt];
#pragma unroll
                for (int ks = 0; ks < 2; ++ks) {
                    bS[ks].x = pk2(D[2 * ks][0], D[2 * ks][1]); bS[ks].y = pk2(D[2 * ks][2], D[2 * ks][3]);
                    bS[ks].z = pk2(D[2 * ks + 1][0], D[2 * ks + 1][1]); bS[ks].w = pk2(D[2 * ks + 1][2], D[2 * ks + 1][3]);
                }
            }
        }
        __syncthreads();
    }
    asm volatile("s_waitcnt vmcnt(0)" ::: "memory");
    __syncthreads();
    if (threadIdx.x == 0) {
        __builtin_amdgcn_fence(__ATOMIC_RELEASE, "agent");
        asm volatile("s_waitcnt vmcnt(0)" ::: "memory");
        __hip_atomic_store((unsigned*)(p.ws + WS_FLAG) + bh, (unsigned)(l + 1), __ATOMIC_RELAXED, __HIP_MEMORY_SCOPE_AGENT);
    }
}

__device__ __forceinline__ void rwkv_out_task(const Params& p, int l, int pairtask) {
    const int tid = tidx(), wave = tid >> 6, lane = tid & 63, lq = lane & 15, g = lane >> 4;
    const int chunk = pairtask * 2 + (wave >> 2), bh = chunk / 64, ch = chunk % 64, b = bh / 6, h = bh % 6;
    const int t = (wave & 3) * 16 + lq;
    const int tok = b * SEQ + ch * 64 + t;
    const bf16_t* SC = (const bf16_t*)(p.ws + WS_SC) + (size_t)chunk * CH_ELEMS;
    const bf16_t* QQ = (const bf16_t*)(p.ws + WS_QQ) + (size_t)chunk * CH_ELEMS;
    const bf16_t* Y0 = (const bf16_t*)(p.ws + WS_Y0) + (size_t)chunk * CH_ELEMS;
    const bf16_t* BV = (const bf16_t*)(p.ws + WS_BV) + (size_t)chunk * CH_ELEMS;
    const bf16_t* sg = (const bf16_t*)(p.ws + WS_GATE) + (size_t)tok * 1024 + h * 64;
    bf16_t* yg = (bf16_t*)(p.ws + WS_YG) + (size_t)tok * 1024 + h * 64;
    bf16x8 bQ[2], aS[4][2]; u32x2 y0[4], bv[4], gt[4]; f32x4 gg[4], gb[4];
#pragma unroll
    for (int ks = 0; ks < 2; ++ks) bQ[ks] = *(const bf16x8*)(QQ + t * 64 + 32 * ks + 8 * g);
#pragma unroll
    for (int vt = 0; vt < 4; ++vt) {
        const int vv = 16 * vt + 4 * g;
        y0[vt] = *(const u32x2*)(Y0 + t * 64 + vv);
#pragma unroll
        for (int ks = 0; ks < 2; ++ks) aS[vt][ks] = *(const bf16x8*)(SC + (16 * vt + lq) * 64 + 32 * ks + 8 * g);
        bv[vt] = *(const u32x2*)(BV + t * 64 + vv); gt[vt] = *(const u32x2*)(sg + vv);
        gg[vt] = *(const f32x4*)(p.in[I_LNG] + l * 384 + h * 64 + vv); gb[vt] = *(const f32x4*)(p.in[I_LNB] + l * 384 + h * 64 + vv);
    }
    f32x4 D[4];
#pragma unroll
    for (int vt = 0; vt < 4; ++vt) {
        D[vt] = (f32x4){bflo(y0[vt].x), bfhi(y0[vt].x), bflo(y0[vt].y), bfhi(y0[vt].y)};
#pragma unroll
        for (int ks = 0; ks < 2; ++ks) D[vt] = __builtin_amdgcn_mfma_f32_16x16x32_bf16(aS[vt][ks], bQ[ks], D[vt], 0, 0, 0);
    }
    float sm = 0.f;
#pragma unroll
    for (int vt = 0; vt < 4; ++vt) sm += (D[vt][0] + D[vt][1]) + (D[vt][2] + D[vt][3]);
    sm += __shfl_xor(sm, 16); sm += __shfl_xor(sm, 32);
    const float mean = sm * (1.0f / 64.0f);
    float vs = 0.f;
#pragma unroll
    for (int vt = 0; vt < 4; ++vt) { D[vt] -= mean; vs += (D[vt][0] * D[vt][0] + D[vt][1] * D[vt][1]) + (D[vt][2] * D[vt][2] + D[vt][3] * D[vt][3]); }
    vs += __shfl_xor(vs, 16); vs += __shfl_xor(vs, 32);
    const float rstd = rsqrtf(vs * (1.0f / 64.0f) + 64e-5f);
#pragma unroll
    for (int vt = 0; vt < 4; ++vt) {
        const float o0 = (D[vt][0] * rstd * gg[vt][0] + gb[vt][0] + bflo(bv[vt].x)) * bflo(gt[vt].x), o1 = (D[vt][1] * rstd * gg[vt][1] + gb[vt][1] + bfhi(bv[vt].x)) * bfhi(gt[vt].x);
        const float o2 = (D[vt][2] * rstd * gg[vt][2] + gb[vt][2] + bflo(bv[vt].y)) * bflo(gt[vt].y), o3 = (D[vt][3] * rstd * gg[vt][3] + gb[vt][3] + bfhi(bv[vt].y)) * bfhi(gt[vt].y);
        u32x2 w; w.x = pk2(o0, o1); w.y = pk2(o2, o3);
        *(u32x2*)(yg + 16 * vt + 4 * g) = w;
    }
}

constexpr int GT_AP = 64 * 144, GT_BP = 128 * 144, GT_BUF = GT_AP + GT_BP;
__device__ __forceinline__ void gate_tail_task(const Params& p, int l, int task, LAS unsigned char* lds) {
    const int tid = tidx(), wave = tid >> 6, lane = tid & 63, lq = lane & 15, g = lane >> 4;
    const int r0 = task * 64, nq = wave & 3, mh = wave >> 2;
    const bf16_t* xb = (const bf16_t*)(p.ws + WS_XB) + (size_t)r0 * 1024;
    const bf16_t* wt = (const bf16_t*)(p.ws + ((l & 1) ? WS_WIN1 : WS_WIN)) + (size_t)4096 * 1024;
    const int srow = tid >> 3, spc = tid & 7;
    const int tokrow = r0 + nq * 16 + lq;
    const float* sq = (const float*)(p.ws + WS_SSQ) + (size_t)tokrow * 16;
    const f32x4 q0 = *(const f32x4*)sq, q1 = *(const f32x4*)(sq + 4), q2 = *(const f32x4*)(sq + 8), q3 = *(const f32x4*)(sq + 12);
    f32x4 acc[4];
#pragma unroll
    for (int mt = 0; mt < 4; ++mt) acc[mt] = (f32x4){0.f, 0.f, 0.f, 0.f};
    u32x4 aA, bA0, bA1, aB, bB0, bB1;
#define GT_LOAD(kt, AR, BR0, BR1) do { AR = *(const u32x4*)(xb + (size_t)srow * 1024 + (kt) * 64 + spc * 8); \
        BR0 = *(const u32x4*)(wt + (size_t)srow * 1024 + (kt) * 64 + spc * 8); BR1 = *(const u32x4*)(wt + (size_t)(srow + 64) * 1024 + (kt) * 64 + spc * 8); } while (0)
#define GT_STORE(buf, AR, BR0, BR1) do { LAS unsigned char* _B = lds + (buf) * GT_BUF; *(LAS u32x4*)(_B + srow * 144 + spc * 16) = AR; \
        *(LAS u32x4*)(_B + GT_AP + srow * 144 + spc * 16) = BR0; *(LAS u32x4*)(_B + GT_AP + (srow + 64) * 144 + spc * 16) = BR1; } while (0)
#define GT_COMPUTE(buf) do { const LAS unsigned char* _B = lds + (buf) * GT_BUF; _Pragma("unroll") for (int ks = 0; ks < 2; ++ks) { \
        const bf16x8 xf = *(const LAS bf16x8*)(_B + (nq * 16 + lq) * 144 + ks * 64 + g * 16); \
        _Pragma("unroll") for (int mt = 0; mt < 4; ++mt) { const bf16x8 wf = *(const LAS bf16x8*)(_B + GT_AP + (mh * 64 + mt * 16 + lq) * 144 + ks * 64 + g * 16); \
            acc[mt] = __builtin_amdgcn_mfma_f32_16x16x32_bf16(wf, xf, acc[mt], 0, 0, 0); } } } while (0)
    GT_LOAD(0, aA, bA0, bA1);
    GT_LOAD(1, aB, bB0, bB1);
    __syncthreads();
    GT_STORE(0, aA, bA0, bA1);
    GT_LOAD(2, aA, bA0, bA1);
    __syncthreads();
    for (int kt = 0; kt < 16; kt += 2) {
        GT_COMPUTE(0);
        GT_STORE(1, aB, bB0, bB1);
        if (kt + 3 < 16) GT_LOAD(kt + 3, aB, bB0, bB1);
        __syncthreads();
        GT_COMPUTE(1);
        if (kt + 2 < 16) { GT_STORE(0, aA, bA0, bA1); if (kt + 4 < 16) GT_LOAD(kt + 4, aA, bA0, bA1); }
        __syncthreads();
    }
#undef GT_LOAD
#undef GT_STORE
#undef GT_COMPUTE
    const float ssum = ((q0[0] + q0[1]) + (q0[2] + q0[3])) + ((q1[0] + q1[1]) + (q1[2] + q1[3])) + ((q2[0] + q2[1]) + (q2[2] + q2[3])) + ((q3[0] + q3[1]) + (q3[2] + q3[3]));
    const float rs = rsqrtf(ssum * (1.0f / 1024.0f) + 1e-6f);
    bf16_t* gate = (bf16_t*)(p.ws + WS_GATE) + (size_t)tokrow * 1024 + 896 + mh * 64 + 4 * g;
#pragma unroll
    for (int mt = 0; mt < 4; ++mt) {
        f32x4 v = acc[mt] * rs;
#pragma unroll
        for (int j = 0; j < 4; ++j) v[j] = v[j] * __builtin_amdgcn_rcpf(1.0f + __expf(-v[j]));
        u32x2 w; w.x = pk2(v[0], v[1]); w.y = pk2(v[2], v[3]);
        *(u32x2*)(gate + mt * 16) = w;
    }
}

#define XB_TMO      128
#define XB_XCNT(j)  (256  + 64 * (j))
#define XB_XSUB(j)  (1280 + 64 * (j))
#define XB_XGEN(j)  (2304 + 64 * (j))
#define XB_TOP      3328
#define XB_TOPGEN   3392
#define XCD_BAR_WORDS 3456
#define XB_SPIN_CAP (1u << 18)

__device__ __forceinline__ unsigned xb_ld(unsigned* p)              { return __hip_atomic_load(p, __ATOMIC_RELAXED, __HIP_MEMORY_SCOPE_AGENT); }
__device__ __forceinline__ unsigned xb_add(unsigned* p, unsigned v) { return __hip_atomic_fetch_add(p, v, __ATOMIC_RELAXED, __HIP_MEMORY_SCOPE_AGENT); }
__device__ __forceinline__ unsigned xb_xcc_id() { return (unsigned)__builtin_amdgcn_s_getreg((3 << 11) | 20) & 0xFu; }
#define XB_SPIN(cond, bar) do { unsigned _sp = 0; while (cond) { __builtin_amdgcn_s_sleep(1); \
    if ((++_sp & 255u) == 0u) { if (xb_ld(&(bar)[XB_TMO])) break; if (_sp > XB_SPIN_CAP) { atomicAdd(&(bar)[XB_TMO], 1u); break; } } } } while (0)

struct XcdBarrier {
    unsigned* bar; unsigned x;
    volatile LAS unsigned* st;
};

__device__ __forceinline__ XcdBarrier xcd_barrier_post(unsigned* bar, volatile LAS unsigned* st) {
    XcdBarrier b; b.bar = bar; b.x = xb_xcc_id(); b.st = st;
    if (threadIdx.x == 0) (void)xb_add(&bar[XB_XCNT(b.x)], 1u);
    return b;
}
__device__ __forceinline__ void xcd_barrier_complete(unsigned* bar, unsigned x, unsigned& nloc, unsigned& nx) {
    const unsigned G = gridDim.x * gridDim.y * gridDim.z;
    unsigned sum, cnt, mine, sp = 0u;
    for (;;) {
        sum = 0u; cnt = 0u; mine = 0u;
#pragma unroll
        for (unsigned j = 0; j < 16; ++j) { const unsigned c = xb_ld(&bar[XB_XCNT(j)]); sum += c; cnt += (c > 0u) ? 1u : 0u; mine = (j == x) ? c : mine; }
        if (sum == G) break;
        __builtin_amdgcn_s_sleep(1);
        if ((++sp & 255u) == 0u) { if (xb_ld(&bar[XB_TMO])) break; if (sp > XB_SPIN_CAP) { atomicAdd(&bar[XB_TMO], 1u); break; } }
    }
    nloc = mine > 0u ? mine : 1u; nx = cnt > 0u ? cnt : 1u;
}

__device__ __forceinline__ void xcd_barrier(const XcdBarrier& b) {
    asm volatile("s_waitcnt vmcnt(0)" ::: "memory");
    __syncthreads();
    if (threadIdx.x == 0) {
        unsigned* bar = b.bar;
        __builtin_amdgcn_s_waitcnt(0);
        unsigned nloc = b.st[0], nx = b.st[1];
        if (nloc == 0u) { xcd_barrier_complete(bar, b.x, nloc, nx); b.st[0] = nloc; b.st[1] = nx; }
        const unsigned old = xb_add(&bar[XB_XSUB(b.x)], 1u);
        const unsigned gen = old / nloc;
        if (old + 1u == (gen + 1u) * nloc) {
            __builtin_amdgcn_fence(__ATOMIC_RELEASE, "agent");
            asm volatile("s_waitcnt vmcnt(0)" ::: "memory");
            const unsigned og = xb_add(&bar[XB_TOP], 1u);
            const unsigned tg = og / nx;
            if (og + 1u == (tg + 1u) * nx) xb_add(&bar[XB_TOPGEN], 1u);
            else XB_SPIN(xb_ld(&bar[XB_TOPGEN]) == tg, bar);
            __builtin_amdgcn_fence(__ATOMIC_ACQUIRE, "agent");
            xb_add(&bar[XB_XGEN(b.x)], 1u);
            asm volatile("s_waitcnt vmcnt(0)" ::: "memory");
        } else {
            XB_SPIN(xb_ld(&bar[XB_XGEN(b.x)]) == gen, bar);
            __builtin_amdgcn_fence(__ATOMIC_ACQUIRE, "agent");
            asm volatile("s_waitcnt vmcnt(0)" ::: "memory");
        }
    }
    __syncthreads();
}

__global__ void __launch_bounds__(512, 2) hymba_fwd(Params p) {
    extern __shared__ __attribute__((aligned(16))) unsigned char shm[];
    LAS unsigned char* lds = (LAS unsigned char*)shm;
    cg::grid_group grid = cg::this_grid();
    volatile LAS unsigned* xbst = (volatile LAS unsigned*)(lds + 131072);
    if (threadIdx.x < 4) xbst[threadIdx.x] = 0u;
    __syncthreads();
    XcdBarrier xb = xcd_barrier_post(p.bar, xbst);
    for (int ph = p.ph_lo; ph < p.ph_hi; ++ph) {
        if (ph > p.ph_lo) { if (ph > 1000) grid.sync(); else xcd_barrier(xb); }
#ifndef NO_P0
        if (ph == 0) { phase_prologue(p, lds); continue; }
#endif
        const int l = (ph - 1) / 5, sub = (ph - 1) % 5;
#ifdef REP_SUB
      for (int rep_i = 0; rep_i < ((sub == REP_SUB) ? 2 : 1); ++rep_i) {
        if (rep_i) xcd_barrier(xb);
#endif
        if (sub == 0) {
            pg8::Gemm g; g.A = (const bf16_t*)(p.ws + WS_XB); g.Bt = (const bf16_t*)(p.ws + ((l & 1) ? WS_WIN1 : WS_WIN)); g.M = T_TOK; g.N = 4096; g.K = 1024;
            pg8::StaticOrder S; S.init(g.M, g.N, (int)gridDim.x, (int)blockIdx.x);
            LAS float* rsl = (LAS float*)(lds + 131072 + 16);
            {
                pg8::Unit u0; S.next(0, u0);
                const int tid = tidx(), r = tid >> 1, hf = tid & 1;
                const float* q = (const float*)(p.ws + WS_SSQ) + (size_t)(u0.pm * 256 + r) * 16 + hf * 8;
                const f32x4 a = *(const f32x4*)q, bq4 = *(const f32x4*)(q + 4);
                float sm = ((a[0] + a[1]) + (a[2] + a[3])) + ((bq4[0] + bq4[1]) + (bq4[2] + bq4[3]));
                sm += __shfl_xor(sm, 1);
                if (hf == 0) rsl[r] = rsqrtf(sm * (1.0f / 1024.0f) + 1e-6f);
                __syncthreads();
            }
            EpiIn E; E.pa = (bf16_t*)(p.ws + WS_PA); E.pbc = (bf16_t*)(p.ws + WS_PBC); E.gate = (bf16_t*)(p.ws + WS_GATE); E.rsl = rsl;
            pg8::gemm_phase<EpiIn, pg8::StaticOrder, false>(lds, g, S, E, nullptr);
        } else if (sub == 1) {
            const int nconv = 64 + (l < 3 ? 4 * 68 : 0);
            const int ntask = 1536 + 1536 + 256 + 256 + nconv + 256;
            {
                ChunkPre cpre;
                if ((int)blockIdx.x < 1536) rwkv_chunk_load(p, blockIdx.x, cpre);
                for (int t = blockIdx.x; t < 1536; t += gridDim.x) rwkv_chunk_task(p, l, t, (t + (int)gridDim.x < 1536) ? t + (int)gridDim.x : -1, cpre, lds);
            }
            for (int t = 1536 + blockIdx.x; t < ntask; t += gridDim.x) {
                if (t < 2304) dil_run(p, l, (t - 1536) / 384, (t - 1536) % 384, lds);
                else if (t < 3072) {}
                else if (t < 3328) kmean_task(p, l, t - 3072, lds);
                else if (t < 3584) gate_tail_task(p, l, t - 3328, lds);
                else if (t >= 3584 + nconv) moba_route_task(p, l, t - 3584 - nconv, lds);
                else { const int c = t - 3584;
                    if (c < 64) convert_strip4(p.in[I_WOUT] + (size_t)l * 1024 * 1024, 1024, 1024, nullptr, (bf16_t*)(p.ws + WS_WOUT), (c & 3) * 4, c >> 2, lds);
                    else { const int u = c - 64; convert_strip4(p.in[I_WIN] + (size_t)(l + 1) * 1024 * 4224, 4224, 4224, p.in[I_NORMG] + (l + 1) * 1024, (bf16_t*)(p.ws + (((l + 1) & 1) ? WS_WIN1 : WS_WIN)), (u & 3) * 4, u >> 2, lds); }
                }
            }
        } else if (sub == 2) {
            if (blockIdx.x < 24) recur_task(p, l, blockIdx.x, lds);
            {
                LAS int* tnum = (LAS int*)(lds + 98304); LAS int* tstart = tnum + 256;
                const unsigned* cnt = (const unsigned*)(p.ws + WS_CNT) + l * 256;
                __syncthreads();
                if (threadIdx.x < 256) tnum[threadIdx.x] = (int)((cnt[threadIdx.x] + 127u) >> 7);
                __syncthreads();
                if (threadIdx.x < 64) {
                    const int a0 = tnum[4 * threadIdx.x], a1 = tnum[4 * threadIdx.x + 1], a2 = tnum[4 * threadIdx.x + 2], a3 = tnum[4 * threadIdx.x + 3];
                    const int sl = a0 + a1 + a2 + a3; int inc = sl;
#pragma unroll
                    for (int d = 1; d < 64; d <<= 1) { const int o = __shfl_up(inc, d); if ((int)threadIdx.x >= d) inc += o; }
                    const int ex = inc - sl;
                    tstart[4 * threadIdx.x] = ex; tstart[4 * threadIdx.x + 1] = ex + a0; tstart[4 * threadIdx.x + 2] = ex + a0 + a1; tstart[4 * threadIdx.x + 3] = ex + a0 + a1 + a2;
                    if (threadIdx.x == 63) tstart[256] = inc;
                }
                __syncthreads();
                const int total = tstart[256];
                auto lookup = [&](int t, int& e, int& i) { int lo = 0, hi = 256;
                    while (hi - lo > 1) { const int mid = (lo + hi) >> 1; if (tstart[mid] <= t) lo = mid; else hi = mid; }
                    e = lo; i = t - tstart[lo]; };
                auto cumw = [&](int w) -> long long { if (gridDim.x != 256u) return (long long)w * 28808ll / (long long)gridDim.x;
                    return w < 24 ? 82ll * w : (w < 176 ? 1968ll + 95ll * (w - 24) : 16408ll + 155ll * (w - 176)); };
                int t = (int)(((long long)total * cumw((int)blockIdx.x)) / 28808ll);
                const int t1 = (int)(((long long)total * cumw((int)blockIdx.x + 1)) / 28808ll);
                while (t < t1) {
                    int e, i; lookup(t, e, i);
                    const int iend = (tnum[e] - i < t1 - t) ? tnum[e] : i + (t1 - t);
                    moba_gather_run(p, l, e, i, iend, (int)cnt[e], lds);
                    t += iend - i;
                }
            }
            if (blockIdx.x >= 24) for (int t = blockIdx.x - 24; t < 384; t += gridDim.x - 24) dil_run(p, l, 2, t, lds);
        } else if (sub == 3) {
            for (int t = blockIdx.x; t < 256; t += gridDim.x) moba_own_run(p, l, t, lds);
            {
                if (threadIdx.x < 64) {
                    const unsigned* fl = (const unsigned*)(p.ws + WS_FLAG); unsigned spins = 0;
                    for (;;) {
                        const unsigned v = (threadIdx.x < 24) ? __hip_atomic_load(fl + threadIdx.x, __ATOMIC_RELAXED, __HIP_MEMORY_SCOPE_AGENT) : 0xFFFFFFFFu;
                        if (__all(v >= (unsigned)(l + 1)) || ++spins > (1u << 22)) break;
                        __builtin_amdgcn_s_sleep(2);
                    }
                    __builtin_amdgcn_fence(__ATOMIC_ACQUIRE, "agent");
                    asm volatile("s_waitcnt vmcnt(0)" ::: "memory");
                }
                __syncthreads();
            }
            for (int t = blockIdx.x; t < 768; t += gridDim.x) rwkv_out_task(p, l, t);
        } else {
            pg8::Gemm g; g.A = (const bf16_t*)(p.ws + WS_YG); g.Bt = (const bf16_t*)(p.ws + WS_WOUT); g.M = T_TOK; g.N = 1024; g.K = 1024;
            pg8::StaticOrder S; S.init(g.M, g.N, (int)gridDim.x, (int)blockIdx.x);
            EpiOut E; E.out = p.out; E.xb = (bf16_t*)(p.ws + WS_XB); E.ssq = (float*)(p.ws + WS_SSQ); E.last = (l == 3) ? 1 : 0;
#ifndef NO_G2
            pg8::gemm_phase<EpiOut, pg8::StaticOrder, false>(lds, g, S, E, nullptr);
#endif
        }
#ifdef REP_SUB
      }
#endif
    }
}

#ifndef MK_MULTI
#define MK_MULTI 0
#endif
extern "C" void kernel_launch(void* const* d_in, const int* in_sizes, int n_in, void* d_out, int out_size, void* d_ws, size_t ws_size, hipStream_t stream) {
    static int grid = 0;
    if (grid == 0) {
        int dev = 0, cus = 0, per_cu = 0;
        hipGetDevice(&dev);
        hipDeviceGetAttribute(&cus, hipDeviceAttributeMultiprocessorCount, dev);
        if (hipFuncSetAttribute((const void*)hymba_fwd, hipFuncAttributeMaxDynamicSharedMemorySize, LDS_BYTES) != hipSuccess) fprintf(stderr, "kernel_launch: hipFuncSetAttribute failed\n");
        if (hipOccupancyMaxActiveBlocksPerMultiprocessor(&per_cu, (const void*)hymba_fwd, NTHR, LDS_BYTES) != hipSuccess || per_cu < 1) { fprintf(stderr, "kernel_launch: occupancy query gave %d\n", per_cu); per_cu = 1; }
        (void)hipGetLastError();
        if (cus <= 0) cus = 256;
        grid = cus;
        if (ws_size < WS_END) fprintf(stderr, "kernel_launch: workspace too small: %zu < %zu\n", ws_size, (size_t)WS_END);
    }
    Params p{};
    for (int i = 0; i < 18; ++i) p.in[i] = (const float*)d_in[i];
    p.out = (float*)d_out; p.ws = (unsigned char*)d_ws; p.bar = (unsigned*)((unsigned char*)d_ws + WS_BAR);
    (void)hipMemsetAsync((unsigned char*)d_ws + WS_BAR, 0, (size_t)XCD_BAR_WORDS_C * 4 + 256 + 4096 + 256, stream);
#if MK_MULTI
    for (int ph = 0; ph < 21; ++ph) {
        p.ph_lo = ph; p.ph_hi = ph + 1;
        hipLaunchKernelGGL(hymba_fwd, dim3(grid), dim3(NTHR), LDS_BYTES, stream, p);
    }
#else
    p.ph_lo = 0; p.ph_hi = 21;
    void* args[] = {&p};
    hipError_t e = hipLaunchCooperativeKernel((const void*)hymba_fwd, dim3(grid), dim3(NTHR), args, LDS_BYTES, stream);
    if (e != hipSuccess) fprintf(stderr, "cooperative launch failed: %s (grid %d)\n", hipGetErrorString(e), grid);
#endif
}
```

```cpp
#include <hip/hip_runtime.h>
#include <hip/hip_cooperative_groups.h>
#include <cstdio>
namespace cg = cooperative_groups;
__device__ __forceinline__ int tidx() { int t = threadIdx.x; asm volatile("" : "+v"(t)); return t; }
namespace pg8 {
#define PG8_LAS __attribute__((address_space(3)))
typedef unsigned short bf16_t;
typedef short bf16x8 __attribute__((ext_vector_type(8)));
typedef float f32x4 __attribute__((ext_vector_type(4)));
typedef unsigned u32x4 __attribute__((ext_vector_type(4)));
constexpr int BM = 256, BK = 64, HALF = 128, HTB = HALF * BK * 2  , STAGE_BYTES = 8 * HTB, NXCD = 8, WGM = 8;

__host__ __device__ __forceinline__ int lds_byte(int r, int c) { const int st = (r >> 4) * 2 + (c >> 5), rr = r & 15, cc = c & 31, ob = rr * 64 + cc * 2; return st * 1024 + (ob ^ (((ob >> 9) & 1) << 5)); }
__host__ __device__ __forceinline__ void stage_rc(int b, int& R, int& C) { const int st = b / 1024, sb = b % 1024, swz = sb ^ (((sb >> 9) & 1) << 5); R = (st >> 1) * 16 + swz / 64; C = (st & 1) * 32 + (swz % 64) / 2; }
__host__ __device__ __forceinline__ int perm32(int rho) { const int n = rho >> 4, i = rho & 15; return 8 * (i >> 2) + 4 * n + (i & 3); }

struct Unit { int pm, pn; };
struct Gemm { const bf16_t* A; const bf16_t* Bt; int M, N, K; };

struct StaticOrder {
    int nM, nN, nwg, G, c;
    __host__ __device__ void init(int M, int N, int G_, int c_) { nM = M / BM; nN = N / BM; nwg = nM * nN; G = G_; c = c_; }
    __host__ __device__ bool next(int i, Unit& u) const {
        const long L = (long)i * G + c; if (L >= nwg) return false;
        int wgid = (int)L; { const int q = nwg / NXCD, r = nwg % NXCD, xcd = wgid % NXCD, off = wgid / NXCD; wgid = (xcd < r ? xcd * (q + 1) : r * (q + 1) + (xcd - r) * q) + off; }
        const int nig = WGM * nN, gid = wgid / nig, fm = gid * WGM, gsz = (nM - fm) < WGM ? (nM - fm) : WGM;
        u.pm = fm + ((wgid % nig) % gsz); u.pn = (wgid % nig) / gsz; return true;
    }
    __device__ __forceinline__ void a_ready(const Unit&) const {}
    __device__ __forceinline__ void done(const Unit&) const {}
};
__device__ __forceinline__ unsigned cvt_pk_bf16(float lo, float hi) { unsigned r; asm volatile("v_cvt_pk_bf16_f32 %0, %1, %2" : "=v"(r) : "v"(lo), "v"(hi)); return r; }
typedef float f32x2 __attribute__((ext_vector_type(2)));
template <class Epi, class Sched, bool STAMP = false>
__device__ __forceinline__ void gemm_phase(PG8_LAS unsigned char* lds, const Gemm g, const Sched& S, const Epi& E, unsigned long long* stamps) {
    const int tid = tidx(), wid = __builtin_amdgcn_readfirstlane(tid >> 6), lane = tid & 63, wr = wid >> 2, wc = wid & 3, fr = lane & 15, fq = lane >> 4;
    const int K = g.K, nt = K / BK;
    int ts_lo = 0, ts_hi = 0, nts = 0; const unsigned long long rt_entry = STAMP ? (unsigned long long)wall_clock64() : 0ull;
#define PG8_STAMP() do { if (STAMP && wid == 0 && nts < 64) { const unsigned long long _c = (unsigned long long)clock64(); \
        ts_lo = (lane == nts) ? (int)(unsigned)_c : ts_lo; ts_hi = (lane == nts) ? (int)(unsigned)(_c >> 32) : ts_hi; ++nts; } } while (0)
    PG8_STAMP();
    unsigned voffA[2], voffB[2];
#pragma unroll
    for (int i = 0; i < 2; ++i) { int R, C; stage_rc(tid * 16 + i * 8192, R, C); const int Rb = Epi::PERM ? ((R & ~31) + perm32(R & 31)) : R;
        voffA[i] = (unsigned)(R * K + C) * 2u; voffB[i] = (unsigned)(Rb * K + C) * 2u; }
    const size_t kstep = (size_t)(BK * 2);
    const size_t hstep = (size_t)HALF * K * 2;
    const size_t tstep = 2 * hstep;
    const unsigned ldsw = (unsigned)wid * 1024u;
    const int aoff = lds_byte(wr * 64 + fr, fq * 8), boff = lds_byte(wc * 32 + fr, fq * 8);
#define PG8_SA(b, h) (((b) * 2 + (h)) * HTB)
#define PG8_SB(b, h) ((4 + (b) * 2 + (h)) * HTB)
#define PG8_STAGE(bufoff, gbase, voff) do { _Pragma("unroll") for (int _i = 0; _i < 2; ++_i) \
        __builtin_amdgcn_global_load_lds((const unsigned*)((const char*)(gbase) + (voff)[_i]), (PG8_LAS unsigned*)(lds + (bufoff) + ldsw + _i * 8192), 16, 0, 0); } while (0)
#define PG8_LDA(dst, b, h) do { _Pragma("unroll") for (int m = 0; m < 4; ++m) _Pragma("unroll") for (int k = 0; k < 2; ++k) dst[m][k] = *(const PG8_LAS bf16x8*)(lds + PG8_SA(b, h) + aoff + m * 2048 + k * 1024); } while (0)
#define PG8_LDB(dst, b, h) do { _Pragma("unroll") for (int n = 0; n < 2; ++n) _Pragma("unroll") for (int k = 0; k < 2; ++k) dst[n][k] = *(const PG8_LAS bf16x8*)(lds + PG8_SB(b, h) + boff + n * 2048 + k * 1024); } while (0)
#define PG8_MMA(ai, bj, At, Bt) do { __builtin_amdgcn_s_setprio(1); _Pragma("unroll") for (int m = 0; m < 4; ++m) _Pragma("unroll") for (int n = 0; n < 2; ++n) _Pragma("unroll") for (int k = 0; k < 2; ++k) \
        acc[ai][bj][m][n] = __builtin_amdgcn_mfma_f32_16x16x32_bf16(Bt[n][k], At[m][k], acc[ai][bj][m][n], 0, 0, 0); __builtin_amdgcn_s_setprio(0); } while (0)
#define PG8_WAIT_V(n) asm volatile("s_waitcnt vmcnt(" #n ")" ::: "memory")
#define PG8_WAIT_L(n) asm volatile("s_waitcnt lgkmcnt(" #n ")" ::: "memory")
#define PG8_BAR __builtin_amdgcn_s_barrier()
#define PG8_SCHED __builtin_amdgcn_sched_barrier(0)
    Unit cur, nxt; int ui = 0;
    if (!S.next(0, cur)) return;
    f32x4 acc[2][2][4][2];
#pragma unroll
    for (int a = 0; a < 2; ++a)
#pragma unroll
        for (int b = 0; b < 2; ++b)
#pragma unroll
            for (int m = 0; m < 4; ++m)
#pragma unroll
                for (int n = 0; n < 2; ++n) acc[a][b][m][n] = (f32x4){0.f, 0.f, 0.f, 0.f};
    bf16x8 At[4][2], B0[2][2], B1[2][2];
    const char* cA = (const char*)g.A + (size_t)cur.pm * tstep; const char* cB = (const char*)g.Bt + (size_t)cur.pn * tstep;
    S.a_ready(cur);
    PG8_STAGE(PG8_SB(0, 0), cB, voffB); PG8_STAGE(PG8_SA(0, 0), cA, voffA); PG8_STAGE(PG8_SB(0, 1), cB + hstep, voffB); PG8_STAGE(PG8_SA(0, 1), cA + hstep, voffA);
    if (wr == 1) PG8_BAR;
    PG8_WAIT_V(4); PG8_BAR;
    PG8_STAGE(PG8_SB(1, 0), cB + kstep, voffB); PG8_STAGE(PG8_SA(1, 0), cA + kstep, voffA); PG8_STAGE(PG8_SB(1, 1), cB + hstep + kstep, voffB);
    PG8_WAIT_V(6); PG8_BAR;
    PG8_STAMP();
    for (;;) {
        const bool has_next = S.next(ui + 1, nxt);
        const char* nA = has_next ? (const char*)g.A + (size_t)nxt.pm * tstep : cA; const char* nB = has_next ? (const char*)g.Bt + (size_t)nxt.pn * tstep : cB;
        for (int t = 0; t < nt; t += 2) {
            const bool last = (t == nt - 2);
            const char* a1 = cA + (size_t)(t + 1) * kstep;
            const char* a2 = last ? nA : cA + (size_t)(t + 2) * kstep; const char* b2 = last ? nB : cB + (size_t)(t + 2) * kstep;
            const char* a3 = a2 + kstep; const char* b3 = b2 + kstep;
            if (last && has_next) S.a_ready(nxt);
            PG8_LDB(B0, 0, 0); PG8_SCHED; PG8_LDA(At, 0, 0); PG8_STAGE(PG8_SA(1, 1), a1 + hstep, voffA);
            PG8_WAIT_L(8); PG8_BAR; PG8_WAIT_L(0); PG8_MMA(0, 0, At, B0); PG8_BAR; PG8_SCHED;
            PG8_LDB(B1, 0, 1); PG8_STAGE(PG8_SB(0, 0), b2, voffB);
            PG8_BAR; PG8_WAIT_L(0); PG8_MMA(0, 1, At, B1); PG8_BAR;
            PG8_LDA(At, 0, 1); PG8_STAGE(PG8_SA(0, 0), a2, voffA);
            PG8_BAR; PG8_WAIT_L(0); PG8_MMA(1, 0, At, B0); PG8_BAR; PG8_SCHED;
            PG8_STAGE(PG8_SB(0, 1), b2 + hstep, voffB);
            PG8_WAIT_V(6); PG8_BAR; PG8_MMA(1, 1, At, B1); PG8_BAR;
            PG8_LDB(B0, 1, 0); PG8_SCHED; PG8_LDA(At, 1, 0); PG8_STAGE(PG8_SA(0, 1), a2 + hstep, voffA);
            PG8_WAIT_L(8); PG8_BAR; PG8_WAIT_L(0); PG8_MMA(0, 0, At, B0); PG8_BAR; PG8_SCHED;
            PG8_LDB(B1, 1, 1); PG8_STAGE(PG8_SB(1, 0), b3, voffB);
            PG8_BAR; PG8_WAIT_L(0); PG8_MMA(0, 1, At, B1); PG8_BAR;
            PG8_LDA(At, 1, 1); PG8_STAGE(PG8_SA(1, 0), a3, voffA);
            PG8_BAR; PG8_WAIT_L(0); PG8_MMA(1, 0, At, B0); PG8_BAR; PG8_SCHED;
            PG8_STAGE(PG8_SB(1, 1), b3 + hstep, voffB);
            PG8_WAIT_V(6); PG8_BAR; PG8_MMA(1, 1, At, B1); PG8_BAR;
        }
        PG8_STAMP();
        if constexpr (!Epi::AFTER_DRAIN) { E(acc, cur, wr, wc, fr, fq); S.done(cur); }
        PG8_STAMP();
        if (!has_next) break;
#pragma unroll
        for (int a = 0; a < 2; ++a)
#pragma unroll
            for (int b = 0; b < 2; ++b)
#pragma unroll
                for (int m = 0; m < 4; ++m)
#pragma unroll
                    for (int n = 0; n < 2; ++n) acc[a][b][m][n] = (f32x4){0.f, 0.f, 0.f, 0.f};
        cur = nxt; cA = nA; cB = nB; ++ui;
    }
    PG8_WAIT_V(0);
    if (wr == 0) PG8_BAR;
    PG8_BAR;
    if constexpr (Epi::AFTER_DRAIN) { E.fused(acc, cur, wr, wc, fr, fq, lds, wid, lane); S.done(cur); }
    PG8_STAMP();
    if (STAMP && wid == 0) { stamps[lane] = lane < nts ? (((unsigned long long)(unsigned)ts_hi << 32) | (unsigned)ts_lo) : 0ull;
        if (lane == 62) stamps[62] = rt_entry; if (lane == 63) stamps[63] = (unsigned long long)wall_clock64(); }
#undef PG8_STAMP
#undef PG8_SA
#undef PG8_SB
#undef PG8_STAGE
#undef PG8_LDA
#undef PG8_LDB
#undef PG8_MMA
#undef PG8_WAIT_V
#undef PG8_WAIT_L
#undef PG8_BAR
#undef PG8_SCHED
}
}

#define LAS __attribute__((address_space(3)))
typedef unsigned short bf16_t;
typedef short bf16x8 __attribute__((ext_vector_type(8)));
typedef float f32x4 __attribute__((ext_vector_type(4)));
typedef unsigned u32x4 __attribute__((ext_vector_type(4)));
typedef unsigned u32x2 __attribute__((ext_vector_type(2)));
typedef short s16x4 __attribute__((ext_vector_type(4)));

constexpr int T_TOK = 16384, SEQ = 4096, DM = 1024;
constexpr int PWP = 4352, PA_W = 1280, PBC_W = 1920;
constexpr int NTHR = 512;
constexpr int XCD_BAR_WORDS_C = 3456;
constexpr int LDS_BYTES = 131072 + 16 + 1024;
constexpr size_t WS_WIN = 0;
constexpr size_t WS_WOUT = WS_WIN + (size_t)PWP * 1024 * 2;
constexpr size_t WS_XB = WS_WOUT + (size_t)1024 * 1024 * 2;
constexpr size_t WS_SSQ = WS_XB + (size_t)T_TOK * 1024 * 2;
constexpr size_t WS_PA = WS_SSQ + (size_t)T_TOK * 16 * 4;
constexpr size_t WS_PBC = WS_PA + (size_t)T_TOK * PA_W * 2;
constexpr size_t WS_GATE = WS_PBC + (size_t)T_TOK * PBC_W * 2;
constexpr size_t WS_GT = WS_GATE + (size_t)T_TOK * 1024 * 2;
constexpr size_t WS_HM = WS_GT + (size_t)1536 * 4096 * 2;
constexpr size_t WS_QQ = WS_HM + (size_t)1536 * 4096 * 2;
constexpr size_t WS_Y0 = WS_QQ + (size_t)1536 * 4096 * 2;
constexpr size_t WS_BV = WS_Y0 + (size_t)1536 * 4096 * 2;
constexpr size_t WS_SC = WS_BV + (size_t)1536 * 4096 * 2;
constexpr size_t WS_KMEAN = WS_SC + (size_t)1536 * 4096 * 2;
constexpr size_t WS_BAR = WS_KMEAN + (size_t)4 * 4 * 16 * 64 * 4;
constexpr size_t WS_FLAG = WS_BAR + (size_t)XCD_BAR_WORDS_C * 4;
constexpr size_t WS_CNT = WS_FLAG + 256;
constexpr size_t WS_KMC = WS_CNT + 4096;
constexpr size_t WS_WIN1 = WS_KMC + 256;
constexpr size_t WS_END = WS_WIN1 + (size_t)PWP * 1024 * 2;
constexpr size_t WS_YG = WS_PA;

struct Params {
    const float* in[18];
    float* out;
    unsigned char* ws;
    unsigned* bar;
    int ph_lo, ph_hi;
};
enum { I_X = 0, I_NORMG, I_WIN, I_WOUT, I_MU, I_W0, I_WUP, I_A0, I_AUP, I_KK, I_KA, I_RK, I_LNG, I_LNB, I_MQG, I_MKG, I_DQG, I_DKG };

__device__ __forceinline__ float bf2f(bf16_t b) { return __uint_as_float(((unsigned)b) << 16); }
__device__ __forceinline__ bf16_t f2bf(float f) { unsigned u = __float_as_uint(f); u += 0x7FFFu + ((u >> 16) & 1u); return (bf16_t)(u >> 16); }
__device__ __forceinline__ unsigned pk2(float lo, float hi) { unsigned r; asm("v_cvt_pk_bf16_f32 %0, %1, %2" : "=v"(r) : "v"(lo), "v"(hi)); return r; }
__device__ __forceinline__ float bflo(unsigned w) { return __uint_as_float(w << 16); }
__device__ __forceinline__ float bfhi(unsigned w) { return __uint_as_float(w & 0xFFFF0000u); }
__device__ __forceinline__ float wsum64(float v) {
    v += __shfl_xor(v, 1); v += __shfl_xor(v, 2); v += __shfl_xor(v, 4); v += __shfl_xor(v, 8); v += __shfl_xor(v, 16); v += __shfl_xor(v, 32); return v;
}
__device__ __forceinline__ float sum8(float v) { v += __shfl_xor(v, 1); v += __shfl_xor(v, 2); v += __shfl_xor(v, 4); return v; }
template <int CTRL> __device__ __forceinline__ float dppf(float x) { return __int_as_float(__builtin_amdgcn_update_dpp(0, __float_as_int(x), CTRL, 0xF, 0xF, true)); }
__device__ __forceinline__ float dsum8(float v) { v += dppf<0xB1>(v); v += dppf<0x4E>(v); v += dppf<0x141>(v); return v; }

struct EpiIn {
    static constexpr bool PERM = true, AFTER_DRAIN = false;
    bf16_t* pa; bf16_t* pbc; bf16_t* gate; const LAS float* rsl;
    __device__ __forceinline__ void operator()(const f32x4 (&acc)[2][2][4][2], const pg8::Unit& u, int wr, int wc, int fr_, int fq_) const {
        int fr = fr_, fq = fq_; asm volatile("" : "+v"(fr), "+v"(fq));
        const int row0 = u.pm * 256 + wr * 64 + fr;
#pragma unroll
        for (int ai = 0; ai < 2; ++ai)
#pragma unroll
            for (int m = 0; m < 4; ++m) {
                const int row = row0 + ai * 128 + m * 16;
                const float rs = rsl[row & 255];
#pragma unroll
                for (int bj = 0; bj < 2; ++bj) {
                    const int c128 = u.pn * 2 + bj;
                    const int col = c128 * 128 + wc * 32 + 8 * fq;
                    f32x4 v0 = acc[ai][bj][m][0] * rs, v1 = acc[ai][bj][m][1] * rs;
                    bf16_t* dst;
                    if (c128 < 10) dst = pa + (size_t)row * PA_W + col;
                    else if (c128 < 25) dst = pbc + (size_t)row * PBC_W + (col - 1280);
                    else if (c128 < 33) {
                        dst = gate + (size_t)row * 1024 + (col - 3200);
#pragma unroll
                        for (int j = 0; j < 4; ++j) { v0[j] = v0[j] * __builtin_amdgcn_rcpf(1.0f + __expf(-v0[j])); v1[j] = v1[j] * __builtin_amdgcn_rcpf(1.0f + __expf(-v1[j])); }
                    } else continue;
                    u32x4 w; w.x = pk2(v0[0], v0[1]); w.y = pk2(v0[2], v0[3]); w.z = pk2(v1[0], v1[1]); w.w = pk2(v1[2], v1[3]);
                    *(u32x4*)dst = w;
                }
            }
    }
};
struct EpiOut {
    static constexpr bool PERM = true, AFTER_DRAIN = false;
    float* out; bf16_t* xb; float* ssq; int last;
    __device__ __forceinline__ void operator()(const f32x4 (&acc)[2][2][4][2], const pg8::Unit& u, int wr, int wc, int fr_, int fq_) const {
        int fr = fr_, fq = fq_; asm volatile("" : "+v"(fr), "+v"(fq));
        const int row0 = u.pm * 256 + wr * 64 + fr;
#pragma unroll
        for (int ai = 0; ai < 2; ++ai)
#pragma unroll
            for (int m = 0; m < 4; ++m) {
                const int row = row0 + ai * 128 + m * 16;
                float sq = 0.f;
#pragma unroll
                for (int bj = 0; bj < 2; ++bj) {
                    const int col = u.pn * 256 + bj * 128 + wc * 32 + 8 * fq;
                    const size_t off = (size_t)row * 1024 + col;
                    const u32x4 r = *(const u32x4*)(xb + off);
                    const f32x4 v0 = acc[ai][bj][m][0] + (f32x4){bflo(r.x), bfhi(r.x), bflo(r.y), bfhi(r.y)}, v1 = acc[ai][bj][m][1] + (f32x4){bflo(r.z), bfhi(r.z), bflo(r.w), bfhi(r.w)};
                    if (last) { *(f32x4*)(out + off) = v0; *(f32x4*)(out + off + 4) = v1; }
                    else {
                        u32x4 w; w.x = pk2(v0[0], v0[1]); w.y = pk2(v0[2], v0[3]); w.z = pk2(v1[0], v1[1]); w.w = pk2(v1[2], v1[3]);
                        *(u32x4*)(xb + off) = w;
                        sq += (v0[0] * v0[0] + v0[1] * v0[1]) + (v0[2] * v0[2] + v0[3] * v0[3]) + (v1[0] * v1[0] + v1[1] * v1[1]) + (v1[2] * v1[2] + v1[3] * v1[3]);
                    }
                }
                if (!last) {
                    sq += __shfl_xor(sq, 16); sq += __shfl_xor(sq, 32);
                    if (fq == 0) ssq[(size_t)row * 16 + u.pn * 4 + wc] = sq;
                }
            }
    }
};

__device__ __forceinline__ void convert_tile(const float* __restrict__ W, int N, int Nvalid, const float* __restrict__ g, bf16_t* __restrict__ Wt, int tk, int tn, LAS unsigned char* lds) {
    LAS float* tl = (LAS float*)lds;
    const int tid = tidx(), r = tid >> 3, c8 = (tid & 7) * 8, n0 = tn * 64, k0 = tk * 64;
    __syncthreads();
    if (n0 < Nvalid) {
        const float* src = W + (size_t)(k0 + r) * N + n0 + c8;
        const f32x4 a = *(const f32x4*)src, b = *(const f32x4*)(src + 4);
        const float gs = g ? g[k0 + r] : 1.0f;
#pragma unroll
        for (int j = 0; j < 4; ++j) { tl[r * 65 + c8 + j] = a[j] * gs; tl[r * 65 + c8 + 4 + j] = b[j] * gs; }
    }
    __syncthreads();
    u32x4 w = {0u, 0u, 0u, 0u};
    if (n0 < Nvalid) {
        float v[8];
#pragma unroll
        for (int j = 0; j < 8; ++j) v[j] = tl[(c8 + j) * 65 + r];
        w.x = pk2(v[0], v[1]); w.y = pk2(v[2], v[3]); w.z = pk2(v[4], v[5]); w.w = pk2(v[6], v[7]);
    }
    *(u32x4*)(Wt + (size_t)(n0 + r) * 1024 + k0 + c8) = w;
}

__device__ __forceinline__ void convert_strip4(const float* __restrict__ W, int N, int Nvalid, const float* __restrict__ g, bf16_t* __restrict__ Wt, int tk0, int tn, LAS unsigned char* lds) {
    LAS float* tl = (LAS float*)lds;
    const int tid = tidx(), r = tid >> 3, c8 = (tid & 7) * 8, n0 = tn * 64;
    const bool valid = n0 < Nvalid;
    __syncthreads();
    if (valid) {
        f32x4 a[4], b[4]; float gs[4];
#pragma unroll
        for (int i = 0; i < 4; ++i) {
            const float* src = W + (size_t)((tk0 + i) * 64 + r) * N + n0 + c8;
            a[i] = *(const f32x4*)src; b[i] = *(const f32x4*)(src + 4);
            gs[i] = g ? g[(tk0 + i) * 64 + r] : 1.0f;
        }
#pragma unroll
        for (int i = 0; i < 4; ++i)
#pragma unroll
            for (int j = 0; j < 4; ++j) { tl[i * 4160 + r * 65 + c8 + j] = a[i][j] * gs[i]; tl[i * 4160 + r * 65 + c8 + 4 + j] = b[i][j] * gs[i]; }
    }
    __syncthreads();
#pragma unroll
    for (int i = 0; i < 4; ++i) {
        u32x4 w = {0u, 0u, 0u, 0u};
        if (valid) {
            float v[8];
#pragma unroll
            for (int j = 0; j < 8; ++j) v[j] = tl[i * 4160 + (c8 + j) * 65 + r];
            w.x = pk2(v[0], v[1]); w.y = pk2(v[2], v[3]); w.z = pk2(v[4], v[5]); w.w = pk2(v[6], v[7]);
        }
        *(u32x4*)(Wt + (size_t)(n0 + r) * 1024 + (tk0 + i) * 64 + c8) = w;
    }
}

__device__ __forceinline__ void phase_prologue(const Params& p, LAS unsigned char* lds) {
    const int tid = tidx(), wave = tid >> 6, lane = tid & 63;
    const float* x = p.in[I_X];
    bf16_t* xb = (bf16_t*)(p.ws + WS_XB); float* ssq = (float*)(p.ws + WS_SSQ);
    for (int row = blockIdx.x * 8 + wave; row < T_TOK; row += gridDim.x * 8) {
        const float* xr = x + (size_t)row * 1024;
        float s = 0.f;
#pragma unroll
        for (int i = 0; i < 4; ++i) {
            const f32x4 v = *(const f32x4*)(xr + i * 256 + lane * 4);
            s += (v[0] * v[0] + v[1] * v[1]) + (v[2] * v[2] + v[3] * v[3]);
            u32x2 w; w.x = pk2(v[0], v[1]); w.y = pk2(v[2], v[3]);
            *(u32x2*)(xb + (size_t)row * 1024 + i * 256 + lane * 4) = w;
        }
        s = wsum64(s);
        if (lane < 16) ssq[(size_t)row * 16 + lane] = (lane == 0) ? s : 0.f;
    }
    bf16_t* wint = (bf16_t*)(p.ws + WS_WIN);
    for (int t = blockIdx.x; t < 4 * 68; t += gridDim.x) convert_strip4(p.in[I_WIN], 4224, 4224, p.in[I_NORMG], wint, (t & 3) * 4, t >> 2, lds);
}

constexpr int KS_PITCH = 144;
constexpr int VT_PITCH = 144;
constexpr int AT_BUF = 64 * KS_PITCH + 64 * VT_PITCH;
constexpr int AT_KM = 2 * AT_BUF, AT_SEL = AT_KM + 4096, AT_ANY = AT_SEL + 512;
struct AttnOut { f32x4 o[4]; float m, l; };
constexpr size_t DO_LIST = (size_t)26 << 20;
constexpr size_t DO_PB = (size_t)28 << 20;
constexpr size_t DO_PL = (size_t)53 << 20;

template <class TK>
__device__ __forceinline__ void attn_core(const TK& tk, const bf16_t* __restrict__ qbase, const bf16_t* __restrict__ kbase, const bf16_t* __restrict__ vbase,
                                          const float* __restrict__ qg, const float* __restrict__ kg, LAS unsigned char* lds, AttnOut& R) {
    const int tid = tidx(), wave = tid >> 6, lane = tid & 63, qi = lane & 15, g = lane >> 4;
    const int mq = wave * 16 + qi;
    bf16x8 bq[2];
    const int kr = tid >> 3, pc = tid & 7;
    float kgv[8];
#pragma unroll
    for (int j = 0; j < 8; ++j) kgv[j] = kg[pc * 8 + j];
#pragma unroll
    for (int mo = 0; mo < 4; ++mo) R.o[mo] = (f32x4){0.f, 0.f, 0.f, 0.f};
    float l_run = 0.f;
    const int nt = tk.ntiles();
    auto next_on = [&](int j) { int jn = j + 1; while (jn < nt && !tk.tile_on(jn)) ++jn; return jn; };
    auto load_t = [&](int jj, u32x4& kreg, u32x4& vreg) {
        kreg = *(const u32x4*)(kbase + (size_t)tk.k_tok(jj, kr) * PBC_W + pc * 8);
        vreg = *(const u32x4*)(vbase + (size_t)tk.k_tok(jj, kr) * PBC_W + pc * 8);
    };
    auto store_t = [&](int buf, const u32x4& kreg, const u32x4& vreg) {
        LAS unsigned char* B = lds + buf * AT_BUF;
        float kf[8];
#pragma unroll
        for (int q = 0; q < 4; ++q) { kf[2 * q] = bflo(kreg[q]); kf[2 * q + 1] = bfhi(kreg[q]); }
        float ss = 0.f;
#pragma unroll
        for (int q = 0; q < 8; ++q) ss += kf[q] * kf[q];
        ss = dsum8(ss);
        const float ks = rsqrtf(ss * (1.0f / 64.0f) + 1e-6f);
        u32x4 w; w.x = pk2(kf[0] * ks * kgv[0], kf[1] * ks * kgv[1]); w.y = pk2(kf[2] * ks * kgv[2], kf[3] * ks * kgv[3]);
        w.z = pk2(kf[4] * ks * kgv[4], kf[5] * ks * kgv[5]); w.w = pk2(kf[6] * ks * kgv[6], kf[7] * ks * kgv[7]);
        *(LAS u32x4*)(B + kr * KS_PITCH + pc * 16) = w;
        *(LAS u32x4*)(B + 64 * KS_PITCH + kr * VT_PITCH + pc * 16) = vreg;
    };
    auto compute_t = [&](int buf, int j) {
        if (!tk.wave_on(wave, j)) return;
        const LAS unsigned char* B = lds + buf * AT_BUF;
        f32x4 st[4];
#pragma unroll
        for (int mt = 0; mt < 4; ++mt) {
            st[mt] = (f32x4){0.f, 0.f, 0.f, 0.f};
#pragma unroll
            for (int ks = 0; ks < 2; ++ks) {
                const bf16x8 a = *(const LAS bf16x8*)(B + (mt * 16 + qi) * KS_PITCH + ks * 64 + g * 16);
                st[mt] = __builtin_amdgcn_mfma_f32_16x16x32_bf16(a, bq[ks], st[mt], 0, 0, 0);
            }
        }
        float ps = 0.f;
#pragma unroll
        for (int mt = 0; mt < 4; ++mt)
#pragma unroll
            for (int i = 0; i < 4; ++i) {
                const float pv = tk.mask(mq, j, mt * 16 + g * 4 + i) ? __builtin_amdgcn_exp2f(st[mt][i]) : 0.f;
                st[mt][i] = pv; ps += pv;
            }
        l_run += ps;
#pragma unroll
        for (int ks = 0; ks < 2; ++ks) {
            u32x4 pbw; pbw.x = pk2(st[2 * ks][0], st[2 * ks][1]); pbw.y = pk2(st[2 * ks][2], st[2 * ks][3]); pbw.z = pk2(st[2 * ks + 1][0], st[2 * ks + 1][1]); pbw.w = pk2(st[2 * ks + 1][2], st[2 * ks + 1][3]);
            const bf16x8 pb = __builtin_bit_cast(bf16x8, pbw);
#pragma unroll
            for (int mo = 0; mo < 4; ++mo) {
                const LAS unsigned char* vp = B + 64 * KS_PITCH + (ks * 32 + 4 * g + (qi >> 2)) * VT_PITCH + (mo * 16 + 4 * (qi & 3)) * 2;
                const s16x4 lo = __builtin_amdgcn_ds_read_tr16_b64_v4i16((LAS s16x4*)vp), hi = __builtin_amdgcn_ds_read_tr16_b64_v4i16((LAS s16x4*)(vp + 16 * VT_PITCH));
                bf16x8 av; av[0] = lo[0]; av[1] = lo[1]; av[2] = lo[2]; av[3] = lo[3]; av[4] = hi[0]; av[5] = hi[1]; av[6] = hi[2]; av[7] = hi[3];
                R.o[mo] = __builtin_amdgcn_mfma_f32_16x16x32_bf16(av, pb, R.o[mo], 0, 0, 0);
            }
        }
    };
    int j0 = -1; j0 = next_on(j0);
    int j1 = (j0 < nt) ? next_on(j0) : nt, j2 = (j1 < nt) ? next_on(j1) : nt;
    u32x4 kA = {0u, 0u, 0u, 0u}, vA = kA, kB = kA, vB = kA;
    if (j0 < nt) load_t(j0, kA, vA);
    if (j1 < nt) load_t(j1, kB, vB);
    {
        const bf16_t* qp = qbase + (size_t)tk.q_tok(mq) * PBC_W;
        const u32x4 r0 = *(const u32x4*)(qp + g * 8), r1 = *(const u32x4*)(qp + 32 + g * 8);
        float qf[16];
#pragma unroll
        for (int j = 0; j < 4; ++j) { qf[2 * j] = bflo(r0[j]); qf[2 * j + 1] = bfhi(r0[j]); qf[8 + 2 * j] = bflo(r1[j]); qf[8 + 2 * j + 1] = bfhi(r1[j]); }
        float ss = 0.f;
#pragma unroll
        for (int j = 0; j < 16; ++j) ss += qf[j] * qf[j];
        ss += __shfl_xor(ss, 16); ss += __shfl_xor(ss, 32);
        const float qs = rsqrtf(ss * (1.0f / 64.0f) + 1e-6f) * (0.125f * 1.4426950408889634f);
        u32x4 b0, b1;
#pragma unroll
        for (int j = 0; j < 4; ++j) {
            b0[j] = pk2(qf[2 * j] * qs * qg[g * 8 + 2 * j], qf[2 * j + 1] * qs * qg[g * 8 + 2 * j + 1]);
            b1[j] = pk2(qf[8 + 2 * j] * qs * qg[32 + g * 8 + 2 * j], qf[8 + 2 * j + 1] * qs * qg[32 + g * 8 + 2 * j + 1]);
        }
        bq[0] = __builtin_bit_cast(bf16x8, b0); bq[1] = __builtin_bit_cast(bf16x8, b1);
    }
    __syncthreads();
    if (j0 < nt) store_t(0, kA, vA);
    if (j2 < nt) load_t(j2, kA, vA);
    __syncthreads();
    while (j0 < nt) {
        compute_t(0, j0);
        int j3 = (j2 < nt) ? next_on(j2) : nt;
        if (j1 < nt) store_t(1, kB, vB);
        if (j3 < nt) load_t(j3, kB, vB);
        __syncthreads();
        j0 = j1; j1 = j2; j2 = j3;
        if (j0 >= nt) break;
        compute_t(1, j0);
        j3 = (j2 < nt) ? next_on(j2) : nt;
        if (j1 < nt) store_t(0, kA, vA);
        if (j3 < nt) load_t(j3, kA, vA);
        __syncthreads();
        j0 = j1; j1 = j2; j2 = j3;
    }
    l_run += __shfl_xor(l_run, 16); l_run += __shfl_xor(l_run, 32);
    R.m = 0.f; R.l = l_run;
}

struct DilTask {
    int tokbase, d, rho, c;
    __device__ __forceinline__ int q_tok(int m) const { return tokbase + (c * 128 + m) * d + rho; }
    __device__ __forceinline__ int ntiles() const { return 4; }
    __device__ __forceinline__ bool tile_on(int j) const { return !(c == 0 && j < 2); }
    __device__ __forceinline__ int k_tok(int j, int n) const { return tokbase + ((c - 1) * 128 + j * 64 + n) * d + rho; }
    __device__ __forceinline__ bool mask(int m, int j, int n) const { const int diff = 128 + m - j * 64 - n; return diff >= 0 && diff <= 128; }
    __device__ __forceinline__ bool wave_on(int w, int j) const { return (w < 4) ? (j < 3) : (j > 0); }
};
__device__ __forceinline__ void dil_epilogue(const Params& p, int gi, int hC, int tok, int g, const f32x4 (&o)[4], float lsum) {
    const float inv = 1.0f / lsum;
    const float L = __builtin_amdgcn_logf(lsum);
    bf16_t* dilo = (bf16_t*)p.out; float* dill = (float*)((unsigned char*)p.out + (size_t)2 * T_TOK * 384 * 2);
    if (gi < 2) {
#pragma unroll
        for (int mo = 0; mo < 4; ++mo) {
            u32x2 w; w.x = pk2(o[mo][0] * inv, o[mo][1] * inv); w.y = pk2(o[mo][2] * inv, o[mo][3] * inv);
            *(u32x2*)(dilo + ((size_t)gi * T_TOK + tok) * 384 + hC * 64 + mo * 16 + g * 4) = w;
        }
        if (g == 0) dill[((size_t)gi * T_TOK + tok) * 6 + hC] = L;
    } else {
        const float L0 = dill[(size_t)tok * 6 + hC], L1 = dill[((size_t)T_TOK + tok) * 6 + hC];
        const float M = fmaxf(L, fmaxf(L0, L1));
        const float w0 = __builtin_amdgcn_exp2f(L0 - M), w1 = __builtin_amdgcn_exp2f(L1 - M), w2 = __builtin_amdgcn_exp2f(L - M);
        const float wi = 1.0f / (w0 + w1 + w2);
        const float a0 = w0 * wi, a1 = w1 * wi, a2 = w2 * wi * inv;
        const bf16_t* sg = (const bf16_t*)(p.ws + WS_GATE) + (size_t)tok * 1024 + 640 + hC * 64;
        bf16_t* yg = (bf16_t*)(p.ws + WS_YG) + (size_t)tok * 1024 + 640 + hC * 64;
#pragma unroll
        for (int mo = 0; mo < 4; ++mo) {
            const int dh = mo * 16 + g * 4;
            const u32x2 o0 = *(const u32x2*)(dilo + (size_t)tok * 384 + hC * 64 + dh), o1 = *(const u32x2*)(dilo + ((size_t)T_TOK + tok) * 384 + hC * 64 + dh);
            const u32x2 gt = *(const u32x2*)(sg + dh);
            const float y0 = a0 * bflo(o0.x) + a1 * bflo(o1.x) + a2 * o[mo][0];
            const float y1 = a0 * bfhi(o0.x) + a1 * bfhi(o1.x) + a2 * o[mo][1];
            const float y2 = a0 * bflo(o0.y) + a1 * bflo(o1.y) + a2 * o[mo][2];
            const float y3 = a0 * bfhi(o0.y) + a1 * bfhi(o1.y) + a2 * o[mo][3];
            u32x2 w; w.x = pk2(y0 * bflo(gt.x), y1 * bfhi(gt.x)); w.y = pk2(y2 * bflo(gt.y), y3 * bfhi(gt.y));
            *(u32x2*)(yg + dh) = w;
        }
    }
}
__device__ __forceinline__ void dil_run(const Params& p, int l, int gi, int r, LAS unsigned char* lds) {
    const int d = (gi == 0) ? 1 : (gi == 1 ? 4 : 16), npair = 16 / d;
    const int b = r / 96, r2 = r % 96, hC = r2 / 16, r3 = r2 % 16, rho = r3 / npair, cp = r3 % npair;
    const int tid = tidx(), wave = tid >> 6, lane = tid & 63, qi = lane & 15, g = lane >> 4;
    const int kr = tid >> 3, pc = tid & 7, m = wave * 16 + qi;
    const bf16_t* pbc = (const bf16_t*)(p.ws + WS_PBC);
    const bf16_t* qbase = pbc + 768 + hC * 64; const bf16_t* kbase = pbc + 1152 + hC * 64; const bf16_t* vbase = pbc + 1536 + hC * 64;
    const float* qg = p.in[I_DQG] + l * 64; const float* kg = p.in[I_DKG] + l * 64;
    const int tokbase = b * SEQ, ksub0 = (2 * cp - 1) * 128;
    const int jt0 = (cp == 0) ? 2 : 0;
    u32x4 qr[2][2]; int qtok[2];
#pragma unroll
    for (int qb = 0; qb < 2; ++qb) {
        qtok[qb] = tokbase + ((2 * cp + qb) * 128 + m) * d + rho;
        qr[qb][0] = *(const u32x4*)(qbase + (size_t)qtok[qb] * PBC_W + g * 8); qr[qb][1] = *(const u32x4*)(qbase + (size_t)qtok[qb] * PBC_W + 32 + g * 8);
    }
    u32x4 kreg[6], vreg[6];
#pragma unroll
    for (int jt = 0; jt < 6; ++jt) {
        kreg[jt] = (u32x4){0u, 0u, 0u, 0u}; vreg[jt] = (u32x4){0u, 0u, 0u, 0u};
        if (jt >= jt0) {
            const size_t ktok = (size_t)(tokbase + (ksub0 + jt * 64 + kr) * d + rho);
            kreg[jt] = *(const u32x4*)(kbase + ktok * PBC_W + pc * 8); vreg[jt] = *(const u32x4*)(vbase + ktok * PBC_W + pc * 8);
        }
    }
    float kgv[8];
#pragma unroll
    for (int j = 0; j < 8; ++j) kgv[j] = kg[pc * 8 + j];
    __syncthreads();
#pragma unroll
    for (int jt = 0; jt < 6; ++jt) {
        if (jt >= jt0) {
            LAS unsigned char* B = lds + jt * AT_BUF;
            float kf[8];
#pragma unroll
            for (int q = 0; q < 4; ++q) { kf[2 * q] = bflo(kreg[jt][q]); kf[2 * q + 1] = bfhi(kreg[jt][q]); }
            float ss = 0.f;
#pragma unroll
            for (int q = 0; q < 8; ++q) ss += kf[q] * kf[q];
            ss = dsum8(ss);
            const float ks = rsqrtf(ss * (1.0f / 64.0f) + 1e-6f);
            u32x4 w; w.x = pk2(kf[0] * ks * kgv[0], kf[1] * ks * kgv[1]); w.y = pk2(kf[2] * ks * kgv[2], kf[3] * ks * kgv[3]);
            w.z = pk2(kf[4] * ks * kgv[4], kf[5] * ks * kgv[5]); w.w = pk2(kf[6] * ks * kgv[6], kf[7] * ks * kgv[7]);
            *(LAS u32x4*)(B + kr * KS_PITCH + pc * 16) = w;
            *(LAS u32x4*)(B + 64 * KS_PITCH + kr * VT_PITCH + pc * 16) = vreg[jt];
        }
    }
    __syncthreads();
#pragma unroll
    for (int qb = 0; qb < 2; ++qb) {
        bf16x8 bq[2];
        {
            float qf[16];
#pragma unroll
            for (int j = 0; j < 4; ++j) { qf[2 * j] = bflo(qr[qb][0][j]); qf[2 * j + 1] = bfhi(qr[qb][0][j]); qf[8 + 2 * j] = bflo(qr[qb][1][j]); qf[8 + 2 * j + 1] = bfhi(qr[qb][1][j]); }
            float ss = 0.f;
#pragma unroll
            for (int j = 0; j < 16; ++j) ss += qf[j] * qf[j];
            ss += __shfl_xor(ss, 16); ss += __shfl_xor(ss, 32);
            const float qs = rsqrtf(ss * (1.0f / 64.0f) + 1e-6f) * (0.125f * 1.4426950408889634f);
            u32x4 b0, b1;
#pragma unroll
            for (int j = 0; j < 4; ++j) {
                b0[j] = pk2(qf[2 * j] * qs * qg[g * 8 + 2 * j], qf[2 * j + 1] * qs * qg[g * 8 + 2 * j + 1]);
                b1[j] = pk2(qf[8 + 2 * j] * qs * qg[32 + g * 8 + 2 * j], qf[8 + 2 * j + 1] * qs * qg[32 + g * 8 + 2 * j + 1]);
            }
            bq[0] = __builtin_bit_cast(bf16x8, b0); bq[1] = __builtin_bit_cast(bf16x8, b1);
        }
        f32x4 o[4];
#pragma unroll
        for (int mo = 0; mo < 4; ++mo) o[mo] = (f32x4){0.f, 0.f, 0.f, 0.f};
        float l_run = 0.f;
#pragma unroll 1
        for (int j = 0; j < 4; ++j) {
            if (2 * qb + j < jt0 || !((wave < 4) ? (j < 3) : (j > 0))) continue;
            const LAS unsigned char* B = lds + (2 * qb + j) * AT_BUF;
            f32x4 st[4];
#pragma unroll
            for (int mt = 0; mt < 4; ++mt) {
                st[mt] = (f32x4){0.f, 0.f, 0.f, 0.f};
#pragma unroll
                for (int ks = 0; ks < 2; ++ks) {
                    const bf16x8 a = *(const LAS bf16x8*)(B + (mt * 16 + qi) * KS_PITCH + ks * 64 + g * 16);
                    st[mt] = __builtin_amdgcn_mfma_f32_16x16x32_bf16(a, bq[ks], st[mt], 0, 0, 0);
                }
            }
            float ps = 0.f;
#pragma unroll
            for (int mt = 0; mt < 4; ++mt)
#pragma unroll
                for (int ii = 0; ii < 4; ++ii) {
                    const int diff = 128 + m - j * 64 - (mt * 16 + g * 4 + ii);
                    const float pv = (diff >= 0 && diff <= 128) ? __builtin_amdgcn_exp2f(st[mt][ii]) : 0.f;
                    st[mt][ii] = pv; ps += pv;
                }
            l_run += ps;
#pragma unroll
            for (int ks = 0; ks < 2; ++ks) {
                u32x4 pbw; pbw.x = pk2(st[2 * ks][0], st[2 * ks][1]); pbw.y = pk2(st[2 * ks][2], st[2 * ks][3]); pbw.z = pk2(st[2 * ks + 1][0], st[2 * ks + 1][1]); pbw.w = pk2(st[2 * ks + 1][2], st[2 * ks + 1][3]);
                const bf16x8 pb = __builtin_bit_cast(bf16x8, pbw);
#pragma unroll
                for (int mo = 0; mo < 4; ++mo) {
                    const LAS unsigned char* vp = B + 64 * KS_PITCH + (ks * 32 + 4 * g + (qi >> 2)) * VT_PITCH + (mo * 16 + 4 * (qi & 3)) * 2;
                    const s16x4 lo = __builtin_amdgcn_ds_read_tr16_b64_v4i16((LAS s16x4*)vp), hi = __builtin_amdgcn_ds_read_tr16_b64_v4i16((LAS s16x4*)(vp + 16 * VT_PITCH));
                    bf16x8 av; av[0] = lo[0]; av[1] = lo[1]; av[2] = lo[2]; av[3] = lo[3]; av[4] = hi[0]; av[5] = hi[1]; av[6] = hi[2]; av[7] = hi[3];
                    o[mo] = __builtin_amdgcn_mfma_f32_16x16x32_bf16(av, pb, o[mo], 0, 0, 0);
                }
            }
        }
        l_run += __shfl_xor(l_run, 16); l_run += __shfl_xor(l_run, 32);
        dil_epilogue(p, gi, hC, qtok[qb], g, o, l_run);
    }
}

struct MobaTask {
    int tokbase, q0, b_own, nown; unsigned anysel, mysel;
    __device__ __forceinline__ int q_tok(int m) const { return tokbase + q0 + m; }
    __device__ __forceinline__ int ntiles() const { return 4 * (b_own + 1); }
    __device__ __forceinline__ bool tile_on(int j) const { return (j < 4) ? (j < nown) : (((anysel >> ((j >> 2) - 1)) & 1u) != 0u); }
    __device__ __forceinline__ int k_tok(int j, int n) const { const int blk = (j < 4) ? b_own : ((j >> 2) - 1); return tokbase + blk * 256 + (j & 3) * 64 + n; }
    __device__ __forceinline__ bool mask(int m, int j, int n) const {
        return (j < 4) ? (b_own * 256 + j * 64 + n <= q0 + m) : (((mysel >> ((j >> 2) - 1)) & 1u) != 0u);
    }
    __device__ __forceinline__ bool wave_on(int w, int j) const { return (j < 4) ? (b_own * 256 + j * 64 <= q0 + w * 16 + 15) : true; }
};
__device__ __forceinline__ void moba_route_task(const Params& p, int l, int task, LAS unsigned char* lds) {
    const int b = task >> 6, hB = (task >> 4) & 3, b_own = task & 15;
    if (b_own == 0) return;
    const int tid = tidx();
    const int bh16 = b * 4 + hB;
    const bf16_t* pbc = (const bf16_t*)(p.ws + WS_PBC);
    const float* kmean = (const float*)(p.ws + WS_KMEAN) + (size_t)bh16 * 1024;
    LAS float* km = (LAS float*)(lds + AT_KM);
    const int q = tid >> 1, part = tid & 1;
    const bf16_t* qp = pbc + (size_t)(b * SEQ + b_own * 256 + q) * PBC_W + hB * 64 + part * 32;
    const u32x4 r0 = *(const u32x4*)qp, r1 = *(const u32x4*)(qp + 8), r2 = *(const u32x4*)(qp + 16), r3 = *(const u32x4*)(qp + 24);
    __syncthreads();
    if (threadIdx.x == 0) {
        const unsigned* kc = (const unsigned*)(p.ws + WS_KMC) + bh16; unsigned spins = 0;
        while (__hip_atomic_load(kc, __ATOMIC_RELAXED, __HIP_MEMORY_SCOPE_AGENT) < 16u * (unsigned)(l + 1)) { __builtin_amdgcn_s_sleep(2); if (++spins > (1u << 22)) break; }
    }
    __syncthreads();
    for (int i = tid; i < 1024; i += NTHR) km[i] = __hip_atomic_load(kmean + i, __ATOMIC_RELAXED, __HIP_MEMORY_SCOPE_AGENT);
    __syncthreads();
    float qf[32];
#pragma unroll
    for (int j = 0; j < 4; ++j) {
        qf[2 * j] = bflo(r0[j]); qf[2 * j + 1] = bfhi(r0[j]); qf[8 + 2 * j] = bflo(r1[j]); qf[8 + 2 * j + 1] = bfhi(r1[j]);
        qf[16 + 2 * j] = bflo(r2[j]); qf[16 + 2 * j + 1] = bfhi(r2[j]); qf[24 + 2 * j] = bflo(r3[j]); qf[24 + 2 * j + 1] = bfhi(r3[j]);
    }
    float ss = 0.f;
#pragma unroll
    for (int j = 0; j < 32; ++j) ss += qf[j] * qf[j];
    ss += __shfl_xor(ss, 1);
    const float qs = rsqrtf(ss * (1.0f / 64.0f) + 1e-6f);
    const float* qg = p.in[I_MQG] + l * 64 + part * 32;
#pragma unroll
    for (int j = 0; j < 32; ++j) qf[j] *= qs * qg[j];
    float v1 = -INFINITY, v2 = -INFINITY, v3 = -INFINITY; int i1 = -1, i2 = -1, i3 = -1;
    for (int n = 0; n < b_own; ++n) {
        float sc = 0.f;
#pragma unroll
        for (int j = 0; j < 32; ++j) sc += qf[j] * km[n * 64 + part * 32 + j];
        sc += __shfl_xor(sc, 1);
        if (sc > v1) { v3 = v2; i3 = i2; v2 = v1; i2 = i1; v1 = sc; i1 = n; }
        else if (sc > v2) { v3 = v2; i3 = i2; v2 = sc; i2 = n; }
        else if (sc > v3) { v3 = sc; i3 = n; }
    }
    LAS unsigned* lcnt = (LAS unsigned*)(lds + AT_SEL); LAS unsigned* lbase = lcnt + 16;
    if (tid < 16) lcnt[tid] = 0u;
    __syncthreads();
    unsigned rk1 = 0u, rk2 = 0u, rk3 = 0u;
    if (part == 0) {
        if (i1 >= 0) rk1 = atomicAdd((unsigned*)(lcnt + i1), 1u);
        if (i2 >= 0) rk2 = atomicAdd((unsigned*)(lcnt + i2), 1u);
        if (i3 >= 0) rk3 = atomicAdd((unsigned*)(lcnt + i3), 1u);
    }
    __syncthreads();
    if (tid < 16) { const unsigned c = lcnt[tid]; lbase[tid] = c ? __hip_atomic_fetch_add((unsigned*)(p.ws + WS_CNT) + (l * 16 + bh16) * 16 + tid, c, __ATOMIC_RELAXED, __HIP_MEMORY_SCOPE_AGENT) : 0u; }
    __syncthreads();
    if (part == 0) {
        unsigned short* list = (unsigned short*)((unsigned char*)p.out + DO_LIST) + (size_t)bh16 * 16 * 4096;
        const unsigned qpos = (unsigned)(b_own * 256 + q);
        if (i1 >= 0) list[(size_t)i1 * 4096 + lbase[i1] + rk1] = (unsigned short)(qpos | (0u << 12));
        if (i2 >= 0) list[(size_t)i2 * 4096 + lbase[i2] + rk2] = (unsigned short)(qpos | (1u << 12));
        if (i3 >= 0) list[(size_t)i3 * 4096 + lbase[i3] + rk3] = (unsigned short)(qpos | (2u << 12));
    }
}

struct GatherTask {
    int tokbase, keytok, nvalid; unsigned mye;
    __device__ __forceinline__ int q_tok(int) const { return tokbase + (int)(mye & 0xFFFu); }
    __device__ __forceinline__ int ntiles() const { return 4; }
    __device__ __forceinline__ bool tile_on(int) const { return true; }
    __device__ __forceinline__ int k_tok(int j, int n) const { return keytok + j * 64 + n; }
    __device__ __forceinline__ bool mask(int, int, int) const { return true; }
    __device__ __forceinline__ bool wave_on(int w, int) const { return w * 16 < nvalid; }
};
__device__ __forceinline__ unsigned moba_gather_entry(const Params& p, int bh16, int n, int i, int count) {
    const int tid = tidx(), m = (tid >> 6) * 16 + (tid & 15);
    const int nvalid = (count - i * 128 < 128) ? (count - i * 128) : 128;
    const unsigned short* ent = (const unsigned short*)((const unsigned char*)p.out + DO_LIST) + ((size_t)bh16 * 16 + n) * 4096 + (size_t)i * 128;
    return ent[m < nvalid ? m : nvalid - 1];
}
__device__ __forceinline__ void moba_gather_task(const Params& p, int l, int bh16, int n, int i, int count, unsigned mye, LAS unsigned char* lds) {
    const int b = bh16 >> 2, hB = bh16 & 3;
    const int tid = tidx(), wave = tid >> 6, lane = tid & 63, qi = lane & 15, g = lane >> 4;
    const bf16_t* pbc = (const bf16_t*)(p.ws + WS_PBC);
    GatherTask tk; tk.tokbase = b * SEQ; tk.keytok = b * SEQ + n * 256; tk.nvalid = (count - i * 128 < 128) ? (count - i * 128) : 128; tk.mye = mye;
    AttnOut R;
    attn_core(tk, pbc + hB * 64, pbc + 256 + hB * 64, pbc + 512 + hB * 64, p.in[I_MQG] + l * 64, p.in[I_MKG] + l * 64, lds, R);
    const int m = wave * 16 + qi;
    if (m < tk.nvalid) {
        const unsigned e = tk.mye;
        const size_t row = ((size_t)(tk.tokbase + (int)(e & 0xFFFu)) * 4 + hB) * 3 + (e >> 12);
        const float inv = 1.0f / R.l;
        bf16_t* pb = (bf16_t*)((unsigned char*)p.out + DO_PB) + row * 64;
#pragma unroll
        for (int mo = 0; mo < 4; ++mo) {
            u32x2 w; w.x = pk2(R.o[mo][0] * inv, R.o[mo][1] * inv); w.y = pk2(R.o[mo][2] * inv, R.o[mo][3] * inv);
            *(u32x2*)(pb + mo * 16 + g * 4) = w;
        }
        if (g == 0) ((float*)((unsigned char*)p.out + DO_PL))[row] = R.l;
    }
}

__device__ __forceinline__ void moba_gather_run(const Params& p, int l, int e, int i0, int i1, int count, LAS unsigned char* lds) {
    const int bh16 = e >> 4, n = e & 15, b = bh16 >> 2, hB = bh16 & 3;
    const int tid = tidx(), wave = tid >> 6, lane = tid & 63, qi = lane & 15, g = lane >> 4;
    const int kr = tid >> 3, pc = tid & 7, m = wave * 16 + qi;
    const bf16_t* pbc = (const bf16_t*)(p.ws + WS_PBC);
    const bf16_t* qbase = pbc + hB * 64; const bf16_t* kbase = pbc + 256 + hB * 64; const bf16_t* vbase = pbc + 512 + hB * 64;
    const float* qg = p.in[I_MQG] + l * 64; const float* kg = p.in[I_MKG] + l * 64;
    const int tokbase = b * SEQ, keytok = b * SEQ + n * 256;
    const unsigned short* ent = (const unsigned short*)((const unsigned char*)p.out + DO_LIST) + ((size_t)bh16 * 16 + n) * 4096;
    auto entry_of = [&](int i) { const int nv = (count - i * 128 < 128) ? (count - i * 128) : 128; return (unsigned)ent[(size_t)i * 128 + (m < nv ? m : nv - 1)]; };
    u32x4 kreg[4], vreg[4];
#pragma unroll
    for (int j = 0; j < 4; ++j) {
        kreg[j] = *(const u32x4*)(kbase + (size_t)(keytok + j * 64 + kr) * PBC_W + pc * 8);
        vreg[j] = *(const u32x4*)(vbase + (size_t)(keytok + j * 64 + kr) * PBC_W + pc * 8);
    }
    unsigned e_cur = entry_of(i0);
    float kgv[8];
#pragma unroll
    for (int j = 0; j < 8; ++j) kgv[j] = kg[pc * 8 + j];
    __syncthreads();
#pragma unroll
    for (int j = 0; j < 4; ++j) {
        LAS unsigned char* B = lds + j * AT_BUF;
        float kf[8];
#pragma unroll
        for (int q = 0; q < 4; ++q) { kf[2 * q] = bflo(kreg[j][q]); kf[2 * q + 1] = bfhi(kreg[j][q]); }
        float ss = 0.f;
#pragma unroll
        for (int q = 0; q < 8; ++q) ss += kf[q] * kf[q];
        ss = dsum8(ss);
        const float ks = rsqrtf(ss * (1.0f / 64.0f) + 1e-6f);
        u32x4 w; w.x = pk2(kf[0] * ks * kgv[0], kf[1] * ks * kgv[1]); w.y = pk2(kf[2] * ks * kgv[2], kf[3] * ks * kgv[3]);
        w.z = pk2(kf[4] * ks * kgv[4], kf[5] * ks * kgv[5]); w.w = pk2(kf[6] * ks * kgv[6], kf[7] * ks * kgv[7]);
        *(LAS u32x4*)(B + kr * KS_PITCH + pc * 16) = w;
        *(LAS u32x4*)(B + 64 * KS_PITCH + kr * VT_PITCH + pc * 16) = vreg[j];
    }
    u32x4 r0 = *(const u32x4*)(qbase + (size_t)(tokbase + (int)(e_cur & 0xFFFu)) * PBC_W + g * 8), r1 = *(const u32x4*)(qbase + (size_t)(tokbase + (int)(e_cur & 0xFFFu)) * PBC_W + 32 + g * 8);
    unsigned e_nxt = (i0 + 1 < i1) ? entry_of(i0 + 1) : e_cur;
    __syncthreads();
    for (int i = i0; i < i1; ++i) {
        const int nvalid = (count - i * 128 < 128) ? (count - i * 128) : 128;
        u32x4 rn0 = r0, rn1 = r1; unsigned e_nn = e_nxt;
        if (i + 1 < i1) {
            const bf16_t* qn = qbase + (size_t)(tokbase + (int)(e_nxt & 0xFFFu)) * PBC_W;
            rn0 = *(const u32x4*)(qn + g * 8); rn1 = *(const u32x4*)(qn + 32 + g * 8);
            if (i + 2 < i1) e_nn = entry_of(i + 2);
        }
        if (wave * 16 < nvalid) {
            bf16x8 bq[2];
            {
                float qf[16];
#pragma unroll
                for (int j = 0; j < 4; ++j) { qf[2 * j] = bflo(r0[j]); qf[2 * j + 1] = bfhi(r0[j]); qf[8 + 2 * j] = bflo(r1[j]); qf[8 + 2 * j + 1] = bfhi(r1[j]); }
                float ss = 0.f;
#pragma unroll
                for (int j = 0; j < 16; ++j) ss += qf[j] * qf[j];
                ss += __shfl_xor(ss, 16); ss += __shfl_xor(ss, 32);
                const float qs = rsqrtf(ss * (1.0f / 64.0f) + 1e-6f) * (0.125f * 1.4426950408889634f);
                u32x4 b0, b1;
#pragma unroll
                for (int j = 0; j < 4; ++j) {
                    b0[j] = pk2(qf[2 * j] * qs * qg[g * 8 + 2 * j], qf[2 * j + 1] * qs * qg[g * 8 + 2 * j + 1]);
                    b1[j] = pk2(qf[8 + 2 * j] * qs * qg[32 + g * 8 + 2 * j], qf[8 + 2 * j + 1] * qs * qg[32 + g * 8 + 2 * j + 1]);
                }
                bq[0] = __builtin_bit_cast(bf16x8, b0); bq[1] = __builtin_bit_cast(bf16x8, b1);
            }
            f32x4 o[4];
#pragma unroll
            for (int mo = 0; mo < 4; ++mo) o[mo] = (f32x4){0.f, 0.f, 0.f, 0.f};
            float l_run = 0.f;
#pragma unroll 1
            for (int j = 0; j < 4; ++j) {
                const LAS unsigned char* B = lds + j * AT_BUF;
                f32x4 st[4];
#pragma unroll
                for (int mt = 0; mt < 4; ++mt) {
                    st[mt] = (f32x4){0.f, 0.f, 0.f, 0.f};
#pragma unroll
                    for (int ks = 0; ks < 2; ++ks) {
                        const bf16x8 a = *(const LAS bf16x8*)(B + (mt * 16 + qi) * KS_PITCH + ks * 64 + g * 16);
                        st[mt] = __builtin_amdgcn_mfma_f32_16x16x32_bf16(a, bq[ks], st[mt], 0, 0, 0);
                    }
                }
                float ps = 0.f;
#pragma unroll
                for (int mt = 0; mt < 4; ++mt)
#pragma unroll
                    for (int ii = 0; ii < 4; ++ii) { const float pv = __builtin_amdgcn_exp2f(st[mt][ii]); st[mt][ii] = pv; ps += pv; }
                l_run += ps;
#pragma unroll
                for (int ks = 0; ks < 2; ++ks) {
                    u32x4 pbw; pbw.x = pk2(st[2 * ks][0], st[2 * ks][1]); pbw.y = pk2(st[2 * ks][2], st[2 * ks][3]); pbw.z = pk2(st[2 * ks + 1][0], st[2 * ks + 1][1]); pbw.w = pk2(st[2 * ks + 1][2], st[2 * ks + 1][3]);
                    const bf16x8 pb = __builtin_bit_cast(bf16x8, pbw);
#pragma unroll
                    for (int mo = 0; mo < 4; ++mo) {
                        const LAS unsigned char* vp = B + 64 * KS_PITCH + (ks * 32 + 4 * g + (qi >> 2)) * VT_PITCH + (mo * 16 + 4 * (qi & 3)) * 2;
                        const s16x4 lo = __builtin_amdgcn_ds_read_tr16_b64_v4i16((LAS s16x4*)vp), hi = __builtin_amdgcn_ds_read_tr16_b64_v4i16((LAS s16x4*)(vp + 16 * VT_PITCH));
                        bf16x8 av; av[0] = lo[0]; av[1] = lo[1]; av[2] = lo[2]; av[3] = lo[3]; av[4] = hi[0]; av[5] = hi[1]; av[6] = hi[2]; av[7] = hi[3];
                        o[mo] = __builtin_amdgcn_mfma_f32_16x16x32_bf16(av, pb, o[mo], 0, 0, 0);
                    }
                }
            }
            l_run += __shfl_xor(l_run, 16); l_run += __shfl_xor(l_run, 32);
            if (m < nvalid) {
                const size_t row = ((size_t)(tokbase + (int)(e_cur & 0xFFFu)) * 4 + hB) * 3 + (e_cur >> 12);
                const float inv = 1.0f / l_run;
                bf16_t* pb = (bf16_t*)((unsigned char*)p.out + DO_PB) + row * 64;
#pragma unroll
                for (int mo = 0; mo < 4; ++mo) {
                    u32x2 w; w.x = pk2(o[mo][0] * inv, o[mo][1] * inv); w.y = pk2(o[mo][2] * inv, o[mo][3] * inv);
                    *(u32x2*)(pb + mo * 16 + g * 4) = w;
                }
                if (g == 0) ((float*)((unsigned char*)p.out + DO_PL))[row] = l_run;
            }
        }
        r0 = rn0; r1 = rn1; e_cur = e_nxt; e_nxt = e_nn;
    }
}

__device__ __forceinline__ void moba_own_task(const Params& p, int l, int task, LAS unsigned char* lds) {
    const int b = task >> 7, hB = (task >> 5) & 3, ci = task & 31;
    const int tid = tidx(), wave = tid >> 6, lane = tid & 63, qi = lane & 15, g = lane >> 4;
    const bf16_t* pbc = (const bf16_t*)(p.ws + WS_PBC);
    MobaTask tk; tk.tokbase = b * SEQ; tk.q0 = ci * 128; tk.b_own = ci >> 1; tk.nown = (ci & 1) ? 4 : 2; tk.anysel = 0u; tk.mysel = 0u;
    const int tok = tk.q_tok(wave * 16 + qi);
    const int nsel = tk.b_own < 3 ? tk.b_own : 3;
    const size_t row0 = ((size_t)tok * 4 + hB) * 3;
    const bf16_t* pb = (const bf16_t*)((const unsigned char*)p.out + DO_PB) + row0 * 64;
    const float* pl = (const float*)((const unsigned char*)p.out + DO_PL) + row0;
    float pw[3]; u32x2 po[3][4];
#pragma unroll
    for (int sidx = 0; sidx < 3; ++sidx) {
        pw[sidx] = 0.f;
#pragma unroll
        for (int mo = 0; mo < 4; ++mo) po[sidx][mo] = (u32x2){0u, 0u};
        if (sidx < nsel) {
            pw[sidx] = pl[sidx];
#pragma unroll
            for (int mo = 0; mo < 4; ++mo) po[sidx][mo] = *(const u32x2*)(pb + sidx * 64 + mo * 16 + g * 4);
        }
    }
    AttnOut R;
    attn_core(tk, pbc + hB * 64, pbc + 256 + hB * 64, pbc + 512 + hB * 64, p.in[I_MQG] + l * 64, p.in[I_MKG] + l * 64, lds, R);
    float tot = R.l;
#pragma unroll
    for (int sidx = 0; sidx < 3; ++sidx) {
        const float w = pw[sidx];
        tot += w;
#pragma unroll
        for (int mo = 0; mo < 4; ++mo) {
            const u32x2 o = po[sidx][mo];
            R.o[mo][0] += w * bflo(o.x); R.o[mo][1] += w * bfhi(o.x); R.o[mo][2] += w * bflo(o.y); R.o[mo][3] += w * bfhi(o.y);
        }
    }
    const float inv = 1.0f / tot;
    const bf16_t* sg = (const bf16_t*)(p.ws + WS_GATE) + (size_t)tok * 1024 + 384 + hB * 64;
    bf16_t* yg = (bf16_t*)(p.ws + WS_YG) + (size_t)tok * 1024 + 384 + hB * 64;
#pragma unroll
    for (int mo = 0; mo < 4; ++mo) {
        const int dh = mo * 16 + g * 4;
        const u32x2 gt = *(const u32x2*)(sg + dh);
        u32x2 w; w.x = pk2(R.o[mo][0] * inv * bflo(gt.x), R.o[mo][1] * inv * bfhi(gt.x)); w.y = pk2(R.o[mo][2] * inv * bflo(gt.y), R.o[mo][3] * inv * bfhi(gt.y));
        *(u32x2*)(yg + dh) = w;
    }
}

__device__ __forceinline__ void moba_own_run(const Params& p, int l, int task, LAS unsigned char* lds) {
    const int b = task >> 6, hB = (task >> 4) & 3, blk = task & 15;
    const int tid = tidx(), wave = tid >> 6, lane = tid & 63, qi = lane & 15, g = lane >> 4;
    const int kr = tid >> 3, pc = tid & 7, m = wave * 16 + qi;
    const bf16_t* pbc = (const bf16_t*)(p.ws + WS_PBC);
    const bf16_t* qbase = pbc + hB * 64; const bf16_t* kbase = pbc + 256 + hB * 64; const bf16_t* vbase = pbc + 512 + hB * 64;
    const float* qg = p.in[I_MQG] + l * 64; const float* kg = p.in[I_MKG] + l * 64;
    const int keytok = b * SEQ + blk * 256;
    u32x4 qr[2][2]; int qtok[2];
#pragma unroll
    for (int qb = 0; qb < 2; ++qb) {
        qtok[qb] = keytok + qb * 128 + m;
        qr[qb][0] = *(const u32x4*)(qbase + (size_t)qtok[qb] * PBC_W + g * 8); qr[qb][1] = *(const u32x4*)(qbase + (size_t)qtok[qb] * PBC_W + 32 + g * 8);
    }
    u32x4 kreg[4], vreg[4];
#pragma unroll
    for (int j = 0; j < 4; ++j) {
        kreg[j] = *(const u32x4*)(kbase + (size_t)(keytok + j * 64 + kr) * PBC_W + pc * 8);
        vreg[j] = *(const u32x4*)(vbase + (size_t)(keytok + j * 64 + kr) * PBC_W + pc * 8);
    }
    float kgv[8];
#pragma unroll
    for (int j = 0; j < 8; ++j) kgv[j] = kg[pc * 8 + j];
    __syncthreads();
#pragma unroll
    for (int j = 0; j < 4; ++j) {
        LAS unsigned char* B = lds + j * AT_BUF;
        float kf[8];
#pragma unroll
        for (int q = 0; q < 4; ++q) { kf[2 * q] = bflo(kreg[j][q]); kf[2 * q + 1] = bfhi(kreg[j][q]); }
        float ss = 0.f;
#pragma unroll
        for (int q = 0; q < 8; ++q) ss += kf[q] * kf[q];
        ss = dsum8(ss);
        const float ks = rsqrtf(ss * (1.0f / 64.0f) + 1e-6f);
        u32x4 w; w.x = pk2(kf[0] * ks * kgv[0], kf[1] * ks * kgv[1]); w.y = pk2(kf[2] * ks * kgv[2], kf[3] * ks * kgv[3]);
        w.z = pk2(kf[4] * ks * kgv[4], kf[5] * ks * kgv[5]); w.w = pk2(kf[6] * ks * kgv[6], kf[7] * ks * kgv[7]);
        *(LAS u32x4*)(B + kr * KS_PITCH + pc * 16) = w;
        *(LAS u32x4*)(B + 64 * KS_PITCH + kr * VT_PITCH + pc * 16) = vreg[j];
    }
    __syncthreads();
    const int nsel = blk < 3 ? blk : 3;
#pragma unroll
    for (int qb = 0; qb < 2; ++qb) {
        const int tok = qtok[qb];
        const size_t row0 = ((size_t)tok * 4 + hB) * 3;
        const bf16_t* pbp = (const bf16_t*)((const unsigned char*)p.out + DO_PB) + row0 * 64;
        const float* plp = (const float*)((const unsigned char*)p.out + DO_PL) + row0;
        float pw[3]; u32x2 po[3][4];
#pragma unroll
        for (int sidx = 0; sidx < 3; ++sidx) {
            pw[sidx] = 0.f;
#pragma unroll
            for (int mo = 0; mo < 4; ++mo) po[sidx][mo] = (u32x2){0u, 0u};
            if (sidx < nsel) {
                pw[sidx] = plp[sidx];
#pragma unroll
                for (int mo = 0; mo < 4; ++mo) po[sidx][mo] = *(const u32x2*)(pbp + sidx * 64 + mo * 16 + g * 4);
            }
        }
        const u32x2 gt0 = *(const u32x2*)((const bf16_t*)(p.ws + WS_GATE) + (size_t)tok * 1024 + 384 + hB * 64 + g * 4);
        bf16x8 bq[2];
        {
            float qf[16];
#pragma unroll
            for (int j = 0; j < 4; ++j) { qf[2 * j] = bflo(qr[qb][0][j]); qf[2 * j + 1] = bfhi(qr[qb][0][j]); qf[8 + 2 * j] = bflo(qr[qb][1][j]); qf[8 + 2 * j + 1] = bfhi(qr[qb][1][j]); }
            float ss = 0.f;
#pragma unroll
            for (int j = 0; j < 16; ++j) ss += qf[j] * qf[j];
            ss += __shfl_xor(ss, 16); ss += __shfl_xor(ss, 32);
            const float qs = rsqrtf(ss * (1.0f / 64.0f) + 1e-6f) * (0.125f * 1.4426950408889634f);
            u32x4 b0, b1;
#pragma unroll
            for (int j = 0; j < 4; ++j) {
                b0[j] = pk2(qf[2 * j] * qs * qg[g * 8 + 2 * j], qf[2 * j + 1] * qs * qg[g * 8 + 2 * j + 1]);
                b1[j] = pk2(qf[8 + 2 * j] * qs * qg[32 + g * 8 + 2 * j], qf[8 + 2 * j + 1] * qs * qg[32 + g * 8 + 2 * j + 1]);
            }
            bq[0] = __builtin_bit_cast(bf16x8, b0); bq[1] = __builtin_bit_cast(bf16x8, b1);
        }
        f32x4 o[4];
#pragma unroll
        for (int mo = 0; mo < 4; ++mo) o[mo] = (f32x4){0.f, 0.f, 0.f, 0.f};
        float l_run = 0.f;
        const int qpos = qb * 128 + m;
#pragma unroll 1
        for (int j = 0; j < 4; ++j) {
            if (j * 64 > qb * 128 + wave * 16 + 15) continue;
            const LAS unsigned char* B = lds + j * AT_BUF;
            f32x4 st[4];
#pragma unroll
            for (int mt = 0; mt < 4; ++mt) {
                st[mt] = (f32x4){0.f, 0.f, 0.f, 0.f};
#pragma unroll
                for (int ks = 0; ks < 2; ++ks) {
                    const bf16x8 a = *(const LAS bf16x8*)(B + (mt * 16 + qi) * KS_PITCH + ks * 64 + g * 16);
                    st[mt] = __builtin_amdgcn_mfma_f32_16x16x32_bf16(a, bq[ks], st[mt], 0, 0, 0);
                }
            }
            float ps = 0.f;
#pragma unroll
            for (int mt = 0; mt < 4; ++mt)
#pragma unroll
                for (int ii = 0; ii < 4; ++ii) {
                    const float pv = (j * 64 + mt * 16 + g * 4 + ii <= qpos) ? __builtin_amdgcn_exp2f(st[mt][ii]) : 0.f;
                    st[mt][ii] = pv; ps += pv;
                }
            l_run += ps;
#pragma unroll
            for (int ks = 0; ks < 2; ++ks) {
                u32x4 pbw; pbw.x = pk2(st[2 * ks][0], st[2 * ks][1]); pbw.y = pk2(st[2 * ks][2], st[2 * ks][3]); pbw.z = pk2(st[2 * ks + 1][0], st[2 * ks + 1][1]); pbw.w = pk2(st[2 * ks + 1][2], st[2 * ks + 1][3]);
                const bf16x8 pb = __builtin_bit_cast(bf16x8, pbw);
#pragma unroll
                for (int mo = 0; mo < 4; ++mo) {
                    const LAS unsigned char* vp = B + 64 * KS_PITCH + (ks * 32 + 4 * g + (qi >> 2)) * VT_PITCH + (mo * 16 + 4 * (qi & 3)) * 2;
                    const s16x4 lo = __builtin_amdgcn_ds_read_tr16_b64_v4i16((LAS s16x4*)vp), hi = __builtin_amdgcn_ds_read_tr16_b64_v4i16((LAS s16x4*)(vp + 16 * VT_PITCH));
                    bf16x8 av; av[0] = lo[0]; av[1] = lo[1]; av[2] = lo[2]; av[3] = lo[3]; av[4] = hi[0]; av[5] = hi[1]; av[6] = hi[2]; av[7] = hi[3];
                    o[mo] = __builtin_amdgcn_mfma_f32_16x16x32_bf16(av, pb, o[mo], 0, 0, 0);
                }
            }
        }
        l_run += __shfl_xor(l_run, 16); l_run += __shfl_xor(l_run, 32);
        float tot = l_run;
#pragma unroll
        for (int sidx = 0; sidx < 3; ++sidx) {
            const float w = pw[sidx];
            tot += w;
#pragma unroll
            for (int mo = 0; mo < 4; ++mo) {
                const u32x2 oo = po[sidx][mo];
                o[mo][0] += w * bflo(oo.x); o[mo][1] += w * bfhi(oo.x); o[mo][2] += w * bflo(oo.y); o[mo][3] += w * bfhi(oo.y);
            }
        }
        const float inv = 1.0f / tot;
        const bf16_t* sg = (const bf16_t*)(p.ws + WS_GATE) + (size_t)tok * 1024 + 384 + hB * 64;
        bf16_t* yg = (bf16_t*)(p.ws + WS_YG) + (size_t)tok * 1024 + 384 + hB * 64;
#pragma unroll
        for (int mo = 0; mo < 4; ++mo) {
            const int dh = mo * 16 + g * 4;
            const u32x2 gt = (mo == 0) ? gt0 : *(const u32x2*)(sg + dh);
            u32x2 w; w.x = pk2(o[mo][0] * inv * bflo(gt.x), o[mo][1] * inv * bfhi(gt.x)); w.y = pk2(o[mo][2] * inv * bflo(gt.y), o[mo][3] * inv * bfhi(gt.y));
            *(u32x2*)(yg + dh) = w;
        }
    }
}

__device__ __forceinline__ void kmean_task(const Params& p, int l, int task, LAS unsigned char* lds) {
    const int b = task / 64, r = task % 64, hB = r / 16, n = r % 16;
    const int tid = tidx(), kr = tid >> 3, pc = tid & 7;
    const bf16_t* kb = (const bf16_t*)(p.ws + WS_PBC) + 256 + hB * 64 + pc * 8;
    const float* kg = p.in[I_MKG] + l * 64 + pc * 8;
    float acc[8];
#pragma unroll
    for (int j = 0; j < 8; ++j) acc[j] = 0.f;
#pragma unroll
    for (int it = 0; it < 4; ++it) {
        const u32x4 rw = *(const u32x4*)(kb + (size_t)(b * SEQ + n * 256 + it * 64 + kr) * PBC_W);
        float kf[8];
#pragma unroll
        for (int q = 0; q < 4; ++q) { kf[2 * q] = bflo(rw[q]); kf[2 * q + 1] = bfhi(rw[q]); }
        float ss = 0.f;
#pragma unroll
        for (int q = 0; q < 8; ++q) ss += kf[q] * kf[q];
        ss = sum8(ss);
        const float ks = rsqrtf(ss * (1.0f / 64.0f) + 1e-6f);
#pragma unroll
        for (int q = 0; q < 8; ++q) acc[q] += bf2f(f2bf(kf[q] * ks * kg[q]));
    }
    LAS float* red = (LAS float*)lds;
    __syncthreads();
#pragma unroll
    for (int q = 0; q < 8; ++q) red[kr * 64 + pc * 8 + q] = acc[q];
    __syncthreads();
    if (tid < 64) {
        float s = 0.f;
        for (int i = 0; i < 64; ++i) s += red[i * 64 + tid];
        __hip_atomic_store((float*)(p.ws + WS_KMEAN) + (size_t)((b * 4 + hB) * 16 + n) * 64 + tid, s * (1.0f / 256.0f), __ATOMIC_RELAXED, __HIP_MEMORY_SCOPE_AGENT);
    }
    asm volatile("s_waitcnt vmcnt(0)" ::: "memory");
    __syncthreads();
    if (threadIdx.x == 0)
        __hip_atomic_fetch_add((unsigned*)(p.ws + WS_KMC) + (b * 4 + hB), 1u, __ATOMIC_RELAXED, __HIP_MEMORY_SCOPE_AGENT);
}

typedef float f32x2 __attribute__((ext_vector_type(2)));
constexpr size_t CH_ELEMS = 4096;
struct ChunkPre { u32x4 cur[5]; };
__device__ __forceinline__ void rwkv_chunk_load(const Params& p, int task, ChunkPre& P) {
    const int bh = task / 64, ch = task % 64, b = bh / 6, h = bh % 6;
    const int tid = tidx(), tl = tid >> 3, pc = tid & 7;
    const int s = ch * 64 + tl, tok = b * SEQ + s;
    const bf16_t* pa = (const bf16_t*)(p.ws + WS_PA);
#pragma unroll
    for (int gi = 0; gi < 5; ++gi) {
        const int cb = (gi < 3 ? gi * 384 + h * 64 : (gi == 3 ? 1152 : 1216)) + pc * 8;
        P.cur[gi] = *(const u32x4*)(pa + (size_t)tok * PA_W + cb);
    }
}
__device__ __forceinline__ void rwkv_chunk_task(const Params& p, int l, int task, int task_next, ChunkPre& P, LAS unsigned char* lds) {
    const int bh = task / 64, ch = task % 64, b = bh / 6, h = bh % 6;
    const int tid = tidx(), tl = tid >> 3, pc = tid & 7;
    const int s = ch * 64 + tl, tok = b * SEQ + s;
    LAS float* sh = (LAS float*)lds;
    LAS float* ops = (LAS float*)lds;
    LAS float* vimg = (LAS float*)(lds + 81920);
    LAS float* y0l = (LAS float*)(lds + 98304);
    LAS bf16_t* qlds = (LAS bf16_t*)(lds + 114688);
    const float* mu = p.in[I_MU] + l * 1280;
    __syncthreads();
    LAS unsigned char* a34 = lds + 49152; LAS unsigned char* wat = lds + 67584; LAS float* lres = (LAS float*)(lds + 86016);
#pragma unroll
    for (int gi = 0; gi < 5; ++gi) {
        const int cb = (gi < 3 ? gi * 384 + h * 64 : (gi == 3 ? 1152 : 1216)) + pc * 8;
        const u32x4 cur = P.cur[gi];
        u32x4 prv = {0u, 0u, 0u, 0u};
        if (s > 0) prv = *(const u32x4*)((const bf16_t*)(p.ws + WS_PA) + (size_t)(tok - 1) * PA_W + cb);
        float vals[8];
#pragma unroll
        for (int q = 0; q < 4; ++q) {
            const float c0 = bflo(cur[q]), c1 = bfhi(cur[q]), p0 = bflo(prv[q]), p1 = bfhi(prv[q]);
            float v0 = c0 + (p0 - c0) * mu[cb + 2 * q], v1 = c1 + (p1 - c1) * mu[cb + 2 * q + 1];
            if (gi == 3) { v0 = 1.0f - 2.0f * __builtin_amdgcn_rcpf(1.0f + __expf(2.0f * v0)); v1 = 1.0f - 2.0f * __builtin_amdgcn_rcpf(1.0f + __expf(2.0f * v1)); }
            vals[2 * q] = v0; vals[2 * q + 1] = v1;
        }
        if (gi < 3) {
#pragma unroll
            for (int q = 0; q < 8; ++q) sh[gi * 4096 + tl * 64 + pc * 8 + q] = vals[q];
        } else {
            u32x4 w; w.x = pk2(vals[0], vals[1]); w.y = pk2(vals[2], vals[3]); w.z = pk2(vals[4], vals[5]); w.w = pk2(vals[6], vals[7]);
            *(LAS u32x4*)(a34 + (gi - 3) * 9216 + tl * 144 + pc * 16) = w;
        }
    }
    {
        const float* wsrc = p.in[I_WUP] + (size_t)l * 64 * 384 + (size_t)tl * 384 + h * 64 + pc * 8;
        const float* asrc = p.in[I_AUP] + (size_t)l * 64 * 384 + (size_t)tl * 384 + h * 64 + pc * 8;
        const f32x4 w0 = *(const f32x4*)wsrc, w1 = *(const f32x4*)(wsrc + 4), a0 = *(const f32x4*)asrc, a1 = *(const f32x4*)(asrc + 4);
#pragma unroll
        for (int q = 0; q < 4; ++q) {
            *(LAS bf16_t*)(wat + (pc * 8 + q) * 144 + tl * 2) = (bf16_t)(pk2(w0[q], 0.f) & 0xFFFFu); *(LAS bf16_t*)(wat + (pc * 8 + 4 + q) * 144 + tl * 2) = (bf16_t)(pk2(w1[q], 0.f) & 0xFFFFu);
            *(LAS bf16_t*)(wat + 9216 + (pc * 8 + q) * 144 + tl * 2) = (bf16_t)(pk2(a0[q], 0.f) & 0xFFFFu); *(LAS bf16_t*)(wat + 9216 + (pc * 8 + 4 + q) * 144 + tl * 2) = (bf16_t)(pk2(a1[q], 0.f) & 0xFFFFu);
        }
    }
    __syncthreads();
    if (task_next >= 0) rwkv_chunk_load(p, task_next, P);
    {
        const int wave = tid >> 6, lane = tid & 63, lq = lane & 15, g = lane >> 4, mat = wave >> 2, mt = wave & 3;
        const LAS unsigned char* Am = a34 + mat * 9216; const LAS unsigned char* Bm = wat + mat * 9216;
        const bf16x8 x0 = *(const LAS bf16x8*)(Am + (16 * mt + lq) * 144 + g * 16), x1 = *(const LAS bf16x8*)(Am + (16 * mt + lq) * 144 + 64 + g * 16);
#pragma unroll
        for (int nt = 0; nt < 4; ++nt) {
            const bf16x8 y0 = *(const LAS bf16x8*)(Bm + (16 * nt + lq) * 144 + g * 16), y1 = *(const LAS bf16x8*)(Bm + (16 * nt + lq) * 144 + 64 + g * 16);
            f32x4 D = {0.f, 0.f, 0.f, 0.f};
            D = __builtin_amdgcn_mfma_f32_16x16x32_bf16(x0, y0, D, 0, 0, 0);
            D = __builtin_amdgcn_mfma_f32_16x16x32_bf16(x1, y1, D, 0, 0, 0);
#pragma unroll
            for (int i = 0; i < 4; ++i) lres[mat * 4096 + (16 * mt + 4 * g + i) * 64 + 16 * nt + lq] = D[i];
        }
    }
    __syncthreads();
    const int cbase = l * 384 + h * 64 + pc * 8;
    float wa[8], aa[8];
#pragma unroll
    for (int j = 0; j < 8; ++j) { wa[j] = p.in[I_W0][cbase + j] + lres[tl * 64 + pc * 8 + j]; aa[j] = p.in[I_A0][cbase + j] + lres[4096 + tl * 64 + pc * 8 + j]; }
    __syncthreads();
    {
        float wv[8], av[8], kkv[8], kp[8], rv[8], vv[8];
        float ssq = 0.f, bon = 0.f;
#pragma unroll
        for (int j = 0; j < 8; ++j) {
            const float z = -wa[j];
            const float sp = fmaxf(z, 0.f) + __logf(1.0f + __expf(-fabsf(z)));
            wv[j] = __expf(-__expf(-sp - 0.5f));
            av[j] = __builtin_amdgcn_rcpf(1.0f + __expf(-aa[j]));
            const float kraw = sh[1 * 4096 + tl * 64 + pc * 8 + j];
            kkv[j] = kraw * p.in[I_KK][cbase + j];
            ssq += kkv[j] * kkv[j];
            kp[j] = kraw * (1.0f + (av[j] - 1.0f) * p.in[I_KA][cbase + j]);
            rv[j] = sh[0 * 4096 + tl * 64 + pc * 8 + j]; vv[j] = sh[2 * 4096 + tl * 64 + pc * 8 + j];
            bon += rv[j] * kp[j] * p.in[I_RK][cbase + j];
        }
        ssq = sum8(ssq); bon = sum8(bon);
        const float inv = rsqrtf(ssq + 1e-12f);
        __syncthreads();
        LAS float* ob = ops + tl * 320 + pc * 8;
#pragma unroll
        for (int j = 0; j < 8; ++j) {
            const float kk = kkv[j] * inv;
            ob[j] = wv[j]; ob[64 + j] = kk; ob[128 + j] = kk * av[j]; ob[192 + j] = rv[j]; ob[256 + j] = kp[j];
            vimg[tl * 64 + pc * 8 + j] = vv[j];
        }
        u32x4 w; w.x = pk2(bon * vv[0], bon * vv[1]); w.y = pk2(bon * vv[2], bon * vv[3]); w.z = pk2(bon * vv[4], bon * vv[5]); w.w = pk2(bon * vv[6], bon * vv[7]);
        *(u32x4*)((bf16_t*)(p.ws + WS_BV) + (size_t)task * CH_ELEMS + tl * 64 + pc * 8) = w;
    }
    __syncthreads();
    const int rp = tid >> 3, kq = tid & 7;
    const bool isH = rp < 32;
    const int rowA = isH ? 2 * rp : 2 * (rp - 32);
    const int posA = ((rowA >> 2) & 3) * 16 + (rowA >> 4) * 4 + (rowA & 3);
    f32x2 S0[4], S1[4];
#pragma unroll
    for (int q = 0; q < 4; ++q) {
        S0[q] = (f32x2){0.f, 0.f}; S1[q] = (f32x2){0.f, 0.f};
        if (!isH) {
            S0[q].x = (8 * kq + 2 * q == rowA) ? 1.f : 0.f; S0[q].y = (8 * kq + 2 * q + 1 == rowA) ? 1.f : 0.f;
            S1[q].x = (8 * kq + 2 * q == rowA + 1) ? 1.f : 0.f; S1[q].y = (8 * kq + 2 * q + 1 == rowA + 1) ? 1.f : 0.f;
        }
    }
    const LAS float* o_b = ops + kq * 8; const LAS float* o_v = vimg + rowA;
    struct Ops { f32x4 w0, w1, kk0, kk1, bb0, bb1, k0, k1, r0, r1; f32x2 v; };
#define CK_LOAD(O, t, HASV) do { const LAS float* _b = o_b + (t) * 320; O.w0 = *(const LAS f32x4*)(_b); O.w1 = *(const LAS f32x4*)(_b + 4); O.kk0 = *(const LAS f32x4*)(_b + 64); O.kk1 = *(const LAS f32x4*)(_b + 68); \
        O.bb0 = *(const LAS f32x4*)(_b + 128); O.bb1 = *(const LAS f32x4*)(_b + 132); O.r0 = *(const LAS f32x4*)(_b + 192); O.r1 = *(const LAS f32x4*)(_b + 196); \
        if (HASV) { O.k0 = *(const LAS f32x4*)(_b + 256); O.k1 = *(const LAS f32x4*)(_b + 260); O.v = *(const LAS f32x2*)(o_v + (t) * 64); } } while (0)
#define CK_P(X, q) ((f32x2){X##0[(q) * 2 & 3], X##0[((q) * 2 & 3) + 1]})
#define CK_STEP(O, t, HASV) do { \
        const f32x2 w_0 = {O.w0[0], O.w0[1]}, w_1 = {O.w0[2], O.w0[3]}, w_2 = {O.w1[0], O.w1[1]}, w_3 = {O.w1[2], O.w1[3]}; \
        const f32x2 kk_0 = {O.kk0[0], O.kk0[1]}, kk_1 = {O.kk0[2], O.kk0[3]}, kk_2 = {O.kk1[0], O.kk1[1]}, kk_3 = {O.kk1[2], O.kk1[3]}; \
        const f32x2 bb_0 = {O.bb0[0], O.bb0[1]}, bb_1 = {O.bb0[2], O.bb0[3]}, bb_2 = {O.bb1[0], O.bb1[1]}, bb_3 = {O.bb1[2], O.bb1[3]}; \
        const f32x2 r_0 = {O.r0[0], O.r0[1]}, r_1 = {O.r0[2], O.r0[3]}, r_2 = {O.r1[0], O.r1[1]}, r_3 = {O.r1[2], O.r1[3]}; \
        f32x2 a0 = S0[0] * kk_0, a1 = S1[0] * kk_0; a0 = S0[1] * kk_1 + a0; a1 = S1[1] * kk_1 + a1; a0 = S0[2] * kk_2 + a0; a1 = S1[2] * kk_2 + a1; a0 = S0[3] * kk_3 + a0; a1 = S1[3] * kk_3 + a1; \
        float sa0 = a0.x + a0.y, sa1 = a1.x + a1.y; \
        sa0 += dppf<0xB1>(sa0); sa1 += dppf<0xB1>(sa1); sa0 += dppf<0x4E>(sa0); sa1 += dppf<0x4E>(sa1); sa0 = -(sa0 + dppf<0x141>(sa0)); sa1 = -(sa1 + dppf<0x141>(sa1)); \
        if (HASV) { const f32x2 k_0 = {O.k0[0], O.k0[1]}, k_1 = {O.k0[2], O.k0[3]}, k_2 = {O.k1[0], O.k1[1]}, k_3 = {O.k1[2], O.k1[3]}; const float v0 = O.v.x, v1 = O.v.y; \
            S0[0] = S0[0] * w_0 + (bb_0 * sa0 + k_0 * v0); S1[0] = S1[0] * w_0 + (bb_0 * sa1 + k_0 * v1); S0[1] = S0[1] * w_1 + (bb_1 * sa0 + k_1 * v0); S1[1] = S1[1] * w_1 + (bb_1 * sa1 + k_1 * v1); \
            S0[2] = S0[2] * w_2 + (bb_2 * sa0 + k_2 * v0); S1[2] = S1[2] * w_2 + (bb_2 * sa1 + k_2 * v1); S0[3] = S0[3] * w_3 + (bb_3 * sa0 + k_3 * v0); S1[3] = S1[3] * w_3 + (bb_3 * sa1 + k_3 * v1); \
        } else { \
            S0[0] = S0[0] * w_0 + bb_0 * sa0; S1[0] = S1[0] * w_0 + bb_0 * sa1; S0[1] = S0[1] * w_1 + bb_1 * sa0; S1[1] = S1[1] * w_1 + bb_1 * sa1; \
            S0[2] = S0[2] * w_2 + bb_2 * sa0; S1[2] = S1[2] * w_2 + bb_2 * sa1; S0[3] = S0[3] * w_3 + bb_3 * sa0; S1[3] = S1[3] * w_3 + bb_3 * sa1; } \
        f32x2 y0 = S0[0] * r_0, y1 = S1[0] * r_0; y0 = S0[1] * r_1 + y0; y1 = S1[1] * r_1 + y1; y0 = S0[2] * r_2 + y0; y1 = S1[2] * r_2 + y1; y0 = S0[3] * r_3 + y0; y1 = S1[3] * r_3 + y1; \
        float ya = y0.x + y0.y, yb = y1.x + y1.y; \
        ya += dppf<0xB1>(ya); yb += dppf<0xB1>(yb); ya += dppf<0x4E>(ya); yb += dppf<0x4E>(yb); ya += dppf<0x141>(ya); yb += dppf<0x141>(yb); \
        { if (HASV) *(LAS f32x2*)(y0l + (t) * 64 + rowA) = (f32x2){ya, yb}; else *(LAS unsigned*)(qlds + (t) * 64 + posA) = pk2(ya, yb); } } while (0)
    Ops OA, OB;
    if (isH) {
        CK_LOAD(OA, 0, true);
        for (int t = 0; t < 64; t += 4) { CK_LOAD(OB, t + 1, true); CK_STEP(OA, t, true); CK_LOAD(OA, t + 2, true); CK_STEP(OB, t + 1, true); CK_LOAD(OB, t + 3, true); CK_STEP(OA, t + 2, true); if (t + 4 < 64) CK_LOAD(OA, t + 4, true); CK_STEP(OB, t + 3, true); }
    } else {
        CK_LOAD(OA, 0, false);
        for (int t = 0; t < 64; t += 4) { CK_LOAD(OB, t + 1, false); CK_STEP(OA, t, false); CK_LOAD(OA, t + 2, false); CK_STEP(OB, t + 1, false); CK_LOAD(OB, t + 3, false); CK_STEP(OA, t + 2, false); if (t + 4 < 64) CK_LOAD(OA, t + 4, false); CK_STEP(OB, t + 3, false); }
    }
#undef CK_LOAD
#undef CK_P
#undef CK_STEP
    if (isH) {
        bf16_t* hm = (bf16_t*)(p.ws + WS_HM) + (size_t)task * CH_ELEMS + ((kq & 1) * 2) * 16 + (kq >> 1) * 4;
        u32x2 w; w.x = pk2(S0[0].x, S0[0].y); w.y = pk2(S0[1].x, S0[1].y); *(u32x2*)(hm + (size_t)rowA * 64) = w;
        w.x = pk2(S0[2].x, S0[2].y); w.y = pk2(S0[3].x, S0[3].y); *(u32x2*)(hm + (size_t)rowA * 64 + 16) = w;
        w.x = pk2(S1[0].x, S1[0].y); w.y = pk2(S1[1].x, S1[1].y); *(u32x2*)(hm + (size_t)(rowA + 1) * 64) = w;
        w.x = pk2(S1[2].x, S1[2].y); w.y = pk2(S1[3].x, S1[3].y); *(u32x2*)(hm + (size_t)(rowA + 1) * 64 + 16) = w;
    } else {
        bf16_t* gt = (bf16_t*)(p.ws + WS_GT) + (size_t)task * CH_ELEMS + posA;
#pragma unroll
        for (int q = 0; q < 4; ++q) {
            *(unsigned*)(gt + (size_t)(8 * kq + 2 * q) * 64) = pk2(S0[q].x, S1[q].x);
            *(unsigned*)(gt + (size_t)(8 * kq + 2 * q + 1) * 64) = pk2(S0[q].y, S1[q].y);
        }
    }
    __syncthreads();
    {
        *(u32x4*)((bf16_t*)(p.ws + WS_QQ) + (size_t)task * CH_ELEMS + tid * 8) = *(const LAS u32x4*)(qlds + tid * 8);
        const f32x4 ya = *(const LAS f32x4*)(y0l + tid * 8), yb = *(const LAS f32x4*)(y0l + tid * 8 + 4);
        u32x4 w; w.x = pk2(ya[0], ya[1]); w.y = pk2(ya[2], ya[3]); w.z = pk2(yb[0], yb[1]); w.w = pk2(yb[2], yb[3]);
        *(u32x4*)((bf16_t*)(p.ws + WS_Y0) + (size_t)task * CH_ELEMS + tid * 8) = w;
    }
}

constexpr int RC_PITCH = 144, RC_IMG = 64 * RC_PITCH, RC_SLOT = 2 * RC_IMG;
__device__ __forceinline__ void recur_task(const Params& p, int l, int bh, LAS unsigned char* lds) {
    const int tid = tidx(), wave = tid >> 6, lane = tid & 63, lq = lane & 15, g = lane >> 4;
    const int v = (wave & 3) * 16 + lq;
    const bf16_t* GT = (const bf16_t*)(p.ws + WS_GT) + (size_t)bh * 64 * CH_ELEMS;
    const bf16_t* HM = (const bf16_t*)(p.ws + WS_HM) + (size_t)bh * 64 * CH_ELEMS;
    bf16_t* SC = (bf16_t*)(p.ws + WS_SC) + (size_t)bh * 64 * CH_ELEMS;
    const int srow = tid >> 3, spc = tid & 7;
    const int soff = srow * RC_PITCH + spc * 16;
    f32x4 sacc[4];
#pragma unroll
    for (int mt = 0; mt < 4; ++mt) sacc[mt] = (f32x4){0.f, 0.f, 0.f, 0.f};
    u32x4 bS[2] = {{0u, 0u, 0u, 0u}, {0u, 0u, 0u, 0u}};
    u32x4 sgA[4], shA[4], sgB[4], shB[4];
#define RC_LD(SG, SH, grpi) do { _Pragma("unroll") for (int i = 0; i < 4; ++i) { SG[i] = *(const u32x4*)(GT + (size_t)((grpi) * 4 + i) * CH_ELEMS + tid * 8); SH[i] = *(const u32x4*)(HM + (size_t)((grpi) * 4 + i) * CH_ELEMS + tid * 8); } } while (0)
#define RC_ST(SG, SH) do { _Pragma("unroll") for (int i = 0; i < 4; ++i) { *(LAS u32x4*)(lds + i * RC_SLOT + soff) = SG[i]; *(LAS u32x4*)(lds + i * RC_SLOT + RC_IMG + soff) = SH[i]; } } while (0)
    RC_LD(sgA, shA, 0); RC_LD(sgB, shB, 1);
    __syncthreads();
    for (int grp = 0; grp < 16; ++grp) {
        if (grp & 1) { RC_ST(sgB, shB); if (grp + 2 < 16) RC_LD(sgB, shB, grp + 2); }
        else         { RC_ST(sgA, shA); if (grp + 2 < 16) RC_LD(sgA, shA, grp + 2); }
        __syncthreads();
        if (wave < 4) {
#pragma unroll 1
            for (int i = 0; i < 4; ++i) {
                const int c = grp * 4 + i;
                const LAS unsigned char* G = lds + i * RC_SLOT;
                u32x4 w0, w1;
                w0.x = pk2(sacc[0][0], sacc[0][1]); w0.y = pk2(sacc[0][2], sacc[0][3]); w0.z = pk2(sacc[1][0], sacc[1][1]); w0.w = pk2(sacc[1][2], sacc[1][3]);
                w1.x = pk2(sacc[2][0], sacc[2][1]); w1.y = pk2(sacc[2][2], sacc[2][3]); w1.z = pk2(sacc[3][0], sacc[3][1]); w1.w = pk2(sacc[3][2], sacc[3][3]);
                *(u32x4*)(SC + (size_t)c * CH_ELEMS + v * 64 + 16 * g) = w0; *(u32x4*)(SC + (size_t)c * CH_ELEMS + v * 64 + 16 * g + 8) = w1;
                const u32x4 h0 = *(const LAS u32x4*)(G + RC_IMG + v * RC_PITCH + g * 32), h1 = *(const LAS u32x4*)(G + RC_IMG + v * RC_PITCH + g * 32 + 16);
                f32x4 D[4];
                D[0] = (f32x4){bflo(h0.x), bfhi(h0.x), bflo(h0.y), bfhi(h0.y)}; D[1] = (f32x4){bflo(h0.z), bfhi(h0.z), bflo(h0.w), bfhi(h0.w)};
                D[2] = (f32x4){bflo(h1.x), bfhi(h1.x), bflo(h1.y), bfhi(h1.y)}; D[3] = (f32x4){bflo(h1.z), bfhi(h1.z), bflo(h1.w), bfhi(h1.w)};
#pragma unroll
                for (int mt = 0; mt < 4; ++mt)
#pragma unroll
                    for (int ks = 0; ks < 2; ++ks) {
                        const bf16x8 a = *(const LAS bf16x8*)(G + (16 * mt + lq) * RC_PITCH + g * 32 + ks * 16);
                        D[mt] = __builtin_amdgcn_mfma_f32_16x16x32_bf16(a, __builtin_bit_cast(bf16x8, bS[ks]), D[mt], 0, 0, 0);
                    }
#pragma unroll
                for (int mt = 0; mt < 4; ++mt) sacc[mt] = D[mt];
#pragma unroll
                for (int ks = 0; ks < 2; ++ks) {
                    bS[ks].x = pk2(D[2 * ks][0], D[2 * ks][1]); bS[ks].y = pk2(D[2 * ks][2], D[2 * ks][3]);
                    bS[ks].z = pk2(D[2 * ks + 1][0], D[2 * ks + 1][1]); bS[ks].w = pk2(D[2 * ks + 1][2], D[2 * ks + 1][3]);
                }
            }
        }
        __syncthreads();
    }
    asm volatile("s_waitcnt vmcnt(0)" ::: "memory");
    __syncthreads();
    if (threadIdx.x == 0) {
        __builtin_amdgcn_fence(__ATOMIC_RELEASE, "agent");
        asm volatile("s_waitcnt vmcnt(0)" ::: "memory");
        __hip_atomic_store((unsigned*)(p.ws + WS_FLAG) + bh, (unsigned)(l + 1), __ATOMIC_RELAXED, __HIP_MEMORY_SCOPE_AGENT);
    }
}

__device__ __forceinline__ void rwkv_out_task(const Params& p, int l, int pairtask) {
    const int tid = tidx(), wave = tid >> 6, lane = tid & 63, lq = lane & 15, g = lane >> 4;
    const int chunk = pairtask * 2 + (wave >> 2), bh = chunk / 64, ch = chunk % 64, b = bh / 6, h = bh % 6;
    const int t = (wave & 3) * 16 + lq;
    const int tok = b * SEQ + ch * 64 + t;
    const bf16_t* SC = (const bf16_t*)(p.ws + WS_SC) + (size_t)chunk * CH_ELEMS;
    const bf16_t* QQ = (const bf16_t*)(p.ws + WS_QQ) + (size_t)chunk * CH_ELEMS;
    const bf16_t* Y0 = (const bf16_t*)(p.ws + WS_Y0) + (size_t)chunk * CH_ELEMS;
    const bf16_t* BV = (const bf16_t*)(p.ws + WS_BV) + (size_t)chunk * CH_ELEMS;
    const bf16_t* sg = (const bf16_t*)(p.ws + WS_GATE) + (size_t)tok * 1024 + h * 64;
    bf16_t* yg = (bf16_t*)(p.ws + WS_YG) + (size_t)tok * 1024 + h * 64;
    bf16x8 bQ[2], aS[4][2]; u32x2 y0[4], bv[4], gt[4]; f32x4 gg[4], gb[4];
#pragma unroll
    for (int ks = 0; ks < 2; ++ks) bQ[ks] = *(const bf16x8*)(QQ + t * 64 + 32 * ks + 8 * g);
#pragma unroll
    for (int vt = 0; vt < 4; ++vt) {
        const int vv = 16 * vt + 4 * g;
        y0[vt] = *(const u32x2*)(Y0 + t * 64 + vv);
#pragma unroll
        for (int ks = 0; ks < 2; ++ks) aS[vt][ks] = *(const bf16x8*)(SC + (16 * vt + lq) * 64 + 32 * ks + 8 * g);
        bv[vt] = *(const u32x2*)(BV + t * 64 + vv); gt[vt] = *(const u32x2*)(sg + vv);
        gg[vt] = *(const f32x4*)(p.in[I_LNG] + l * 384 + h * 64 + vv); gb[vt] = *(const f32x4*)(p.in[I_LNB] + l * 384 + h * 64 + vv);
    }
    f32x4 D[4];
#pragma unroll
    for (int vt = 0; vt < 4; ++vt) {
        D[vt] = (f32x4){bflo(y0[vt].x), bfhi(y0[vt].x), bflo(y0[vt].y), bfhi(y0[vt].y)};
#pragma unroll
        for (int ks = 0; ks < 2; ++ks) D[vt] = __builtin_amdgcn_mfma_f32_16x16x32_bf16(aS[vt][ks], bQ[ks], D[vt], 0, 0, 0);
    }
    float sm = 0.f;
#pragma unroll
    for (int vt = 0; vt < 4; ++vt) sm += (D[vt][0] + D[vt][1]) + (D[vt][2] + D[vt][3]);
    sm += __shfl_xor(sm, 16); sm += __shfl_xor(sm, 32);
    const float mean = sm * (1.0f / 64.0f);
    float vs = 0.f;
#pragma unroll
    for (int vt = 0; vt < 4; ++vt) { D[vt] -= mean; vs += (D[vt][0] * D[vt][0] + D[vt][1] * D[vt][1]) + (D[vt][2] * D[vt][2] + D[vt][3] * D[vt][3]); }
    vs += __shfl_xor(vs, 16); vs += __shfl_xor(vs, 32);
    const float rstd = rsqrtf(vs * (1.0f / 64.0f) + 64e-5f);
#pragma unroll
    for (int vt = 0; vt < 4; ++vt) {
        const float o0 = (D[vt][0] * rstd * gg[vt][0] + gb[vt][0] + bflo(bv[vt].x)) * bflo(gt[vt].x), o1 = (D[vt][1] * rstd * gg[vt][1] + gb[vt][1] + bfhi(bv[vt].x)) * bfhi(gt[vt].x);
        const float o2 = (D[vt][2] * rstd * gg[vt][2] + gb[vt][2] + bflo(bv[vt].y)) * bflo(gt[vt].y), o3 = (D[vt][3] * rstd * gg[vt][3] + gb[vt][3] + bfhi(bv[vt].y)) * bfhi(gt[vt].y);
        u32x2 w; w.x = pk2(o0, o1); w.y = pk2(o2, o3);
        *(u32x2*)(yg + 16 * vt + 4 * g) = w;
    }
}

constexpr int GT_AP = 64 * 144, GT_BP = 128 * 144, GT_BUF = GT_AP + GT_BP;
__device__ __forceinline__ void gate_tail_task(const Params& p, int l, int task, LAS unsigned char* lds) {
    const int tid = tidx(), wave = tid >> 6, lane = tid & 63, lq = lane & 15, g = lane >> 4;
    const int r0 = task * 64, nq = wave & 3, mh = wave >> 2;
    const bf16_t* xb = (const bf16_t*)(p.ws + WS_XB) + (size_t)r0 * 1024;
    const bf16_t* wt = (const bf16_t*)(p.ws + ((l & 1) ? WS_WIN1 : WS_WIN)) + (size_t)4096 * 1024;
    const int srow = tid >> 3, spc = tid & 7;
    const int tokrow = r0 + nq * 16 + lq;
    const float* sq = (const float*)(p.ws + WS_SSQ) + (size_t)tokrow * 16;
    const f32x4 q0 = *(const f32x4*)sq, q1 = *(const f32x4*)(sq + 4), q2 = *(const f32x4*)(sq + 8), q3 = *(const f32x4*)(sq + 12);
    f32x4 acc[4];
#pragma unroll
    for (int mt = 0; mt < 4; ++mt) acc[mt] = (f32x4){0.f, 0.f, 0.f, 0.f};
    u32x4 aA, bA0, bA1, aB, bB0, bB1;
#define GT_LOAD(kt, AR, BR0, BR1) do { AR = *(const u32x4*)(xb + (size_t)srow * 1024 + (kt) * 64 + spc * 8); \
        BR0 = *(const u32x4*)(wt + (size_t)srow * 1024 + (kt) * 64 + spc * 8); BR1 = *(const u32x4*)(wt + (size_t)(srow + 64) * 1024 + (kt) * 64 + spc * 8); } while (0)
#define GT_STORE(buf, AR, BR0, BR1) do { LAS unsigned char* _B = lds + (buf) * GT_BUF; *(LAS u32x4*)(_B + srow * 144 + spc * 16) = AR; \
        *(LAS u32x4*)(_B + GT_AP + srow * 144 + spc * 16) = BR0; *(LAS u32x4*)(_B + GT_AP + (srow + 64) * 144 + spc * 16) = BR1; } while (0)
#define GT_COMPUTE(buf) do { const LAS unsigned char* _B = lds + (buf) * GT_BUF; _Pragma("unroll") for (int ks = 0; ks < 2; ++ks) { \
        const bf16x8 xf = *(const LAS bf16x8*)(_B + (nq * 16 + lq) * 144 + ks * 64 + g * 16); \
        _Pragma("unroll") for (int mt = 0; mt < 4; ++mt) { const bf16x8 wf = *(const LAS bf16x8*)(_B + GT_AP + (mh * 64 + mt * 16 + lq) * 144 + ks * 64 + g * 16); \
            acc[mt] = __builtin_amdgcn_mfma_f32_16x16x32_bf16(wf, xf, acc[mt], 0, 0, 0); } } } while (0)
    GT_LOAD(0, aA, bA0, bA1);
    GT_LOAD(1, aB, bB0, bB1);
    __syncthreads();
    GT_STORE(0, aA, bA0, bA1);
    GT_LOAD(2, aA, bA0, bA1);
    __syncthreads();
    for (int kt = 0; kt < 16; kt += 2) {
        GT_COMPUTE(0);
        GT_STORE(1, aB, bB0, bB1);
        if (kt + 3 < 16) GT_LOAD(kt + 3, aB, bB0, bB1);
        __syncthreads();
        GT_COMPUTE(1);
        if (kt + 2 < 16) { GT_STORE(0, aA, bA0, bA1); if (kt + 4 < 16) GT_LOAD(kt + 4, aA, bA0, bA1); }
        __syncthreads();
    }
#undef GT_LOAD
#undef GT_STORE
#undef GT_COMPUTE
    const float ssum = ((q0[0] + q0[1]) + (q0[2] + q0[3])) + ((q1[0] + q1[1]) + (q1[2] + q1[3])) + ((q2[0] + q2[1]) + (q2[2] + q2[3])) + ((q3[0] + q3[1]) + (q3[2] + q3[3]));
    const float rs = rsqrtf(ssum * (1.0f / 1024.0f) + 1e-6f);
    bf16_t* gate = (bf16_t*)(p.ws + WS_GATE) + (size_t)tokrow * 1024 + 896 + mh * 64 + 4 * g;
#pragma unroll
    for (int mt = 0; mt < 4; ++mt) {
        f32x4 v = acc[mt] * rs;
#pragma unroll
        for (int j = 0; j < 4; ++j) v[j] = v[j] * __builtin_amdgcn_rcpf(1.0f + __expf(-v[j]));
        u32x2 w; w.x = pk2(v[0], v[1]); w.y = pk2(v[2], v[3]);
        *(u32x2*)(gate + mt * 16) = w;
    }
}

#define XB_TMO      128
#define XB_XCNT(j)  (256  + 64 * (j))
#define XB_XSUB(j)  (1280 + 64 * (j))
#define XB_XGEN(j)  (2304 + 64 * (j))
#define XB_TOP      3328
#define XB_TOPGEN   3392
#define XCD_BAR_WORDS 3456
#define XB_SPIN_CAP (1u << 18)

__device__ __forceinline__ unsigned xb_ld(unsigned* p)              { return __hip_atomic_load(p, __ATOMIC_RELAXED, __HIP_MEMORY_SCOPE_AGENT); }
__device__ __forceinline__ unsigned xb_add(unsigned* p, unsigned v) { return __hip_atomic_fetch_add(p, v, __ATOMIC_RELAXED, __HIP_MEMORY_SCOPE_AGENT); }
__device__ __forceinline__ unsigned xb_xcc_id() { return (unsigned)__builtin_amdgcn_s_getreg((3 << 11) | 20) & 0xFu; }
#define XB_SPIN(cond, bar) do { unsigned _sp = 0; while (cond) { __builtin_amdgcn_s_sleep(1); \
    if ((++_sp & 255u) == 0u) { if (xb_ld(&(bar)[XB_TMO])) break; if (_sp > XB_SPIN_CAP) { atomicAdd(&(bar)[XB_TMO], 1u); break; } } } } while (0)

struct XcdBarrier {
    unsigned* bar; unsigned x;
    volatile LAS unsigned* st;
};

__device__ __forceinline__ XcdBarrier xcd_barrier_post(unsigned* bar, volatile LAS unsigned* st) {
    XcdBarrier b; b.bar = bar; b.x = xb_xcc_id(); b.st = st;
    if (threadIdx.x == 0) (void)xb_add(&bar[XB_XCNT(b.x)], 1u);
    return b;
}
__device__ __forceinline__ void xcd_barrier_complete(unsigned* bar, unsigned x, unsigned& nloc, unsigned& nx) {
    const unsigned G = gridDim.x * gridDim.y * gridDim.z;
    unsigned sum, cnt, mine, sp = 0u;
    for (;;) {
        sum = 0u; cnt = 0u; mine = 0u;
#pragma unroll
        for (unsigned j = 0; j < 16; ++j) { const unsigned c = xb_ld(&bar[XB_XCNT(j)]); sum += c; cnt += (c > 0u) ? 1u : 0u; mine = (j == x) ? c : mine; }
        if (sum == G) break;
        __builtin_amdgcn_s_sleep(1);
        if ((++sp & 255u) == 0u) { if (xb_ld(&bar[XB_TMO])) break; if (sp > XB_SPIN_CAP) { atomicAdd(&bar[XB_TMO], 1u); break; } }
    }
    nloc = mine > 0u ? mine : 1u; nx = cnt > 0u ? cnt : 1u;
}

__device__ __forceinline__ void xcd_barrier(const XcdBarrier& b) {
    asm volatile("s_waitcnt vmcnt(0)" ::: "memory");
    __syncthreads();
    if (threadIdx.x == 0) {
        unsigned* bar = b.bar;
        __builtin_amdgcn_s_waitcnt(0);
        unsigned nloc = b.st[0], nx = b.st[1];
        if (nloc == 0u) { xcd_barrier_complete(bar, b.x, nloc, nx); b.st[0] = nloc; b.st[1] = nx; }
        const unsigned old = xb_add(&bar[XB_XSUB(b.x)], 1u);
        const unsigned gen = old / nloc;
        if (old + 1u == (gen + 1u) * nloc) {
            __builtin_amdgcn_fence(__ATOMIC_RELEASE, "agent");
            asm volatile("s_waitcnt vmcnt(0)" ::: "memory");
            const unsigned og = xb_add(&bar[XB_TOP], 1u);
            const unsigned tg = og / nx;
            if (og + 1u == (tg + 1u) * nx) xb_add(&bar[XB_TOPGEN], 1u);
            else XB_SPIN(xb_ld(&bar[XB_TOPGEN]) == tg, bar);
            __builtin_amdgcn_fence(__ATOMIC_ACQUIRE, "agent");
            xb_add(&bar[XB_XGEN(b.x)], 1u);
            asm volatile("s_waitcnt vmcnt(0)" ::: "memory");
        } else {
            XB_SPIN(xb_ld(&bar[XB_XGEN(b.x)]) == gen, bar);
            __builtin_amdgcn_fence(__ATOMIC_ACQUIRE, "agent");
            asm volatile("s_waitcnt vmcnt(0)" ::: "memory");
        }
    }
    __syncthreads();
}

__global__ void __launch_bounds__(512, 2) hymba_fwd(Params p) {
    extern __shared__ __attribute__((aligned(16))) unsigned char shm[];
    LAS unsigned char* lds = (LAS unsigned char*)shm;
    cg::grid_group grid = cg::this_grid();
    volatile LAS unsigned* xbst = (volatile LAS unsigned*)(lds + 131072);
    if (threadIdx.x < 4) xbst[threadIdx.x] = 0u;
    __syncthreads();
    XcdBarrier xb = xcd_barrier_post(p.bar, xbst);
    for (int ph = p.ph_lo; ph < p.ph_hi; ++ph) {
        if (ph > p.ph_lo) { if (ph > 1000) grid.sync(); else xcd_barrier(xb); }
#ifndef NO_P0
        if (ph == 0) { phase_prologue(p, lds); continue; }
#endif
        const int l = (ph - 1) / 5, sub = (ph - 1) % 5;
#ifdef REP_SUB
      for (int rep_i = 0; rep_i < ((sub == REP_SUB) ? 2 : 1); ++rep_i) {
        if (rep_i) xcd_barrier(xb);
#endif
        if (sub == 0) {
            pg8::Gemm g; g.A = (const bf16_t*)(p.ws + WS_XB); g.Bt = (const bf16_t*)(p.ws + ((l & 1) ? WS_WIN1 : WS_WIN)); g.M = T_TOK; g.N = 4096; g.K = 1024;
            pg8::StaticOrder S; S.init(g.M, g.N, (int)gridDim.x, (int)blockIdx.x);
            LAS float* rsl = (LAS float*)(lds + 131072 + 16);
            {
                pg8::Unit u0; S.next(0, u0);
                const int tid = tidx(), r = tid >> 1, hf = tid & 1;
                const float* q = (const float*)(p.ws + WS_SSQ) + (size_t)(u0.pm * 256 + r) * 16 + hf * 8;
                const f32x4 a = *(const f32x4*)q, bq4 = *(const f32x4*)(q + 4);
                float sm = ((a[0] + a[1]) + (a[2] + a[3])) + ((bq4[0] + bq4[1]) + (bq4[2] + bq4[3]));
                sm += __shfl_xor(sm, 1);
                if (hf == 0) rsl[r] = rsqrtf(sm * (1.0f / 1024.0f) + 1e-6f);
                __syncthreads();
            }
            EpiIn E; E.pa = (bf16_t*)(p.ws + WS_PA); E.pbc = (bf16_t*)(p.ws + WS_PBC); E.gate = (bf16_t*)(p.ws + WS_GATE); E.rsl = rsl;
            pg8::gemm_phase<EpiIn, pg8::StaticOrder, false>(lds, g, S, E, nullptr);
        } else if (sub == 1) {
            const int nconv = 64 + (l < 3 ? 4 * 68 : 0);
            const int ntask = 1536 + 1536 + 256 + 256 + nconv + 256;
            {
                ChunkPre cpre;
                if ((int)blockIdx.x < 1536) rwkv_chunk_load(p, blockIdx.x, cpre);
                for (int t = blockIdx.x; t < 1536; t += gridDim.x) rwkv_chunk_task(p, l, t, (t + (int)gridDim.x < 1536) ? t + (int)gridDim.x : -1, cpre, lds);
            }
            for (int t = 1536 + blockIdx.x; t < ntask; t += gridDim.x) {
                if (t < 2304) dil_run(p, l, (t - 1536) / 384, (t - 1536) % 384, lds);
                else if (t < 3072) {}
                else if (t < 3328) kmean_task(p, l, t - 3072, lds);
                else if (t < 3584) gate_tail_task(p, l, t - 3328, lds);
                else if (t >= 3584 + nconv) moba_route_task(p, l, t - 3584 - nconv, lds);
                else { const int c = t - 3584;
                    if (c < 64) convert_strip4(p.in[I_WOUT] + (size_t)l * 1024 * 1024, 1024, 1024, nullptr, (bf16_t*)(p.ws + WS_WOUT), (c & 3) * 4, c >> 2, lds);
                    else { const int u = c - 64; convert_strip4(p.in[I_WIN] + (size_t)(l + 1) * 1024 * 4224, 4224, 4224, p.in[I_NORMG] + (l + 1) * 1024, (bf16_t*)(p.ws + (((l + 1) & 1) ? WS_WIN1 : WS_WIN)), (u & 3) * 4, u >> 2, lds); }
                }
            }
        } else if (sub == 2) {
            if (blockIdx.x < 24) recur_task(p, l, blockIdx.x, lds);
            {
                LAS int* tnum = (LAS int*)(lds + 98304); LAS int* tstart = tnum + 256;
                const unsigned* cnt = (const unsigned*)(p.ws + WS_CNT) + l * 256;
                __syncthreads();
                if (threadIdx.x < 256) tnum[threadIdx.x] = (int)((cnt[threadIdx.x] + 127u) >> 7);
                __syncthreads();
                if (threadIdx.x < 64) {
                    const int a0 = tnum[4 * threadIdx.x], a1 = tnum[4 * threadIdx.x + 1], a2 = tnum[4 * threadIdx.x + 2], a3 = tnum[4 * threadIdx.x + 3];
                    const int sl = a0 + a1 + a2 + a3; int inc = sl;
#pragma unroll
                    for (int d = 1; d < 64; d <<= 1) { const int o = __shfl_up(inc, d); if ((int)threadIdx.x >= d) inc += o; }
                    const int ex = inc - sl;
                    tstart[4 * threadIdx.x] = ex; tstart[4 * threadIdx.x + 1] = ex + a0; tstart[4 * threadIdx.x + 2] = ex + a0 + a1; tstart[4 * threadIdx.x + 3] = ex + a0 + a1 + a2;
                    if (threadIdx.x == 63) tstart[256] = inc;
                }
                __syncthreads();
                const int total = tstart[256];
                auto lookup = [&](int t, int& e, int& i) { int lo = 0, hi = 256;
                    while (hi - lo > 1) { const int mid = (lo + hi) >> 1; if (tstart[mid] <= t) lo = mid; else hi = mid; }
                    e = lo; i = t - tstart[lo]; };
                auto cumw = [&](int w) -> long long { if (gridDim.x != 256u) return (long long)w * 28808ll / (long long)gridDim.x;
                    return w < 24 ? 82ll * w : (w < 176 ? 1968ll + 95ll * (w - 24) : 16408ll + 155ll * (w - 176)); };
                int t = (int)(((long long)total * cumw((int)blockIdx.x)) / 28808ll);
                const int t1 = (int)(((long long)total * cumw((int)blockIdx.x + 1)) / 28808ll);
                while (t < t1) {
                    int e, i; lookup(t, e, i);
                    const int iend = (tnum[e] - i < t1 - t) ? tnum[e] : i + (t1 - t);
                    moba_gather_run(p, l, e, i, iend, (int)cnt[e], lds);
                    t += iend - i;
                }
            }
            if (blockIdx.x >= 24) for (int t = blockIdx.x - 24; t < 384; t += gridDim.x - 24) dil_run(p, l, 2, t, lds);
        } else if (sub == 3) {
            for (int t = blockIdx.x; t < 256; t += gridDim.x) moba_own_run(p, l, t, lds);
            {
                if (threadIdx.x < 64) {
                    const unsigned* fl = (const unsigned*)(p.ws + WS_FLAG); unsigned spins = 0;
                    for (;;) {
                        const unsigned v = (threadIdx.x < 24) ? __hip_atomic_load(fl + threadIdx.x, __ATOMIC_RELAXED, __HIP_MEMORY_SCOPE_AGENT) : 0xFFFFFFFFu;
                        if (__all(v >= (unsigned)(l + 1)) || ++spins > (1u << 22)) break;
                        __builtin_amdgcn_s_sleep(2);
                    }
                    __builtin_amdgcn_fence(__ATOMIC_ACQUIRE, "agent");
                    asm volatile("s_waitcnt vmcnt(0)" ::: "memory");
                }
                __syncthreads();
            }
            for (int t = blockIdx.x; t < 768; t += gridDim.x) rwkv_out_task(p, l, t);
        } else {
            pg8::Gemm g; g.A = (const bf16_t*)(p.ws + WS_YG); g.Bt = (const bf16_t*)(p.ws + WS_WOUT); g.M = T_TOK; g.N = 1024; g.K = 1024;
            pg8::StaticOrder S; S.init(g.M, g.N, (int)gridDim.x, (int)blockIdx.x);
            EpiOut E; E.out = p.out; E.xb = (bf16_t*)(p.ws + WS_XB); E.ssq = (float*)(p.ws + WS_SSQ); E.last = (l == 3) ? 1 : 0;
#ifndef NO_G2
            pg8::gemm_phase<EpiOut, pg8::StaticOrder, false>(lds, g, S, E, nullptr);
#endif
        }
#ifdef REP_SUB
      }
#endif
    }
}

#ifndef MK_MULTI
#define MK_MULTI 0
#endif
extern "C" void kernel_launch(void* const* d_in, const int* in_sizes, int n_in, void* d_out, int out_size, void* d_ws, size_t ws_size, hipStream_t stream) {
    static int grid = 0;
    if (grid == 0) {
        int dev = 0, cus = 0, per_cu = 0;
        hipGetDevice(&dev);
        hipDeviceGetAttribute(&cus, hipDeviceAttributeMultiprocessorCount, dev);
        if (hipFuncSetAttribute((const void*)hymba_fwd, hipFuncAttributeMaxDynamicSharedMemorySize, LDS_BYTES) != hipSuccess) fprintf(stderr, "kernel_launch: hipFuncSetAttribute failed\n");
        if (hipOccupancyMaxActiveBlocksPerMultiprocessor(&per_cu, (const void*)hymba_fwd, NTHR, LDS_BYTES) != hipSuccess || per_cu < 1) { fprintf(stderr, "kernel_launch: occupancy query gave %d\n", per_cu); per_cu = 1; }
        (void)hipGetLastError();
        if (cus <= 0) cus = 256;
        grid = cus;
        if (ws_size < WS_END) fprintf(stderr, "kernel_launch: workspace too small: %zu < %zu\n", ws_size, (size_t)WS_END);
    }
    Params p{};
    for (int i = 0; i < 18; ++i) p.in[i] = (const float*)d_in[i];
    p.out = (float*)d_out; p.ws = (unsigned char*)d_ws; p.bar = (unsigned*)((unsigned char*)d_ws + WS_BAR);
    (void)hipMemsetAsync((unsigned char*)d_ws + WS_BAR, 0, (size_t)XCD_BAR_WORDS_C * 4 + 256 + 4096 + 256, stream);
#if MK_MULTI
    for (int ph = 0; ph < 21; ++ph) {
        p.ph_lo = ph; p.ph_hi = ph + 1;
        hipLaunchKernelGGL(hymba_fwd, dim3(grid), dim3(NTHR), LDS_BYTES, stream, p);
    }
#else
    p.ph_lo = 0; p.ph_hi = 21;
    void* args[] = {&p};
    hipError_t e = hipLaunchCooperativeKernel((const void*)hymba_fwd, dim3(grid), dim3(NTHR), args, LDS_BYTES, stream);
    if (e != hipSuccess) fprintf(stderr, "cooperative launch failed: %s (grid %d)\n", hipGetErrorString(e), grid);
#endif
}
```

```cpp
#include <hip/hip_runtime.h>
#include <hip/hip_cooperative_groups.h>
#include <cstdio>
namespace cg = cooperative_groups;
__device__ __forceinline__ int tidx() { int t = threadIdx.x; asm volatile("" : "+v"(t)); return t; }
namespace pg8 {
#define PG8_LAS __attribute__((address_space(3)))
typedef unsigned short bf16_t;
typedef short bf16x8 __attribute__((ext_vector_type(8)));
typedef float f32x4 __attribute__((ext_vector_type(4)));
typedef unsigned u32x4 __attribute__((ext_vector_type(4)));
constexpr int BM = 256, BK = 64, HALF = 128, HTB = HALF * BK * 2  , STAGE_BYTES = 8 * HTB, NXCD = 8, WGM = 8;

__host__ __device__ __forceinline__ int lds_byte(int r, int c) { const int st = (r >> 4) * 2 + (c >> 5), rr = r & 15, cc = c & 31, ob = rr * 64 + cc * 2; return st * 1024 + (ob ^ (((ob >> 9) & 1) << 5)); }
__host__ __device__ __forceinline__ void stage_rc(int b, int& R, int& C) { const int st = b / 1024, sb = b % 1024, swz = sb ^ (((sb >> 9) & 1) << 5); R = (st >> 1) * 16 + swz / 64; C = (st & 1) * 32 + (swz % 64) / 2; }
__host__ __device__ __forceinline__ int perm32(int rho) { const int n = rho >> 4, i = rho & 15; return 8 * (i >> 2) + 4 * n + (i & 3); }

struct Unit { int pm, pn; };
struct Gemm { const bf16_t* A; const bf16_t* Bt; int M, N, K; };

struct StaticOrder {
    int nM, nN, nwg, G, c;
    __host__ __device__ void init(int M, int N, int G_, int c_) { nM = M / BM; nN = N / BM; nwg = nM * nN; G = G_; c = c_; }
    __host__ __device__ bool next(int i, Unit& u) const {
        const long L = (long)i * G + c; if (L >= nwg) return false;
        int wgid = (int)L; { const int q = nwg / NXCD, r = nwg % NXCD, xcd = wgid % NXCD, off = wgid / NXCD; wgid = (xcd < r ? xcd * (q + 1) : r * (q + 1) + (xcd - r) * q) + off; }
        const int nig = WGM * nN, gid = wgid / nig, fm = gid * WGM, gsz = (nM - fm) < WGM ? (nM - fm) : WGM;
        u.pm = fm + ((wgid % nig) % gsz); u.pn = (wgid % nig) / gsz; return true;
    }
    __device__ __forceinline__ void a_ready(const Unit&) const {}
    __device__ __forceinline__ void done(const Unit&) const {}
};
__device__ __forceinline__ unsigned cvt_pk_bf16(float lo, float hi) { unsigned r; asm volatile("v_cvt_pk_bf16_f32 %0, %1, %2" : "=v"(r) : "v"(lo), "v"(hi)); return r; }
typedef float f32x2 __attribute__((ext_vector_type(2)));
template <class Epi, class Sched, bool STAMP = false>
__device__ __forceinline__ void gemm_phase(PG8_LAS unsigned char* lds, const Gemm g, const Sched& S, const Epi& E, unsigned long long* stamps) {
    const int tid = tidx(), wid = __builtin_amdgcn_readfirstlane(tid >> 6), lane = tid & 63, wr = wid >> 2, wc = wid & 3, fr = lane & 15, fq = lane >> 4;
    const int K = g.K, nt = K / BK;
    int ts_lo = 0, ts_hi = 0, nts = 0; const unsigned long long rt_entry = STAMP ? (unsigned long long)wall_clock64() : 0ull;
#define PG8_STAMP() do { if (STAMP && wid == 0 && nts < 64) { const unsigned long long _c = (unsigned long long)clock64(); \
        ts_lo = (lane == nts) ? (int)(unsigned)_c : ts_lo; ts_hi = (lane == nts) ? (int)(unsigned)(_c >> 32) : ts_hi; ++nts; } } while (0)
    PG8_STAMP();
    unsigned voffA[2], voffB[2];
#pragma unroll
    for (int i = 0; i < 2; ++i) { int R, C; stage_rc(tid * 16 + i * 8192, R, C); const int Rb = Epi::PERM ? ((R & ~31) + perm32(R & 31)) : R;
        voffA[i] = (unsigned)(R * K + C) * 2u; voffB[i] = (unsigned)(Rb * K + C) * 2u; }
    const size_t kstep = (size_t)(BK * 2);
    const size_t hstep = (size_t)HALF * K * 2;
    const size_t tstep = 2 * hstep;
    const unsigned ldsw = (unsigned)wid * 1024u;
    const int aoff = lds_byte(wr * 64 + fr, fq * 8), boff = lds_byte(wc * 32 + fr, fq * 8);
#define PG8_SA(b, h) (((b) * 2 + (h)) * HTB)
#define PG8_SB(b, h) ((4 + (b) * 2 + (h)) * HTB)
#define PG8_STAGE(bufoff, gbase, voff) do { _Pragma("unroll") for (int _i = 0; _i < 2; ++_i) \
        __builtin_amdgcn_global_load_lds((const unsigned*)((const char*)(gbase) + (voff)[_i]), (PG8_LAS unsigned*)(lds + (bufoff) + ldsw + _i * 8192), 16, 0, 0); } while (0)
#define PG8_LDA(dst, b, h) do { _Pragma("unroll") for (int m = 0; m < 4; ++m) _Pragma("unroll") for (int k = 0; k < 2; ++k) dst[m][k] = *(const PG8_LAS bf16x8*)(lds + PG8_SA(b, h) + aoff + m * 2048 + k * 1024); } while (0)
#define PG8_LDB(dst, b, h) do { _Pragma("unroll") for (int n = 0; n < 2; ++n) _Pragma("unroll") for (int k = 0; k < 2; ++k) dst[n][k] = *(const PG8_LAS bf16x8*)(lds + PG8_SB(b, h) + boff + n * 2048 + k * 1024); } while (0)
#define PG8_MMA(ai, bj, At, Bt) do { __builtin_amdgcn_s_setprio(1); _Pragma("unroll") for (int m = 0; m < 4; ++m) _Pragma("unroll") for (int n = 0; n < 2; ++n) _Pragma("unroll") for (int k = 0; k < 2; ++k) \
        acc[ai][bj][m][n] = __builtin_amdgcn_mfma_f32_16x16x32_bf16(Bt[n][k], At[m][k], acc[ai][bj][m][n], 0, 0, 0); __builtin_amdgcn_s_setprio(0); } while (0)
#define PG8_WAIT_V(n) asm volatile("s_waitcnt vmcnt(" #n ")" ::: "memory")
#define PG8_WAIT_L(n) asm volatile("s_waitcnt lgkmcnt(" #n ")" ::: "memory")
#define PG8_BAR __builtin_amdgcn_s_barrier()
#define PG8_SCHED __builtin_amdgcn_sched_barrier(0)
    Unit cur, nxt; int ui = 0;
    if (!S.next(0, cur)) return;
    f32x4 acc[2][2][4][2];
#pragma unroll
    for (int a = 0; a < 2; ++a)
#pragma unroll
        for (int b = 0; b < 2; ++b)
#pragma unroll
            for (int m = 0; m < 4; ++m)
#pragma unroll
                for (int n = 0; n < 2; ++n) acc[a][b][m][n] = (f32x4){0.f, 0.f, 0.f, 0.f};
    bf16x8 At[4][2], B0[2][2], B1[2][2];
    const char* cA = (const char*)g.A + (size_t)cur.pm * tstep; const char* cB = (const char*)g.Bt + (size_t)cur.pn * tstep;
    S.a_ready(cur);
    PG8_STAGE(PG8_SB(0, 0), cB, voffB); PG8_STAGE(PG8_SA(0, 0), cA, voffA); PG8_STAGE(PG8_SB(0, 1), cB + hstep, voffB); PG8_STAGE(PG8_SA(0, 1), cA + hstep, voffA);
    if (wr == 1) PG8_BAR;
    PG8_WAIT_V(4); PG8_BAR;
    PG8_STAGE(PG8_SB(1, 0), cB + kstep, voffB); PG8_STAGE(PG8_SA(1, 0), cA + kstep, voffA); PG8_STAGE(PG8_SB(1, 1), cB + hstep + kstep, voffB);
    PG8_WAIT_V(6); PG8_BAR;
    PG8_STAMP();
    for (;;) {
        const bool has_next = S.next(ui + 1, nxt);
        const char* nA = has_next ? (const char*)g.A + (size_t)nxt.pm * tstep : cA; const char* nB = has_next ? (const char*)g.Bt + (size_t)nxt.pn * tstep : cB;
        for (int t = 0; t < nt; t += 2) {
            const bool last = (t == nt - 2);
            const char* a1 = cA + (size_t)(t + 1) * kstep;
            const char* a2 = last ? nA : cA + (size_t)(t + 2) * kstep; const char* b2 = last ? nB : cB + (size_t)(t + 2) * kstep;
            const char* a3 = a2 + kstep; const char* b3 = b2 + kstep;
            if (last && has_next) S.a_ready(nxt);
            PG8_LDB(B0, 0, 0); PG8_SCHED; PG8_LDA(At, 0, 0); PG8_STAGE(PG8_SA(1, 1), a1 + hstep, voffA);
            PG8_WAIT_L(8); PG8_BAR; PG8_WAIT_L(0); PG8_MMA(0, 0, At, B0); PG8_BAR; PG8_SCHED;
            PG8_LDB(B1, 0, 1); PG8_STAGE(PG8_SB(0, 0), b2, voffB);
            PG8_BAR; PG8_WAIT_L(0); PG8_MMA(0, 1, At, B1); PG8_BAR;
            PG8_LDA(At, 0, 1); PG8_STAGE(PG8_SA(0, 0), a2, voffA);
            PG8_BAR; PG8_WAIT_L(0); PG8_MMA(1, 0, At, B0); PG8_BAR; PG8_SCHED;
            PG8_STAGE(PG8_SB(0, 1), b2 + hstep, voffB);
            PG8_WAIT_V(6); PG8_BAR; PG8_MMA(1, 1, At, B1); PG8_BAR;
            PG8_LDB(B0, 1, 0); PG8_SCHED; PG8_LDA(At, 1, 0); PG8_STAGE(PG8_SA(0, 1), a2 + hstep, voffA);
            PG8_WAIT_L(8); PG8_BAR; PG8_WAIT_L(0); PG8_MMA(0, 0, At, B0); PG8_BAR; PG8_SCHED;
            PG8_LDB(B1, 1, 1); PG8_STAGE(PG8_SB(1, 0), b3, voffB);
            PG8_BAR; PG8_WAIT_L(0); PG8_MMA(0, 1, At, B1); PG8_BAR;
            PG8_LDA(At, 1, 1); PG8_STAGE(PG8_SA(1, 0), a3, voffA);
            PG8_BAR; PG8_WAIT_L(0); PG8_MMA(1, 0, At, B0); PG8_BAR; PG8_SCHED;
            PG8_STAGE(PG8_SB(1, 1), b3 + hstep, voffB);
            PG8_WAIT_V(6); PG8_BAR; PG8_MMA(1, 1, At, B1); PG8_BAR;
        }
        PG8_STAMP();
        if constexpr (!Epi::AFTER_DRAIN) { E(acc, cur, wr, wc, fr, fq); S.done(cur); }
        PG8_STAMP();
        if (!has_next) break;
#pragma unroll
        for (int a = 0; a < 2; ++a)
#pragma unroll
            for (int b = 0; b < 2; ++b)
#pragma unroll
                for (int m = 0; m < 4; ++m)
#pragma unroll
                    for (int n = 0; n < 2; ++n) acc[a][b][m][n] = (f32x4){0.f, 0.f, 0.f, 0.f};
        cur = nxt; cA = nA; cB = nB; ++ui;
    }
    PG8_WAIT_V(0);
    if (wr == 0) PG8_BAR;
    PG8_BAR;
    if constexpr (Epi::AFTER_DRAIN) { E.fused(acc, cur, wr, wc, fr, fq, lds, wid, lane); S.done(cur); }
    PG8_STAMP();
    if (STAMP && wid == 0) { stamps[lane] = lane < nts ? (((unsigned long long)(unsigned)ts_hi << 32) | (unsigned)ts_lo) : 0ull;
        if (lane == 62) stamps[62] = rt_entry; if (lane == 63) stamps[63] = (unsigned long long)wall_clock64(); }
#undef PG8_STAMP
#undef PG8_SA
#undef PG8_SB
#undef PG8_STAGE
#undef PG8_LDA
#undef PG8_LDB
#undef PG8_MMA
#undef PG8_WAIT_V
#undef PG8_WAIT_L
#undef PG8_BAR
#undef PG8_SCHED
}
}

#define LAS __attribute__((address_space(3)))
typedef unsigned short bf16_t;
typedef short bf16x8 __attribute__((ext_vector_type(8)));
typedef float f32x4 __attribute__((ext_vector_type(4)));
typedef unsigned u32x4 __attribute__((ext_vector_type(4)));
typedef unsigned u32x2 __attribute__((ext_vector_type(2)));
typedef short s16x4 __attribute__((ext_vector_type(4)));

constexpr int T_TOK = 16384, SEQ = 4096, DM = 1024;
constexpr int PWP = 4352, PA_W = 1280, PBC_W = 1920;
constexpr int NTHR = 512;
constexpr int XCD_BAR_WORDS_C = 3456;
constexpr int LDS_BYTES = 131072 + 16 + 1024;
constexpr size_t WS_WIN = 0;
constexpr size_t WS_WOUT = WS_WIN + (size_t)PWP * 1024 * 2;
constexpr size_t WS_XB = WS_WOUT + (size_t)1024 * 1024 * 2;
constexpr size_t WS_SSQ = WS_XB + (size_t)T_TOK * 1024 * 2;
constexpr size_t WS_PA = WS_SSQ + (size_t)T_TOK * 16 * 4;
constexpr size_t WS_PBC = WS_PA + (size_t)T_TOK * PA_W * 2;
constexpr size_t WS_GATE = WS_PBC + (size_t)T_TOK * PBC_W * 2;
constexpr size_t WS_GT = WS_GATE + (size_t)T_TOK * 1024 * 2;
constexpr size_t WS_HM = WS_GT + (size_t)1536 * 4096 * 2;
constexpr size_t WS_QQ = WS_HM + (size_t)1536 * 4096 * 2;
constexpr size_t WS_Y0 = WS_QQ + (size_t)1536 * 4096 * 2;
constexpr size_t WS_BV = WS_Y0 + (size_t)1536 * 4096 * 2;
constexpr size_t WS_SC = WS_BV + (size_t)1536 * 4096 * 2;
constexpr size_t WS_KMEAN = WS_SC + (size_t)1536 * 4096 * 2;
constexpr size_t WS_BAR = WS_KMEAN + (size_t)4 * 4 * 16 * 64 * 4;
constexpr size_t WS_FLAG = WS_BAR + (size_t)XCD_BAR_WORDS_C * 4;
constexpr size_t WS_CNT = WS_FLAG + 256;
constexpr size_t WS_KMC = WS_CNT + 4096;
constexpr size_t WS_WIN1 = WS_KMC + 256;
constexpr size_t WS_END = WS_WIN1 + (size_t)PWP * 1024 * 2;
constexpr size_t WS_YG = WS_PA;

struct Params {
    const float* in[18];
    float* out;
    unsigned char* ws;
    unsigned* bar;
    int ph_lo, ph_hi;
};
enum { I_X = 0, I_NORMG, I_WIN, I_WOUT, I_MU, I_W0, I_WUP, I_A0, I_AUP, I_KK, I_KA, I_RK, I_LNG, I_LNB, I_MQG, I_MKG, I_DQG, I_DKG };

__device__ __forceinline__ float bf2f(bf16_t b) { return __uint_as_float(((unsigned)b) << 16); }
__device__ __forceinline__ bf16_t f2bf(float f) { unsigned u = __float_as_uint(f); u += 0x7FFFu + ((u >> 16) & 1u); return (bf16_t)(u >> 16); }
__device__ __forceinline__ unsigned pk2(float lo, float hi) { unsigned r; asm("v_cvt_pk_bf16_f32 %0, %1, %2" : "=v"(r) : "v"(lo), "v"(hi)); return r; }
__device__ __forceinline__ float bflo(unsigned w) { return __uint_as_float(w << 16); }
__device__ __forceinline__ float bfhi(unsigned w) { return __uint_as_float(w & 0xFFFF0000u); }
__device__ __forceinline__ float wsum64(float v) {
    v += __shfl_xor(v, 1); v += __shfl_xor(v, 2); v += __shfl_xor(v, 4); v += __shfl_xor(v, 8); v += __shfl_xor(v, 16); v += __shfl_xor(v, 32); return v;
}
__device__ __forceinline__ float sum8(float v) { v += __shfl_xor(v, 1); v += __shfl_xor(v, 2); v += __shfl_xor(v, 4); return v; }
template <int CTRL> __device__ __forceinline__ float dppf(float x) { return __int_as_float(__builtin_amdgcn_update_dpp(0, __float_as_int(x), CTRL, 0xF, 0xF, true)); }
__device__ __forceinline__ float dsum8(float v) { v += dppf<0xB1>(v); v += dppf<0x4E>(v); v += dppf<0x141>(v); return v; }

struct EpiIn {
    static constexpr bool PERM = true, AFTER_DRAIN = false;
    bf16_t* pa; bf16_t* pbc; bf16_t* gate; const LAS float* rsl;
    __device__ __forceinline__ void operator()(const f32x4 (&acc)[2][2][4][2], const pg8::Unit& u, int wr, int wc, int fr_, int fq_) const {
        int fr = fr_, fq = fq_; asm volatile("" : "+v"(fr), "+v"(fq));
        const int row0 = u.pm * 256 + wr * 64 + fr;
#pragma unroll
        for (int ai = 0; ai < 2; ++ai)
#pragma unroll
            for (int m = 0; m < 4; ++m) {
                const int row = row0 + ai * 128 + m * 16;
                const float rs = rsl[row & 255];
#pragma unroll
                for (int bj = 0; bj < 2; ++bj) {
                    const int c128 = u.pn * 2 + bj;
                    const int col = c128 * 128 + wc * 32 + 8 * fq;
                    f32x4 v0 = acc[ai][bj][m][0] * rs, v1 = acc[ai][bj][m][1] * rs;
                    bf16_t* dst;
                    if (c128 < 10) dst = pa + (size_t)row * PA_W + col;
                    else if (c128 < 25) dst = pbc + (size_t)row * PBC_W + (col - 1280);
                    else if (c128 < 33) {
                        dst = gate + (size_t)row * 1024 + (col - 3200);
#pragma unroll
                        for (int j = 0; j < 4; ++j) { v0[j] = v0[j] * __builtin_amdgcn_rcpf(1.0f + __expf(-v0[j])); v1[j] = v1[j] * __builtin_amdgcn_rcpf(1.0f + __expf(-v1[j])); }
                    } else continue;
                    u32x4 w; w.x = pk2(v0[0], v0[1]); w.y = pk2(v0[2], v0[3]); w.z = pk2(v1[0], v1[1]); w.w = pk2(v1[2], v1[3]);
                    *(u32x4*)dst = w;
                }
            }
    }
};
struct EpiOut {
    static constexpr bool PERM = true, AFTER_DRAIN = false;
    float* out; bf16_t* xb; float* ssq; int last;
    __device__ __forceinline__ void operator()(const f32x4 (&acc)[2][2][4][2], const pg8::Unit& u, int wr, int wc, int fr_, int fq_) const {
        int fr = fr_, fq = fq_; asm volatile("" : "+v"(fr), "+v"(fq));
        const int row0 = u.pm * 256 + wr * 64 + fr;
#pragma unroll
        for (int ai = 0; ai < 2; ++ai)
#pragma unroll
            for (int m = 0; m < 4; ++m) {
                const int row = row0 + ai * 128 + m * 16;
                float sq = 0.f;
#pragma unroll
                for (int bj = 0; bj < 2; ++bj) {
                    const int col = u.pn * 256 + bj * 128 + wc * 32 + 8 * fq;
                    const size_t off = (size_t)row * 1024 + col;
                    const u32x4 r = *(const u32x4*)(xb + off);
                    const f32x4 v0 = acc[ai][bj][m][0] + (f32x4){bflo(r.x), bfhi(r.x), bflo(r.y), bfhi(r.y)}, v1 = acc[ai][bj][m][1] + (f32x4){bflo(r.z), bfhi(r.z), bflo(r.w), bfhi(r.w)};
                    if (last) { *(f32x4*)(out + off) = v0; *(f32x4*)(out + off + 4) = v1; }
                    else {
                        u32x4 w; w.x = pk2(v0[0], v0[1]); w.y = pk2(v0[2], v0[3]); w.z = pk2(v1[0], v1[1]); w.w = pk2(v1[2], v1[3]);
                        *(u32x4*)(xb + off) = w;
                        sq += (v0[0] * v0[0] + v0[1] * v0[1]) + (v0[2] * v0[2] + v0[3] * v0[3]) + (v1[0] * v1[0] + v1[1] * v1[1]) + (v1[2] * v1[2] + v1[3] * v1[3]);
                    }
                }
                if (!last) {
                    sq += __shfl_xor(sq, 16); sq += __shfl_xor(sq, 32);
                    if (fq == 0) ssq[(size_t)row * 16 + u.pn * 4 + wc] = sq;
                }
            }
    }
};

__device__ __forceinline__ void convert_tile(const float* __restrict__ W, int N, int Nvalid, const float* __restrict__ g, bf16_t* __restrict__ Wt, int tk, int tn, LAS unsigned char* lds) {
    LAS float* tl = (LAS float*)lds;
    const int tid = tidx(), r = tid >> 3, c8 = (tid & 7) * 8, n0 = tn * 64, k0 = tk * 64;
    __syncthreads();
    if (n0 < Nvalid) {
        const float* src = W + (size_t)(k0 + r) * N + n0 + c8;
        const f32x4 a = *(const f32x4*)src, b = *(const f32x4*)(src + 4);
        const float gs = g ? g[k0 + r] : 1.0f;
#pragma unroll
        for (int j = 0; j < 4; ++j) { tl[r * 65 + c8 + j] = a[j] * gs; tl[r * 65 + c8 + 4 + j] = b[j] * gs; }
    }
    __syncthreads();
    u32x4 w = {0u, 0u, 0u, 0u};
    if (n0 < Nvalid) {
        float v[8];
#pragma unroll
        for (int j = 0; j < 8; ++j) v[j] = tl[(c8 + j) * 65 + r];
        w.x = pk2(v[0], v[1]); w.y = pk2(v[2], v[3]); w.z = pk2(v[4], v[5]); w.w = pk2(v[6], v[7]);
    }
    *(u32x4*)(Wt + (size_t)(n0 + r) * 1024 + k0 + c8) = w;
}

__device__ __forceinline__ void convert_strip4(const float* __restrict__ W, int N, int Nvalid, const float* __restrict__ g, bf16_t* __restrict__ Wt, int tk0, int tn, LAS unsigned char* lds) {
    LAS float* tl = (LAS float*)lds;
    const int tid = tidx(), r = tid >> 3, c8 = (tid & 7) * 8, n0 = tn * 64;
    const bool valid = n0 < Nvalid;
    __syncthreads();
    if (valid) {
        f32x4 a[4], b[4]; float gs[4];
#pragma unroll
        for (int i = 0; i < 4; ++i) {
            const float* src = W + (size_t)((tk0 + i) * 64 + r) * N + n0 + c8;
            a[i] = *(const f32x4*)src; b[i] = *(const f32x4*)(src + 4);
            gs[i] = g ? g[(tk0 + i) * 64 + r] : 1.0f;
        }
#pragma unroll
        for (int i = 0; i < 4; ++i)
#pragma unroll
            for (int j = 0; j < 4; ++j) { tl[i * 4160 + r * 65 + c8 + j] = a[i][j] * gs[i]; tl[i * 4160 + r * 65 + c8 + 4 + j] = b[i][j] * gs[i]; }
    }
    __syncthreads();
#pragma unroll
    for (int i = 0; i < 4; ++i) {
        u32x4 w = {0u, 0u, 0u, 0u};
        if (valid) {
            float v[8];
#pragma unroll
            for (int j = 0; j < 8; ++j) v[j] = tl[i * 4160 + (c8 + j) * 65 + r];
            w.x = pk2(v[0], v[1]); w.y = pk2(v[2], v[3]); w.z = pk2(v[4], v[5]); w.w = pk2(v[6], v[7]);
        }
        *(u32x4*)(Wt + (size_t)(n0 + r) * 1024 + (tk0 + i) * 64 + c8) = w;
    }
}

__device__ __forceinline__ void phase_prologue(const Params& p, LAS unsigned char* lds) {
    const int tid = tidx(), wave = tid >> 6, lane = tid & 63;
    const float* x = p.in[I_X];
    bf16_t* xb = (bf16_t*)(p.ws + WS_XB); float* ssq = (float*)(p.ws + WS_SSQ);
    for (int row = blockIdx.x * 8 + wave; row < T_TOK; row += gridDim.x * 8) {
        const float* xr = x + (size_t)row * 1024;
        float s = 0.f;
#pragma unroll
        for (int i = 0; i < 4; ++i) {
            const f32x4 v = *(const f32x4*)(xr + i * 256 + lane * 4);
            s += (v[0] * v[0] + v[1] * v[1]) + (v[2] * v[2] + v[3] * v[3]);
            u32x2 w; w.x = pk2(v[0], v[1]); w.y = pk2(v[2], v[3]);
            *(u32x2*)(xb + (size_t)row * 1024 + i * 256 + lane * 4) = w;
        }
        s = wsum64(s);
        if (lane < 16) ssq[(size_t)row * 16 + lane] = (lane == 0) ? s : 0.f;
    }
    bf16_t* wint = (bf16_t*)(p.ws + WS_WIN);
    for (int t = blockIdx.x; t < 4 * 68; t += gridDim.x) convert_strip4(p.in[I_WIN], 4224, 4224, p.in[I_NORMG], wint, (t & 3) * 4, t >> 2, lds);
}

constexpr int KS_PITCH = 144;
constexpr int VT_PITCH = 144;
constexpr int AT_BUF = 64 * KS_PITCH + 64 * VT_PITCH;
constexpr int AT_KM = 2 * AT_BUF, AT_SEL = AT_KM + 4096, AT_ANY = AT_SEL + 512;
struct AttnOut { f32x4 o[4]; float m, l; };
constexpr size_t DO_LIST = (size_t)26 << 20;
constexpr size_t DO_PB = (size_t)28 << 20;
constexpr size_t DO_PL = (size_t)53 << 20;

template <class TK>
__device__ __forceinline__ void attn_core(const TK& tk, const bf16_t* __restrict__ qbase, const bf16_t* __restrict__ kbase, const bf16_t* __restrict__ vbase,
                                          const float* __restrict__ qg, const float* __restrict__ kg, LAS unsigned char* lds, AttnOut& R) {
    const int tid = tidx(), wave = tid >> 6, lane = tid & 63, qi = lane & 15, g = lane >> 4;
    const int mq = wave * 16 + qi;
    bf16x8 bq[2];
    const int kr = tid >> 3, pc = tid & 7;
    float kgv[8];
#pragma unroll
    for (int j = 0; j < 8; ++j) kgv[j] = kg[pc * 8 + j];
#pragma unroll
    for (int mo = 0; mo < 4; ++mo) R.o[mo] = (f32x4){0.f, 0.f, 0.f, 0.f};
    float l_run = 0.f;
    const int nt = tk.ntiles();
    auto next_on = [&](int j) { int jn = j + 1; while (jn < nt && !tk.tile_on(jn)) ++jn; return jn; };
    auto load_t = [&](int jj, u32x4& kreg, u32x4& vreg) {
        kreg = *(const u32x4*)(kbase + (size_t)tk.k_tok(jj, kr) * PBC_W + pc * 8);
        vreg = *(const u32x4*)(vbase + (size_t)tk.k_tok(jj, kr) * PBC_W + pc * 8);
    };
    auto store_t = [&](int buf, const u32x4& kreg, const u32x4& vreg) {
        LAS unsigned char* B = lds + buf * AT_BUF;
        float kf[8];
#pragma unroll
        for (int q = 0; q < 4; ++q) { kf[2 * q] = bflo(kreg[q]); kf[2 * q + 1] = bfhi(kreg[q]); }
        float ss = 0.f;
#pragma unroll
        for (int q = 0; q < 8; ++q) ss += kf[q] * kf[q];
        ss = dsum8(ss);
        const float ks = rsqrtf(ss * (1.0f / 64.0f) + 1e-6f);
        u32x4 w; w.x = pk2(kf[0] * ks * kgv[0], kf[1] * ks * kgv[1]); w.y = pk2(kf[2] * ks * kgv[2], kf[3] * ks * kgv[3]);
        w.z = pk2(kf[4] * ks * kgv[4], kf[5] * ks * kgv[5]); w.w = pk2(kf[6] * ks * kgv[6], kf[7] * ks * kgv[7]);
        *(LAS u32x4*)(B + kr * KS_PITCH + pc * 16) = w;
        *(LAS u32x4*)(B + 64 * KS_PITCH + kr * VT_PITCH + pc * 16) = vreg;
    };
    auto compute_t = [&](int buf, int j) {
        if (!tk.wave_on(wave, j)) return;
        const LAS unsigned char* B = lds + buf * AT_BUF;
        f32x4 st[4];
#pragma unroll
        for (int mt = 0; mt < 4; ++mt) {
            st[mt] = (f32x4){0.f, 0.f, 0.f, 0.f};
#pragma unroll
            for (int ks = 0; ks < 2; ++ks) {
                const bf16x8 a = *(const LAS bf16x8*)(B + (mt * 16 + qi) * KS_PITCH + ks * 64 + g * 16);
                st[mt] = __builtin_amdgcn_mfma_f32_16x16x32_bf16(a, bq[ks], st[mt], 0, 0, 0);
            }
        }
        float ps = 0.f;
#pragma unroll
        for (int mt = 0; mt < 4; ++mt)
#pragma unroll
            for (int i = 0; i < 4; ++i) {
                const float pv = tk.mask(mq, j, mt * 16 + g * 4 + i) ? __builtin_amdgcn_exp2f(st[mt][i]) : 0.f;
                st[mt][i] = pv; ps += pv;
            }
        l_run += ps;
#pragma unroll
        for (int ks = 0; ks < 2; ++ks) {
            u32x4 pbw; pbw.x = pk2(st[2 * ks][0], st[2 * ks][1]); pbw.y = pk2(st[2 * ks][2], st[2 * ks][3]); pbw.z = pk2(st[2 * ks + 1][0], st[2 * ks + 1][1]); pbw.w = pk2(st[2 * ks + 1][2], st[2 * ks + 1][3]);
            const bf16x8 pb = __builtin_bit_cast(bf16x8, pbw);
#pragma unroll
            for (int mo = 0; mo < 4; ++mo) {
                const LAS unsigned char* vp = B + 64 * KS_PITCH + (ks * 32 + 4 * g + (qi >> 2)) * VT_PITCH + (mo * 16 + 4 * (qi & 3)) * 2;
                const s16x4 lo = __builtin_amdgcn_ds_read_tr16_b64_v4i16((LAS s16x4*)vp), hi = __builtin_amdgcn_ds_read_tr16_b64_v4i16((LAS s16x4*)(vp + 16 * VT_PITCH));
                bf16x8 av; av[0] = lo[0]; av[1] = lo[1]; av[2] = lo[2]; av[3] = lo[3]; av[4] = hi[0]; av[5] = hi[1]; av[6] = hi[2]; av[7] = hi[3];
                R.o[mo] = __builtin_amdgcn_mfma_f32_16x16x32_bf16(av, pb, R.o[mo], 0, 0, 0);
            }
        }
    };
    int j0 = -1; j0 = next_on(j0);
    int j1 = (j0 < nt) ? next_on(j0) : nt, j2 = (j1 < nt) ? next_on(j1) : nt;
    u32x4 kA = {0u, 0u, 0u, 0u}, vA = kA, kB = kA, vB = kA;
    if (j0 < nt) load_t(j0, kA, vA);
    if (j1 < nt) load_t(j1, kB, vB);
    {
        const bf16_t* qp = qbase + (size_t)tk.q_tok(mq) * PBC_W;
        const u32x4 r0 = *(const u32x4*)(qp + g * 8), r1 = *(const u32x4*)(qp + 32 + g * 8);
        float qf[16];
#pragma unroll
        for (int j = 0; j < 4; ++j) { qf[2 * j] = bflo(r0[j]); qf[2 * j + 1] = bfhi(r0[j]); qf[8 + 2 * j] = bflo(r1[j]); qf[8 + 2 * j + 1] = bfhi(r1[j]); }
        float ss = 0.f;
#pragma unroll
        for (int j = 0; j < 16; ++j) ss += qf[j] * qf[j];
        ss += __shfl_xor(ss, 16); ss += __shfl_xor(ss, 32);
        const float qs = rsqrtf(ss * (1.0f / 64.0f) + 1e-6f) * (0.125f * 1.4426950408889634f);
        u32x4 b0, b1;
#pragma unroll
        for (int j = 0; j < 4; ++j) {
            b0[j] = pk2(qf[2 * j] * qs * qg[g * 8 + 2 * j], qf[2 * j + 1] * qs * qg[g * 8 + 2 * j + 1]);
            b1[j] = pk2(qf[8 + 2 * j] * qs * qg[32 + g * 8 + 2 * j], qf[8 + 2 * j + 1] * qs * qg[32 + g * 8 + 2 * j + 1]);
        }
        bq[0] = __builtin_bit_cast(bf16x8, b0); bq[1] = __builtin_bit_cast(bf16x8, b1);
    }
    __syncthreads();
    if (j0 < nt) store_t(0, kA, vA);
    if (j2 < nt) load_t(j2, kA, vA);
    __syncthreads();
    while (j0 < nt) {
        compute_t(0, j0);
        int j3 = (j2 < nt) ? next_on(j2) : nt;
        if (j1 < nt) store_t(1, kB, vB);
        if (j3 < nt) load_t(j3, kB, vB);
        __syncthreads();
        j0 = j1; j1 = j2; j2 = j3;
        if (j0 >= nt) break;
        compute_t(1, j0);
        j3 = (j2 < nt) ? next_on(j2) : nt;
        if (j1 < nt) store_t(0, kA, vA);
        if (j3 < nt) load_t(j3, kA, vA);
        __syncthreads();
        j0 = j1; j1 = j2; j2 = j3;
    }
    l_run += __shfl_xor(l_run, 16); l_run += __shfl_xor(l_run, 32);
    R.m = 0.f; R.l = l_run;
}

struct DilTask {
    int tokbase, d, rho, c;
    __device__ __forceinline__ int q_tok(int m) const { return tokbase + (c * 128 + m) * d + rho; }
    __device__ __forceinline__ int ntiles() const { return 4; }
    __device__ __forceinline__ bool tile_on(int j) const { return !(c == 0 && j < 2); }
    __device__ __forceinline__ int k_tok(int j, int n) const { return tokbase + ((c - 1) * 128 + j * 64 + n) * d + rho; }
    __device__ __forceinline__ bool mask(int m, int j, int n) const { const int diff = 128 + m - j * 64 - n; return diff >= 0 && diff <= 128; }
    __device__ __forceinline__ bool wave_on(int w, int j) const { return (w < 4) ? (j < 3) : (j > 0); }
};
__device__ __forceinline__ void dil_epilogue(const Params& p, int gi, int hC, int tok, int g, const f32x4 (&o)[4], float lsum) {
    const float inv = 1.0f / lsum;
    const float L = __builtin_amdgcn_logf(lsum);
    bf16_t* dilo = (bf16_t*)p.out; float* dill = (float*)((unsigned char*)p.out + (size_t)2 * T_TOK * 384 * 2);
    if (gi < 2) {
#pragma unroll
        for (int mo = 0; mo < 4; ++mo) {
            u32x2 w; w.x = pk2(o[mo][0] * inv, o[mo][1] * inv); w.y = pk2(o[mo][2] * inv, o[mo][3] * inv);
            *(u32x2*)(dilo + ((size_t)gi * T_TOK + tok) * 384 + hC * 64 + mo * 16 + g * 4) = w;
        }
        if (g == 0) dill[((size_t)gi * T_TOK + tok) * 6 + hC] = L;
    } else {
        const float L0 = dill[(size_t)tok * 6 + hC], L1 = dill[((size_t)T_TOK + tok) * 6 + hC];
        const float M = fmaxf(L, fmaxf(L0, L1));
        const float w0 = __builtin_amdgcn_exp2f(L0 - M), w1 = __builtin_amdgcn_exp2f(L1 - M), w2 = __builtin_amdgcn_exp2f(L - M);
        const float wi = 1.0f / (w0 + w1 + w2);
        const float a0 = w0 * wi, a1 = w1 * wi, a2 = w2 * wi * inv;
        const bf16_t* sg = (const bf16_t*)(p.ws + WS_GATE) + (size_t)tok * 1024 + 640 + hC * 64;
        bf16_t* yg = (bf16_t*)(p.ws + WS_YG) + (size_t)tok * 1024 + 640 + hC * 64;
#pragma unroll
        for (int mo = 0; mo < 4; ++mo) {
            const int dh = mo * 16 + g * 4;
            const u32x2 o0 = *(const u32x2*)(dilo + (size_t)tok * 384 + hC * 64 + dh), o1 = *(const u32x2*)(dilo + ((size_t)T_TOK + tok) * 384 + hC * 64 + dh);
            const u32x2 gt = *(const u32x2*)(sg + dh);
            const float y0 = a0 * bflo(o0.x) + a1 * bflo(o1.x) + a2 * o[mo][0];
            const float y1 = a0 * bfhi(o0.x) + a1 * bfhi(o1.x) + a2 * o[mo][1];
            const float y2 = a0 * bflo(o0.y) + a1 * bflo(o1.y) + a2 * o[mo][2];
            const float y3 = a0 * bfhi(o0.y) + a1 * bfhi(o1.y) + a2 * o[mo][3];
            u32x2 w; w.x = pk2(y0 * bflo(gt.x), y1 * bfhi(gt.x)); w.y = pk2(y2 * bflo(gt.y), y3 * bfhi(gt.y));
            *(u32x2*)(yg + dh) = w;
        }
    }
}
__device__ __forceinline__ void dil_run(const Params& p, int l, int gi, int r, LAS unsigned char* lds) {
    const int d = (gi == 0) ? 1 : (gi == 1 ? 4 : 16), npair = 16 / d;
    const int b = r / 96, r2 = r % 96, hC = r2 / 16, r3 = r2 % 16, rho = r3 / npair, cp = r3 % npair;
    const int tid = tidx(), wave = tid >> 6, lane = tid & 63, qi = lane & 15, g = lane >> 4;
    const int kr = tid >> 3, pc = tid & 7, m = wave * 16 + qi;
    const bf16_t* pbc = (const bf16_t*)(p.ws + WS_PBC);
    const bf16_t* qbase = pbc + 768 + hC * 64; const bf16_t* kbase = pbc + 1152 + hC * 64; const bf16_t* vbase = pbc + 1536 + hC * 64;
    const float* qg = p.in[I_DQG] + l * 64; const float* kg = p.in[I_DKG] + l * 64;
    const int tokbase = b * SEQ, ksub0 = (2 * cp - 1) * 128;
    const int jt0 = (cp == 0) ? 2 : 0;
    u32x4 qr[2][2]; int qtok[2];
#pragma unroll
    for (int qb = 0; qb < 2; ++qb) {
        qtok[qb] = tokbase + ((2 * cp + qb) * 128 + m) * d + rho;
        qr[qb][0] = *(const u32x4*)(qbase + (size_t)qtok[qb] * PBC_W + g * 8); qr[qb][1] = *(const u32x4*)(qbase + (size_t)qtok[qb] * PBC_W + 32 + g * 8);
    }
    u32x4 kreg[6], vreg[6];
#pragma unroll
    for (int jt = 0; jt < 6; ++jt) {
        kreg[jt] = (u32x4){0u, 0u, 0u, 0u}; vreg[jt] = (u32x4){0u, 0u, 0u, 0u};
        if (jt >= jt0) {
            const size_t ktok = (size_t)(tokbase + (ksub0 + jt * 64 + kr) * d + rho);
            kreg[jt] = *(const u32x4*)(kbase + ktok * PBC_W + pc * 8); vreg[jt] = *(const u32x4*)(vbase + ktok * PBC_W + pc * 8);
        }
    }
    float kgv[8];
#pragma unroll
    for (int j = 0; j < 8; ++j) kgv[j] = kg[pc * 8 + j];
    __syncthreads();
#pragma unroll
    for (int jt = 0; jt < 6; ++jt) {
        if (jt >= jt0) {
            LAS unsigned char* B = lds + jt * AT_BUF;
            float kf[8];
#pragma unroll
            for (int q = 0; q < 4; ++q) { kf[2 * q] = bflo(kreg[jt][q]); kf[2 * q + 1] = bfhi(kreg[jt][q]); }
            float ss = 0.f;
#pragma unroll
            for (int q = 0; q < 8; ++q) ss += kf[q] * kf[q];
            ss = dsum8(ss);
            const float ks = rsqrtf(ss * (1.0f / 64.0f) + 1e-6f);
            u32x4 w; w.x = pk2(kf[0] * ks * kgv[0], kf[1] * ks * kgv[1]); w.y = pk2(kf[2] * ks * kgv[2], kf[3] * ks * kgv[3]);
            w.z = pk2(kf[4] * ks * kgv[4], kf[5] * ks * kgv[5]); w.w = pk2(kf[6] * ks * kgv[6], kf[7] * ks * kgv[7]);
            *(LAS u32x4*)(B + kr * KS_PITCH + pc * 16) = w;
            *(LAS u32x4*)(B + 64 * KS_PITCH + kr * VT_PITCH + pc * 16) = vreg[jt];
        }
    }
    __syncthreads();
#pragma unroll
    for (int qb = 0; qb < 2; ++qb) {
        bf16x8 bq[2];
        {
            float qf[16];
#pragma unroll
            for (int j = 0; j < 4; ++j) { qf[2 * j] = bflo(qr[qb][0][j]); qf[2 * j + 1] = bfhi(qr[qb][0][j]); qf[8 + 2 * j] = bflo(qr[qb][1][j]); qf[8 + 2 * j + 1] = bfhi(qr[qb][1][j]); }
            float ss = 0.f;
#pragma unroll
            for (int j = 0; j < 16; ++j) ss += qf[j] * qf[j];
            ss += __shfl_xor(ss, 16); ss += __shfl_xor(ss, 32);
            const float qs = rsqrtf(ss * (1.0f / 64.0f) + 1e-6f) * (0.125f * 1.4426950408889634f);
            u32x4 b0, b1;
#pragma unroll
            for (int j = 0; j < 4; ++j) {
                b0[j] = pk2(qf[2 * j] * qs * qg[g * 8 + 2 * j], qf[2 * j + 1] * qs * qg[g * 8 + 2 * j + 1]);
                b1[j] = pk2(qf[8 + 2 * j] * qs * qg[32 + g * 8 + 2 * j], qf[8 + 2 * j + 1] * qs * qg[32 + g * 8 + 2 * j + 1]);
            }
            bq[0] = __builtin_bit_cast(bf16x8, b0); bq[1] = __builtin_bit_cast(bf16x8, b1);
        }
        f32x4 o[4];
#pragma unroll
        for (int mo = 0; mo < 4; ++mo) o[mo] = (f32x4){0.f, 0.f, 0.f, 0.f};
        float l_run = 0.f;
#pragma unroll 1
        for (int j = 0; j < 4; ++j) {
            if (2 * qb + j < jt0 || !((wave < 4) ? (j < 3) : (j > 0))) continue;
            const LAS unsigned char* B = lds + (2 * qb + j) * AT_BUF;
            f32x4 st[4];
#pragma unroll
            for (int mt = 0; mt < 4; ++mt) {
                st[mt] = (f32x4){0.f, 0.f, 0.f, 0.f};
#pragma unroll
                for (int ks = 0; ks < 2; ++ks) {
                    const bf16x8 a = *(const LAS bf16x8*)(B + (mt * 16 + qi) * KS_PITCH + ks * 64 + g * 16);
                    st[mt] = __builtin_amdgcn_mfma_f32_16x16x32_bf16(a, bq[ks], st[mt], 0, 0, 0);
                }
            }
            float ps = 0.f;
#pragma unroll
            for (int mt = 0; mt < 4; ++mt)
#pragma unroll
                for (int ii = 0; ii < 4; ++ii) {
                    const int diff = 128 + m - j * 64 - (mt * 16 + g * 4 + ii);
                    const float pv = (diff >= 0 && diff <= 128) ? __builtin_amdgcn_exp2f(st[mt][ii]) : 0.f;
                    st[mt][ii] = pv; ps += pv;
                }
            l_run += ps;
#pragma unroll
            for (int ks = 0; ks < 2; ++ks) {
                u32x4 pbw; pbw.x = pk2(st[2 * ks][0], st[2 * ks][1]); pbw.y = pk2(st[2 * ks][2], st[2 * ks][3]); pbw.z = pk2(st[2 * ks + 1][0], st[2 * ks + 1][1]); pbw.w = pk2(st[2 * ks + 1][2], st[2 * ks + 1][3]);
                const bf16x8 pb = __builtin_bit_cast(bf16x8, pbw);
#pragma unroll
                for (int mo = 0; mo < 4; ++mo) {
                    const LAS unsigned char* vp = B + 64 * KS_PITCH + (ks * 32 + 4 * g + (qi >> 2)) * VT_PITCH + (mo * 16 + 4 * (qi & 3)) * 2;
                    const s16x4 lo = __builtin_amdgcn_ds_read_tr16_b64_v4i16((LAS s16x4*)vp), hi = __builtin_amdgcn_ds_read_tr16_b64_v4i16((LAS s16x4*)(vp + 16 * VT_PITCH));
                    bf16x8 av; av[0] = lo[0]; av[1] = lo[1]; av[2] = lo[2]; av[3] = lo[3]; av[4] = hi[0]; av[5] = hi[1]; av[6] = hi[2]; av[7] = hi[3];
                    o[mo] = __builtin_amdgcn_mfma_f32_16x16x32_bf16(av, pb, o[mo], 0, 0, 0);
                }
            }
        }
        l_run += __shfl_xor(l_run, 16); l_run += __shfl_xor(l_run, 32);
        dil_epilogue(p, gi, hC, qtok[qb], g, o, l_run);
    }
}

struct MobaTask {
    int tokbase, q0, b_own, nown; unsigned anysel, mysel;
    __device__ __forceinline__ int q_tok(int m) const { return tokbase + q0 + m; }
    __device__ __forceinline__ int ntiles() const { return 4 * (b_own + 1); }
    __device__ __forceinline__ bool tile_on(int j) const { return (j < 4) ? (j < nown) : (((anysel >> ((j >> 2) - 1)) & 1u) != 0u); }
    __device__ __forceinline__ int k_tok(int j, int n) const { const int blk = (j < 4) ? b_own : ((j >> 2) - 1); return tokbase + blk * 256 + (j & 3) * 64 + n; }
    __device__ __forceinline__ bool mask(int m, int j, int n) const {
        return (j < 4) ? (b_own * 256 + j * 64 + n <= q0 + m) : (((mysel >> ((j >> 2) - 1)) & 1u) != 0u);
    }
    __device__ __forceinline__ bool wave_on(int w, int j) const { return (j < 4) ? (b_own * 256 + j * 64 <= q0 + w * 16 + 15) : true; }
};
__device__ __forceinline__ void moba_route_task(const Params& p, int l, int task, LAS unsigned char* lds) {
    const int b = task >> 6, hB = (task >> 4) & 3, b_own = task & 15;
    if (b_own == 0) return;
    const int tid = tidx();
    const int bh16 = b * 4 + hB;
    const bf16_t* pbc = (const bf16_t*)(p.ws + WS_PBC);
    const float* kmean = (const float*)(p.ws + WS_KMEAN) + (size_t)bh16 * 1024;
    LAS float* km = (LAS float*)(lds + AT_KM);
    const int q = tid >> 1, part = tid & 1;
    const bf16_t* qp = pbc + (size_t)(b * SEQ + b_own * 256 + q) * PBC_W + hB * 64 + part * 32;
    const u32x4 r0 = *(const u32x4*)qp, r1 = *(const u32x4*)(qp + 8), r2 = *(const u32x4*)(qp + 16), r3 = *(const u32x4*)(qp + 24);
    __syncthreads();
    if (threadIdx.x == 0) {
        const unsigned* kc = (const unsigned*)(p.ws + WS_KMC) + bh16; unsigned spins = 0;
        while (__hip_atomic_load(kc, __ATOMIC_RELAXED, __HIP_MEMORY_SCOPE_AGENT) < 16u * (unsigned)(l + 1)) { __builtin_amdgcn_s_sleep(2); if (++spins > (1u << 22)) break; }
    }
    __syncthreads();
    for (int i = tid; i < 1024; i += NTHR) km[i] = __hip_atomic_load(kmean + i, __ATOMIC_RELAXED, __HIP_MEMORY_SCOPE_AGENT);
    __syncthreads();
    float qf[32];
#pragma unroll
    for (int j = 0; j < 4; ++j) {
        qf[2 * j] = bflo(r0[j]); qf[2 * j + 1] = bfhi(r0[j]); qf[8 + 2 * j] = bflo(r1[j]); qf[8 + 2 * j + 1] = bfhi(r1[j]);
        qf[16 + 2 * j] = bflo(r2[j]); qf[16 + 2 * j + 1] = bfhi(r2[j]); qf[24 + 2 * j] = bflo(r3[j]); qf[24 + 2 * j + 1] = bfhi(r3[j]);
    }
    float ss = 0.f;
#pragma unroll
    for (int j = 0; j < 32; ++j) ss += qf[j] * qf[j];
    ss += __shfl_xor(ss, 1);
    const float qs = rsqrtf(ss * (1.0f / 64.0f) + 1e-6f);
    const float* qg = p.in[I_MQG] + l * 64 + part * 32;
#pragma unroll
    for (int j = 0; j < 32; ++j) qf[j] *= qs * qg[j];
    float v1 = -INFINITY, v2 = -INFINITY, v3 = -INFINITY; int i1 = -1, i2 = -1, i3 = -1;
    for (int n = 0; n < b_own; ++n) {
        float sc = 0.f;
#pragma unroll
        for (int j = 0; j < 32; ++j) sc += qf[j] * km[n * 64 + part * 32 + j];
        sc += __shfl_xor(sc, 1);
        if (sc > v1) { v3 = v2; i3 = i2; v2 = v1; i2 = i1; v1 = sc; i1 = n; }
        else if (sc > v2) { v3 = v2; i3 = i2; v2 = sc; i2 = n; }
        else if (sc > v3) { v3 = sc; i3 = n; }
    }
    LAS unsigned* lcnt = (LAS unsigned*)(lds + AT_SEL); LAS unsigned* lbase = lcnt + 16;
    if (tid < 16) lcnt[tid] = 0u;
    __syncthreads();
    unsigned rk1 = 0u, rk2 = 0u, rk3 = 0u;
    if (part == 0) {
        if (i1 >= 0) rk1 = atomicAdd((unsigned*)(lcnt + i1), 1u);
        if (i2 >= 0) rk2 = atomicAdd((unsigned*)(lcnt + i2), 1u);
        if (i3 >= 0) rk3 = atomicAdd((unsigned*)(lcnt + i3), 1u);
    }
    __syncthreads();
    if (tid < 16) { const unsigned c = lcnt[tid]; lbase[tid] = c ? __hip_atomic_fetch_add((unsigned*)(p.ws + WS_CNT) + (l * 16 + bh16) * 16 + tid, c, __ATOMIC_RELAXED, __HIP_MEMORY_SCOPE_AGENT) : 0u; }
    __syncthreads();
    if (part == 0) {
        unsigned short* list = (unsigned short*)((unsigned char*)p.out + DO_LIST) + (size_t)bh16 * 16 * 4096;
        const unsigned qpos = (unsigned)(b_own * 256 + q);
        if (i1 >= 0) list[(size_t)i1 * 4096 + lbase[i1] + rk1] = (unsigned short)(qpos | (0u << 12));
        if (i2 >= 0) list[(size_t)i2 * 4096 + lbase[i2] + rk2] = (unsigned short)(qpos | (1u << 12));
        if (i3 >= 0) list[(size_t)i3 * 4096 + lbase[i3] + rk3] = (unsigned short)(qpos | (2u << 12));
    }
}

struct GatherTask {
    int tokbase, keytok, nvalid; unsigned mye;
    __device__ __forceinline__ int q_tok(int) const { return tokbase + (int)(mye & 0xFFFu); }
    __device__ __forceinline__ int ntiles() const { return 4; }
    __device__ __forceinline__ bool tile_on(int) const { return true; }
    __device__ __forceinline__ int k_tok(int j, int n) const { return keytok + j * 64 + n; }
    __device__ __forceinline__ bool mask(int, int, int) const { return true; }
    __device__ __forceinline__ bool wave_on(int w, int) const { return w * 16 < nvalid; }
};
__device__ __forceinline__ unsigned moba_gather_entry(const Params& p, int bh16, int n, int i, int count) {
    const int tid = tidx(), m = (tid >> 6) * 16 + (tid & 15);
    const int nvalid = (count - i * 128 < 128) ? (count - i * 128) : 128;
    const unsigned short* ent = (const unsigned short*)((const unsigned char*)p.out + DO_LIST) + ((size_t)bh16 * 16 + n) * 4096 + (size_t)i * 128;
    return ent[m < nvalid ? m : nvalid - 1];
}
__device__ __forceinline__ void moba_gather_task(const Params& p, int l, int bh16, int n, int i, int count, unsigned mye, LAS unsigned char* lds) {
    const int b = bh16 >> 2, hB = bh16 & 3;
    const int tid = tidx(), wave = tid >> 6, lane = tid & 63, qi = lane & 15, g = lane >> 4;
    const bf16_t* pbc = (const bf16_t*)(p.ws + WS_PBC);
    GatherTask tk; tk.tokbase = b * SEQ; tk.keytok = b * SEQ + n * 256; tk.nvalid = (count - i * 128 < 128) ? (count - i * 128) : 128; tk.mye = mye;
    AttnOut R;
    attn_core(tk, pbc + hB * 64, pbc + 256 + hB * 64, pbc + 512 + hB * 64, p.in[I_MQG] + l * 64, p.in[I_MKG] + l * 64, lds, R);
    const int m = wave * 16 + qi;
    if (m < tk.nvalid) {
        const unsigned e = tk.mye;
        const size_t row = ((size_t)(tk.tokbase + (int)(e & 0xFFFu)) * 4 + hB) * 3 + (e >> 12);
        const float inv = 1.0f / R.l;
        bf16_t* pb = (bf16_t*)((unsigned char*)p.out + DO_PB) + row * 64;
#pragma unroll
        for (int mo = 0; mo < 4; ++mo) {
            u32x2 w; w.x = pk2(R.o[mo][0] * inv, R.o[mo][1] * inv); w.y = pk2(R.o[mo][2] * inv, R.o[mo][3] * inv);
            *(u32x2*)(pb + mo * 16 + g * 4) = w;
        }
        if (g == 0) ((float*)((unsigned char*)p.out + DO_PL))[row] = R.l;
    }
}

__device__ __forceinline__ void moba_gather_run(const Params& p, int l, int e, int i0, int i1, int count, LAS unsigned char* lds) {
    const int bh16 = e >> 4, n = e & 15, b = bh16 >> 2, hB = bh16 & 3;
    const int tid = tidx(), wave = tid >> 6, lane = tid & 63, qi = lane & 15, g = lane >> 4;
    const int kr = tid >> 3, pc = tid & 7, m = wave * 16 + qi;
    const bf16_t* pbc = (const bf16_t*)(p.ws + WS_PBC);
    const bf16_t* qbase = pbc + hB * 64; const bf16_t* kbase = pbc + 256 + hB * 64; const bf16_t* vbase = pbc + 512 + hB * 64;
    const float* qg = p.in[I_MQG] + l * 64; const float* kg = p.in[I_MKG] + l * 64;
    const int tokbase = b * SEQ, keytok = b * SEQ + n * 256;
    const unsigned short* ent = (const unsigned short*)((const unsigned char*)p.out + DO_LIST) + ((size_t)bh16 * 16 + n) * 4096;
    auto entry_of = [&](int i) { const int nv = (count - i * 128 < 128) ? (count - i * 128) : 128; return (unsigned)ent[(size_t)i * 128 + (m < nv ? m : nv - 1)]; };
    u32x4 kreg[4], vreg[4];
#pragma unroll
    for (int j = 0; j < 4; ++j) {
        kreg[j] = *(const u32x4*)(kbase + (size_t)(keytok + j * 64 + kr) * PBC_W + pc * 8);
        vreg[j] = *(const u32x4*)(vbase + (size_t)(keytok + j * 64 + kr) * PBC_W + pc * 8);
    }
    unsigned e_cur = entry_of(i0);
    float kgv[8];
#pragma unroll
    for (int j = 0; j < 8; ++j) kgv[j] = kg[pc * 8 + j];
    __syncthreads();
#pragma unroll
    for (int j = 0; j < 4; ++j) {
        LAS unsigned char* B = lds + j * AT_BUF;
        float kf[8];
#pragma unroll
        for (int q = 0; q < 4; ++q) { kf[2 * q] = bflo(kreg[j][q]); kf[2 * q + 1] = bfhi(kreg[j][q]); }
        float ss = 0.f;
#pragma unroll
        for (int q = 0; q < 8; ++q) ss += kf[q] * kf[q];
        ss = dsum8(ss);
        const float ks = rsqrtf(ss * (1.0f / 64.0f) + 1e-6f);
        u32x4 w; w.x = pk2(kf[0] * ks * kgv[0], kf[1] * ks * kgv[1]); w.y = pk2(kf[2] * ks * kgv[2], kf[3] * ks * kgv[3]);
        w.z = pk2(kf[4] * ks * kgv[4], kf[5] * ks * kgv[5]); w.w = pk2(kf[6] * ks * kgv[6], kf[7] * ks * kgv[7]);
        *(LAS u32x4*)(B + kr * KS_PITCH + pc * 16) = w;
        *(LAS u32x4*)(B + 64 * KS_PITCH + kr * VT_PITCH + pc * 16) = vreg[j];
    }
    u32x4 r0 = *(const u32x4*)(qbase + (size_t)(tokbase + (int)(e_cur & 0xFFFu)) * PBC_W + g * 8), r1 = *(const u32x4*)(qbase + (size_t)(tokbase + (int)(e_cur & 0xFFFu)) * PBC_W + 32 + g * 8);
    unsigned e_nxt = (i0 + 1 < i1) ? entry_of(i0 + 1) : e_cur;
    __syncthreads();
    for (int i = i0; i < i1; ++i) {
        const int nvalid = (count - i * 128 < 128) ? (count - i * 128) : 128;
        u32x4 rn0 = r0, rn1 = r1; unsigned e_nn = e_nxt;
        if (i + 1 < i1) {
            const bf16_t* qn = qbase + (size_t)(tokbase + (int)(e_nxt & 0xFFFu)) * PBC_W;
            rn0 = *(const u32x4*)(qn + g * 8); rn1 = *(const u32x4*)(qn + 32 + g * 8);
            if (i + 2 < i1) e_nn = entry_of(i + 2);
        }
        if (wave * 16 < nvalid) {
            bf16x8 bq[2];
            {
                float qf[16];
#pragma unroll
                for (int j = 0; j < 4; ++j) { qf[2 * j] = bflo(r0[j]); qf[2 * j + 1] = bfhi(r0[j]); qf[8 + 2 * j] = bflo(r1[j]); qf[8 + 2 * j + 1] = bfhi(r1[j]); }
                float ss = 0.f;
#pragma unroll
                for (int j = 0; j < 16; ++j) ss += qf[j] * qf[j];
                ss += __shfl_xor(ss, 16); ss += __shfl_xor(ss, 32);
                const float qs = rsqrtf(ss * (1.0f / 64.0f) + 1e-6f) * (0.125f * 1.4426950408889634f);
                u32x4 b0, b1;
#pragma unroll
                for (int j = 0; j < 4; ++j) {
                    b0[j] = pk2(qf[2 * j] * qs * qg[g * 8 + 2 * j], qf[2 * j + 1] * qs * qg[g * 8 + 2 * j + 1]);
                    b1[j] = pk2(qf[8 + 2 * j] * qs * qg[32 + g * 8 + 2 * j], qf[8 + 2 * j + 1] * qs * qg[32 + g * 8 + 2 * j + 1]);
                }
                bq[0] = __builtin_bit_cast(bf16x8, b0); bq[1] = __builtin_bit_cast(bf16x8, b1);
            }
            f32x4 o[4];
#pragma unroll
            for (int mo = 0; mo < 4; ++mo) o[mo] = (f32x4){0.f, 0.f, 0.f, 0.f};
            float l_run = 0.f;
#pragma unroll 1
            for (int j = 0; j < 4; ++j) {
                const LAS unsigned char* B = lds + j * AT_BUF;
                f32x4 st[4];
#pragma unroll
                for (int mt = 0; mt < 4; ++mt) {
                    st[mt] = (f32x4){0.f, 0.f, 0.f, 0.f};
#pragma unroll
                    for (int ks = 0; ks < 2; ++ks) {
                        const bf16x8 a = *(const LAS bf16x8*)(B + (mt * 16 + qi) * KS_PITCH + ks * 64 + g * 16);
                        st[mt] = __builtin_amdgcn_mfma_f32_16x16x32_bf16(a, bq[ks], st[mt], 0, 0, 0);
                    }
                }
                float ps = 0.f;
#pragma unroll
                for (int mt = 0; mt < 4; ++mt)
#pragma unroll
                    for (int ii = 0; ii < 4; ++ii) { const float pv = __builtin_amdgcn_exp2f(st[mt][ii]); st[mt][ii] = pv; ps += pv; }
                l_run += ps;
#pragma unroll
                for (int ks = 0; ks < 2; ++ks) {
                    u32x4 pbw; pbw.x = pk2(st[2 * ks][0], st[2 * ks][1]); pbw.y = pk2(st[2 * ks][2], st[2 * ks][3]); pbw.z = pk2(st[2 * ks + 1][0], st[2 * ks + 1][1]); pbw.w = pk2(st[2 * ks + 1][2], st[2 * ks + 1][3]);
                    const bf16x8 pb = __builtin_bit_cast(bf16x8, pbw);
#pragma unroll
                    for (int mo = 0; mo < 4; ++mo) {
                        const LAS unsigned char* vp = B + 64 * KS_PITCH + (ks * 32 + 4 * g + (qi >> 2)) * VT_PITCH + (mo * 16 + 4 * (qi & 3)) * 2;
                        const s16x4 lo = __builtin_amdgcn_ds_read_tr16_b64_v4i16((LAS s16x4*)vp), hi = __builtin_amdgcn_ds_read_tr16_b64_v4i16((LAS s16x4*)(vp + 16 * VT_PITCH));
                        bf16x8 av; av[0] = lo[0]; av[1] = lo[1]; av[2] = lo[2]; av[3] = lo[3]; av[4] = hi[0]; av[5] = hi[1]; av[6] = hi[2]; av[7] = hi[3];
                        o[mo] = __builtin_amdgcn_mfma_f32_16x16x32_bf16(av, pb, o[mo], 0, 0, 0);
                    }
                }
            }
            l_run += __shfl_xor(l_run, 16); l_run += __shfl_xor(l_run, 32);
            if (m < nvalid) {
                const size_t row = ((size_t)(tokbase + (int)(e_cur & 0xFFFu)) * 4 + hB) * 3 + (e_cur >> 12);
                const float inv = 1.0f / l_run;
                bf16_t* pb = (bf16_t*)((unsigned char*)p.out + DO_PB) + row * 64;
#pragma unroll
                for (int mo = 0; mo < 4; ++mo) {
                    u32x2 w; w.x = pk2(o[mo][0] * inv, o[mo][1] * inv); w.y = pk2(o[mo][2] * inv, o[mo][3] * inv);
                    *(u32x2*)(pb + mo * 16 + g * 4) = w;
                }
                if (g == 0) ((float*)((unsigned char*)p.out + DO_PL))[row] = l_run;
            }
        }
        r0 = rn0; r1 = rn1; e_cur = e_nxt; e_nxt = e_nn;
    }
}

__device__ __forceinline__ void moba_own_task(const Params& p, int l, int task, LAS unsigned char* lds) {
    const int b = task >> 7, hB = (task >> 5) & 3, ci = task & 31;
    const int tid = tidx(), wave = tid >> 6, lane = tid & 63, qi = lane & 15, g = lane >> 4;
    const bf16_t* pbc = (const bf16_t*)(p.ws + WS_PBC);
    MobaTask tk; tk.tokbase = b * SEQ; tk.q0 = ci * 128; tk.b_own = ci >> 1; tk.nown = (ci & 1) ? 4 : 2; tk.anysel = 0u; tk.mysel = 0u;
    const int tok = tk.q_tok(wave * 16 + qi);
    const int nsel = tk.b_own < 3 ? tk.b_own : 3;
    const size_t row0 = ((size_t)tok * 4 + hB) * 3;
    const bf16_t* pb = (const bf16_t*)((const unsigned char*)p.out + DO_PB) + row0 * 64;
    const float* pl = (const float*)((const unsigned char*)p.out + DO_PL) + row0;
    float pw[3]; u32x2 po[3][4];
#pragma unroll
    for (int sidx = 0; sidx < 3; ++sidx) {
        pw[sidx] = 0.f;
#pragma unroll
        for (int mo = 0; mo < 4; ++mo) po[sidx][mo] = (u32x2){0u, 0u};
        if (sidx < nsel) {
            pw[sidx] = pl[sidx];
#pragma unroll
            for (int mo = 0; mo < 4; ++mo) po[sidx][mo] = *(const u32x2*)(pb + sidx * 64 + mo * 16 + g * 4);
        }
    }
    AttnOut R;
    attn_core(tk, pbc + hB * 64, pbc + 256 + hB * 64, pbc + 512 + hB * 64, p.in[I_MQG] + l * 64, p.in[I_MKG] + l * 64, lds, R);
    float tot = R.l;
#pragma unroll
    for (int sidx = 0; sidx < 3; ++sidx) {
        const float w = pw[sidx];
        tot += w;
#pragma unroll
        for (int mo = 0; mo < 4; ++mo) {
            const u32x2 o = po[sidx][mo];
            R.o[mo][0] += w * bflo(o.x); R.o[mo][1] += w * bfhi(o.x); R.o[mo][2] += w * bflo(o.y); R.o[mo][3] += w * bfhi(o.y);
        }
    }
    const float inv = 1.0f / tot;
    const bf16_t* sg = (const bf16_t*)(p.ws + WS_GATE) + (size_t)tok * 1024 + 384 + hB * 64;
    bf16_t* yg = (bf16_t*)(p.ws + WS_YG) + (size_t)tok * 1024 + 384 + hB * 64;
#pragma unroll
    for (int mo = 0; mo < 4; ++mo) {
        const int dh = mo * 16 + g * 4;
        const u32x2 gt = *(const u32x2*)(sg + dh);
        u32x2 w; w.x = pk2(R.o[mo][0] * inv * bflo(gt.x), R.o[mo][1] * inv * bfhi(gt.x)); w.y = pk2(R.o[mo][2] * inv * bflo(gt.y), R.o[mo][3] * inv * bfhi(gt.y));
        *(u32x2*)(yg + dh) = w;
    }
}

__device__ __forceinline__ void moba_own_run(const Params& p, int l, int task, LAS unsigned char* lds) {
    const int b = task >> 6, hB = (task >> 4) & 3, blk = task & 15;
    const int tid = tidx(), wave = tid >> 6, lane = tid & 63, qi = lane & 15, g = lane >> 4;
    const int kr = tid >> 3, pc = tid & 7, m = wave * 16 + qi;
    const bf16_t* pbc = (const bf16_t*)(p.ws + WS_PBC);
    const bf16_t* qbase = pbc + hB * 64; const bf16_t* kbase = pbc + 256 + hB * 64; const bf16_t* vbase = pbc + 512 + hB * 64;
    const float* qg = p.in[I_MQG] + l * 64; const float* kg = p.in[I_MKG] + l * 64;
    const int keytok = b * SEQ + blk * 256;
    u32x4 qr[2][2]; int qtok[2];
#pragma unroll
    for (int qb = 0; qb < 2; ++qb) {
        qtok[qb] = keytok + qb * 128 + m;
        qr[qb][0] = *(const u32x4*)(qbase + (size_t)qtok[qb] * PBC_W + g * 8); qr[qb][1] = *(const u32x4*)(qbase + (size_t)qtok[qb] * PBC_W + 32 + g * 8);
    }
    u32x4 kreg[4], vreg[4];
#pragma unroll
    for (int j = 0; j < 4; ++j) {
        kreg[j] = *(const u32x4*)(kbase + (size_t)(keytok + j * 64 + kr) * PBC_W + pc * 8);
        vreg[j] = *(const u32x4*)(vbase + (size_t)(keytok + j * 64 + kr) * PBC_W + pc * 8);
    }
    float kgv[8];
#pragma unroll
    for (int j = 0; j < 8; ++j) kgv[j] = kg[pc * 8 + j];
    __syncthreads();
#pragma unroll
    for (int j = 0; j < 4; ++j) {
        LAS unsigned char* B = lds + j * AT_BUF;
        float kf[8];
#pragma unroll
        for (int q = 0; q < 4; ++q) { kf[2 * q] = bflo(kreg[j][q]); kf[2 * q + 1] = bfhi(kreg[j][q]); }
        float ss = 0.f;
#pragma unroll
        for (int q = 0; q < 8; ++q) ss += kf[q] * kf[q];
        ss = dsum8(ss);
        const float ks = rsqrtf(ss * (1.0f / 64.0f) + 1e-6f);
        u32x4 w; w.x = pk2(kf[0] * ks * kgv[0], kf[1] * ks * kgv[1]); w.y = pk2(kf[2] * ks * kgv[2], kf[3] * ks * kgv[3]);
        w.z = pk2(kf[4] * ks * kgv[4], kf[5] * ks * kgv[5]); w.w = pk2(kf[6] * ks * kgv[6], kf[7] * ks * kgv[7]);
        *(LAS u32x4*)(B + kr * KS_PITCH + pc * 16) = w;
        *(LAS u32x4*)(B + 64 * KS_PITCH + kr * VT_PITCH + pc * 16) = vreg[j];
    }
    __syncthreads();
    const int nsel = blk < 3 ? blk : 3;
#pragma unroll
    for (int qb = 0; qb < 2; ++qb) {
        const int tok = qtok[qb];
        const size_t row0 = ((size_t)tok * 4 + hB) * 3;
        const bf16_t* pbp = (const bf16_t*)((const unsigned char*)p.out + DO_PB) + row0 * 64;
        const float* plp = (const float*)((const unsigned char*)p.out + DO_PL) + row0;
        float pw[3]; u32x2 po[3][4];
#pragma unroll
        for (int sidx = 0; sidx < 3; ++sidx) {
            pw[sidx] = 0.f;
#pragma unroll
            for (int mo = 0; mo < 4; ++mo) po[sidx][mo] = (u32x2){0u, 0u};
            if (sidx < nsel) {
                pw[sidx] = plp[sidx];
#pragma unroll
                for (int mo = 0; mo < 4; ++mo) po[sidx][mo] = *(const u32x2*)(pbp + sidx * 64 + mo * 16 + g * 4);
            }
        }
        const u32x2 gt0 = *(const u32x2*)((const bf16_t*)(p.ws + WS_GATE) + (size_t)tok * 1024 + 384 + hB * 64 + g * 4);
        bf16x8 bq[2];
        {
            float qf[16];
#pragma unroll
            for (int j = 0; j < 4; ++j) { qf[2 * j] = bflo(qr[qb][0][j]); qf[2 * j + 1] = bfhi(qr[qb][0][j]); qf[8 + 2 * j] = bflo(qr[qb][1][j]); qf[8 + 2 * j + 1] = bfhi(qr[qb][1][j]); }
            float ss = 0.f;
#pragma unroll
            for (int j = 0; j < 16; ++j) ss += qf[j] * qf[j];
            ss += __shfl_xor(ss, 16); ss += __shfl_xor(ss, 32);
            const float qs = rsqrtf(ss * (1.0f / 64.0f) + 1e-6f) * (0.125f * 1.4426950408889634f);
            u32x4 b0, b1;
#pragma unroll
            for (int j = 0; j < 4; ++j) {
                b0[j] = pk2(qf[2 * j] * qs * qg[g * 8 + 2 * j], qf[2 * j + 1] * qs * qg[g * 8 + 2 * j + 1]);
                b1[j] = pk2(qf[8 + 2 * j] * qs * qg[32 + g * 8 + 2 * j], qf[8 + 2 * j + 1] * qs * qg[32 + g * 8 + 2 * j + 1]);
            }
            bq[0] = __builtin_bit_cast(bf16x8, b0); bq[1] = __builtin_bit_cast(bf16x8, b1);
        }
        f32x4 o[4];
#pragma unroll
        for (int mo = 0; mo < 4; ++mo) o[mo] = (f32x4){0.f, 0.f, 0.f, 0.f};
        float l_run = 0.f;
        const int qpos = qb * 128 + m;
#pragma unroll 1
        for (int j = 0; j < 4; ++j) {
            if (j * 64 > qb * 128 + wave * 16 + 15) continue;
            const LAS unsigned char* B = lds + j * AT_BUF;
            f32x4 st[4];
#pragma unroll
            for (int mt = 0; mt < 4; ++mt) {
                st[mt] = (f32x4){0.f, 0.f, 0.f, 0.f};
#pragma unroll
                for (int ks = 0; ks < 2; ++ks) {
                    const bf16x8 a = *(const LAS bf16x8*)(B + (mt * 16 + qi) * KS_PITCH + ks * 64 + g * 16);
                    st[mt] = __builtin_amdgcn_mfma_f32_16x16x32_bf16(a, bq[ks], st[mt], 0, 0, 0);
                }
            }
            float ps = 0.f;
#pragma unroll
            for (int mt = 0; mt < 4; ++mt)
#pragma unroll
                for (int ii = 0; ii < 4; ++ii) {
                    const float pv = (j * 64 + mt * 16 + g * 4 + ii <= qpos) ? __builtin_amdgcn_exp2f(st[mt][ii]) : 0.f;
                    st[mt][ii] = pv; ps += pv;
                }
            l_run += ps;
#pragma unroll
            for (int ks = 0; ks < 2; ++ks) {
                u32x4 pbw; pbw.x = pk2(st[2 * ks][0], st[2 * ks][1]); pbw.y = pk2(st[2 * ks][2], st[2 * ks][3]); pbw.z = pk2(st[2 * ks + 1][0], st[2 * ks + 1][1]); pbw.w = pk2(st[2 * ks + 1][2], st[2 * ks + 1][3]);
                const bf16x8 pb = __builtin_bit_cast(bf16x8, pbw);
#pragma unroll
                for (int mo = 0; mo < 4; ++mo) {
                    const LAS unsigned char* vp = B + 64 * KS_PITCH + (ks * 32 + 4 * g + (qi >> 2)) * VT_PITCH + (mo * 16 + 4 * (qi & 3)) * 2;
                    const s16x4 lo = __builtin_amdgcn_ds_read_tr16_b64_v4i16((LAS s16x4*)vp), hi = __builtin_amdgcn_ds_read_tr16_b64_v4i16((LAS s16x4*)(vp + 16 * VT_PITCH));
                    bf16x8 av; av[0] = lo[0]; av[1] = lo[1]; av[2] = lo[2]; av[3] = lo[3]; av[4] = hi[0]; av[5] = hi[1]; av[6] = hi[2]; av[7] = hi[3];
                    o[mo] = __builtin_amdgcn_mfma_f32_16x16x32_bf16(av, pb, o[mo], 0, 0, 0);
                }
            }
        }
        l_run += __shfl_xor(l_run, 16); l_run += __shfl_xor(l_run, 32);
        float tot = l_run;
#pragma unroll
        for (int sidx = 0; sidx < 3; ++sidx) {
            const float w = pw[sidx];
            tot += w;
#pragma unroll
            for (int mo = 0; mo < 4; ++mo) {
                const u32x2 oo = po[sidx][mo];
                o[mo][0] += w * bflo(oo.x); o[mo][1] += w * bfhi(oo.x); o[mo][2] += w * bflo(oo.y); o[mo][3] += w * bfhi(oo.y);
            }
        }
        const float inv = 1.0f / tot;
        const bf16_t* sg = (const bf16_t*)(p.ws + WS_GATE) + (size_t)tok * 1024 + 384 + hB * 64;
        bf16_t* yg = (bf16_t*)(p.ws + WS_YG) + (size_t)tok * 1024 + 384 + hB * 64;
#pragma unroll
        for (int mo = 0; mo < 4; ++mo) {
            const int dh = mo * 16 + g * 4;
            const u32x2 gt = (mo == 0) ? gt0 : *(const u32x2*)(sg + dh);
            u32x2 w; w.x = pk2(o[mo][0] * inv * bflo(gt.x), o[mo][1] * inv * bfhi(gt.x)); w.y = pk2(o[mo][2] * inv * bflo(gt.y), o[mo][3] * inv * bfhi(gt.y));
            *(u32x2*)(yg + dh) = w;
        }
    }
}

__device__ __forceinline__ void kmean_task(const Params& p, int l, int task, LAS unsigned char* lds) {
    const int b = task / 64, r = task % 64, hB = r / 16, n = r % 16;
    const int tid = tidx(), kr = tid >> 3, pc = tid & 7;
    const bf16_t* kb = (const bf16_t*)(p.ws + WS_PBC) + 256 + hB * 64 + pc * 8;
    const float* kg = p.in[I_MKG] + l * 64 + pc * 8;
    float acc[8];
#pragma unroll
    for (int j = 0; j < 8; ++j) acc[j] = 0.f;
#pragma unroll
    for (int it = 0; it < 4; ++it) {
        const u32x4 rw = *(const u32x4*)(kb + (size_t)(b * SEQ + n * 256 + it * 64 + kr) * PBC_W);
        float kf[8];
#pragma unroll
        for (int q = 0; q < 4; ++q) { kf[2 * q] = bflo(rw[q]); kf[2 * q + 1] = bfhi(rw[q]); }
        float ss = 0.f;
#pragma unroll
        for (int q = 0; q < 8; ++q) ss += kf[q] * kf[q];
        ss = sum8(ss);
        const float ks = rsqrtf(ss * (1.0f / 64.0f) + 1e-6f);
#pragma unroll
        for (int q = 0; q < 8; ++q) acc[q] += bf2f(f2bf(kf[q] * ks * kg[q]));
    }
    LAS float* red = (LAS float*)lds;
    __syncthreads();
#pragma unroll
    for (int q = 0; q < 8; ++q) red[kr * 64 + pc * 8 + q] = acc[q];
    __syncthreads();
    if (tid < 64) {
        float s = 0.f;
        for (int i = 0; i < 64; ++i) s += red[i * 64 + tid];
        __hip_atomic_store((float*)(p.ws + WS_KMEAN) + (size_t)((b * 4 + hB) * 16 + n) * 64 + tid, s * (1.0f / 256.0f), __ATOMIC_RELAXED, __HIP_MEMORY_SCOPE_AGENT);
    }
    asm volatile("s_waitcnt vmcnt(0)" ::: "memory");
    __syncthreads();
    if (threadIdx.x == 0)
        __hip_atomic_fetch_add((unsigned*)(p.ws + WS_KMC) + (b * 4 + hB), 1u, __ATOMIC_RELAXED, __HIP_MEMORY_SCOPE_AGENT);
}

typedef float f32x2 __attribute__((ext_vector_type(2)));
constexpr size_t CH_ELEMS = 4096;
struct ChunkPre { u32x4 cur[5]; };
__device__ __forceinline__ void rwkv_chunk_load(const Params& p, int task, ChunkPre& P) {
    const int bh = task / 64, ch = task % 64, b = bh / 6, h = bh % 6;
    const int tid = tidx(), tl = tid >> 3, pc = tid & 7;
    const int s = ch * 64 + tl, tok = b * SEQ + s;
    const bf16_t* pa = (const bf16_t*)(p.ws + WS_PA);
#pragma unroll
    for (int gi = 0; gi < 5; ++gi) {
        const int cb = (gi < 3 ? gi * 384 + h * 64 : (gi == 3 ? 1152 : 1216)) + pc * 8;
        P.cur[gi] = *(const u32x4*)(pa + (size_t)tok * PA_W + cb);
    }
}
__device__ __forceinline__ void rwkv_chunk_task(const Params& p, int l, int task, int task_next, ChunkPre& P, LAS unsigned char* lds) {
    const int bh = task / 64, ch = task % 64, b = bh / 6, h = bh % 6;
    const int tid = tidx(), tl = tid >> 3, pc = tid & 7;
    const int s = ch * 64 + tl, tok = b * SEQ + s;
    LAS float* sh = (LAS float*)lds;
    LAS float* ops = (LAS float*)lds;
    LAS float* vimg = (LAS float*)(lds + 81920);
    LAS float* y0l = (LAS float*)(lds + 98304);
    LAS bf16_t* qlds = (LAS bf16_t*)(lds + 114688);
    const float* mu = p.in[I_MU] + l * 1280;
    __syncthreads();
    LAS unsigned char* a34 = lds + 49152; LAS unsigned char* wat = lds + 67584; LAS float* lres = (LAS float*)(lds + 86016);
#pragma unroll
    for (int gi = 0; gi < 5; ++gi) {
        const int cb = (gi < 3 ? gi * 384 + h * 64 : (gi == 3 ? 1152 : 1216)) + pc * 8;
        const u32x4 cur = P.cur[gi];
        u32x4 prv = {0u, 0u, 0u, 0u};
        if (s > 0) prv = *(const u32x4*)((const bf16_t*)(p.ws + WS_PA) + (size_t)(tok - 1) * PA_W + cb);
        float vals[8];
#pragma unroll
        for (int q = 0; q < 4; ++q) {
            const float c0 = bflo(cur[q]), c1 = bfhi(cur[q]), p0 = bflo(prv[q]), p1 = bfhi(prv[q]);
            float v0 = c0 + (p0 - c0) * mu[cb + 2 * q], v1 = c1 + (p1 - c1) * mu[cb + 2 * q + 1];
            if (gi == 3) { v0 = 1.0f - 2.0f * __builtin_amdgcn_rcpf(1.0f + __expf(2.0f * v0)); v1 = 1.0f - 2.0f * __builtin_amdgcn_rcpf(1.0f + __expf(2.0f * v1)); }
            vals[2 * q] = v0; vals[2 * q + 1] = v1;
        }
        if (gi < 3) {
#pragma unroll
            for (int q = 0; q < 8; ++q) sh[gi * 4096 + tl * 64 + pc * 8 + q] = vals[q];
        } else {
            u32x4 w; w.x = pk2(vals[0], vals[1]); w.y = pk2(vals[2], vals[3]); w.z = pk2(vals[4], vals[5]); w.w = pk2(vals[6], vals[7]);
            *(LAS u32x4*)(a34 + (gi - 3) * 9216 + tl * 144 + pc * 16) = w;
        }
    }
    {
        const float* wsrc = p.in[I_WUP] + (size_t)l * 64 * 384 + (size_t)tl * 384 + h * 64 + pc * 8;
        const float* asrc = p.in[I_AUP] + (size_t)l * 64 * 384 + (size_t)tl * 384 + h * 64 + pc * 8;
        const f32x4 w0 = *(const f32x4*)wsrc, w1 = *(const f32x4*)(wsrc + 4), a0 = *(const f32x4*)asrc, a1 = *(const f32x4*)(asrc + 4);
#pragma unroll
        for (int q = 0; q < 4; ++q) {
            *(LAS bf16_t*)(wat + (pc * 8 + q) * 144 + tl * 2) = (bf16_t)(pk2(w0[q], 0.f) & 0xFFFFu); *(LAS bf16_t*)(wat + (pc * 8 + 4 + q) * 144 + tl * 2) = (bf16_t)(pk2(w1[q], 0.f) & 0xFFFFu);
            *(LAS bf16_t*)(wat + 9216 + (pc * 8 + q) * 144 + tl * 2) = (bf16_t)(pk2(a0[q], 0.f) & 0xFFFFu); *(LAS bf16_t*)(wat + 9216 + (pc * 8 + 4 + q) * 144 + tl * 2) = (bf16_t)(pk2(a1[q], 0.f) & 0xFFFFu);
        }
    }
    __syncthreads();
    if (task_next >= 0) rwkv_chunk_load(p, task_next, P);
    {
        const int wave = tid >> 6, lane = tid & 63, lq = lane & 15, g = lane >> 4, mat = wave >> 2, mt = wave & 3;
        const LAS unsigned char* Am = a34 + mat * 9216; const LAS unsigned char* Bm = wat + mat * 9216;
        const bf16x8 x0 = *(const LAS bf16x8*)(Am + (16 * mt + lq) * 144 + g * 16), x1 = *(const LAS bf16x8*)(Am + (16 * mt + lq) * 144 + 64 + g * 16);
#pragma unroll
        for (int nt = 0; nt < 4; ++nt) {
            const bf16x8 y0 = *(const LAS bf16x8*)(Bm + (16 * nt + lq) * 144 + g * 16), y1 = *(const LAS bf16x8*)(Bm + (16 * nt + lq) * 144 + 64 + g * 16);
            f32x4 D = {0.f, 0.f, 0.f, 0.f};
            D = __builtin_amdgcn_mfma_f32_16x16x32_bf16(x0, y0, D, 0, 0, 0);
            D = __builtin_amdgcn_mfma_f32_16x16x32_bf16(x1, y1, D, 0, 0, 0);
#pragma unroll
            for (int i = 0; i < 4; ++i) lres[mat * 4096 + (16 * mt + 4 * g + i) * 64 + 16 * nt + lq] = D[i];
        }
    }
    __syncthreads();
    const int cbase = l * 384 + h * 64 + pc * 8;
    float wa[8], aa[8];
#pragma unroll
    for (int j = 0; j < 8; ++j) { wa[j] = p.in[I_W0][cbase + j] + lres[tl * 64 + pc * 8 + j]; aa[j] = p.in[I_A0][cbase + j] + lres[4096 + tl * 64 + pc * 8 + j]; }
    __syncthreads();
    {
        float wv[8], av[8], kkv[8], kp[8], rv[8], vv[8];
        float ssq = 0.f, bon = 0.f;
#pragma unroll
        for (int j = 0; j < 8; ++j) {
            const float z = -wa[j];
            const float sp = fmaxf(z, 0.f) + __logf(1.0f + __expf(-fabsf(z)));
            wv[j] = __expf(-__expf(-sp - 0.5f));
            av[j] = __builtin_amdgcn_rcpf(1.0f + __expf(-aa[j]));
            const float kraw = sh[1 * 4096 + tl * 64 + pc * 8 + j];
            kkv[j] = kraw * p.in[I_KK][cbase + j];
            ssq += kkv[j] * kkv[j];
            kp[j] = kraw * (1.0f + (av[j] - 1.0f) * p.in[I_KA][cbase + j]);
            rv[j] = sh[0 * 4096 + tl * 64 + pc * 8 + j]; vv[j] = sh[2 * 4096 + tl * 64 + pc * 8 + j];
            bon += rv[j] * kp[j] * p.in[I_RK][cbase + j];
        }
        ssq = sum8(ssq); bon = sum8(bon);
        const float inv = rsqrtf(ssq + 1e-12f);
        __syncthreads();
        LAS float* ob = ops + tl * 320 + pc * 8;
#pragma unroll
        for (int j = 0; j < 8; ++j) {
            const float kk = kkv[j] * inv;
            ob[j] = wv[j]; ob[64 + j] = kk; ob[128 + j] = kk * av[j]; ob[192 + j] = rv[j]; ob[256 + j] = kp[j];
            vimg[tl * 64 + pc * 8 + j] = vv[j];
        }
        u32x4 w; w.x = pk2(bon * vv[0], bon * vv[1]); w.y = pk2(bon * vv[2], bon * vv[3]); w.z = pk2(bon * vv[4], bon * vv[5]); w.w = pk2(bon * vv[6], bon * vv[7]);
        *(u32x4*)((bf16_t*)(p.ws + WS_BV) + (size_t)task * CH_ELEMS + tl * 64 + pc * 8) = w;
    }
    __syncthreads();
    const int rp = tid >> 3, kq = tid & 7;
    const bool isH = rp < 32;
    const int rowA = isH ? 2 * rp : 2 * (rp - 32);
    const int posA = ((rowA >> 2) & 3) * 16 + (rowA >> 4) * 4 + (rowA & 3);
    f32x2 S0[4], S1[4];
#pragma unroll
    for (int q = 0; q < 4; ++q) {
        S0[q] = (f32x2){0.f, 0.f}; S1[q] = (f32x2){0.f, 0.f};
        if (!isH) {
            S0[q].x = (8 * kq + 2 * q == rowA) ? 1.f : 0.f; S0[q].y = (8 * kq + 2 * q + 1 == rowA) ? 1.f : 0.f;
            S1[q].x = (8 * kq + 2 * q == rowA + 1) ? 1.f : 0.f; S1[q].y = (8 * kq + 2 * q + 1 == rowA + 1) ? 1.f : 0.f;
        }
    }
    const LAS float* o_b = ops + kq * 8; const LAS float* o_v = vimg + rowA;
    struct Ops { f32x4 w0, w1, kk0, kk1, bb0, bb1, k0, k1, r0, r1; f32x2 v; };
#define CK_LOAD(O, t, HASV) do { const LAS float* _b = o_b + (t) * 320; O.w0 = *(const LAS f32x4*)(_b); O.w1 = *(const LAS f32x4*)(_b + 4); O.kk0 = *(const LAS f32x4*)(_b + 64); O.kk1 = *(const LAS f32x4*)(_b + 68); \
        O.bb0 = *(const LAS f32x4*)(_b + 128); O.bb1 = *(const LAS f32x4*)(_b + 132); O.r0 = *(const LAS f32x4*)(_b + 192); O.r1 = *(const LAS f32x4*)(_b + 196); \
        if (HASV) { O.k0 = *(const LAS f32x4*)(_b + 256); O.k1 = *(const LAS f32x4*)(_b + 260); O.v = *(const LAS f32x2*)(o_v + (t) * 64); } } while (0)
#define CK_P(X, q) ((f32x2){X##0[(q) * 2 & 3], X##0[((q) * 2 & 3) + 1]})
#define CK_STEP(O, t, HASV) do { \
        const f32x2 w_0 = {O.w0[0], O.w0[1]}, w_1 = {O.w0[2], O.w0[3]}, w_2 = {O.w1[0], O.w1[1]}, w_3 = {O.w1[2], O.w1[3]}; \
        const f32x2 kk_0 = {O.kk0[0], O.kk0[1]}, kk_1 = {O.kk0[2], O.kk0[3]}, kk_2 = {O.kk1[0], O.kk1[1]}, kk_3 = {O.kk1[2], O.kk1[3]}; \
        const f32x2 bb_0 = {O.bb0[0], O.bb0[1]}, bb_1 = {O.bb0[2], O.bb0[3]}, bb_2 = {O.bb1[0], O.bb1[1]}, bb_3 = {O.bb1[2], O.bb1[3]}; \
        const f32x2 r_0 = {O.r0[0], O.r0[1]}, r_1 = {O.r0[2], O.r0[3]}, r_2 = {O.r1[0], O.r1[1]}, r_3 = {O.r1[2], O.r1[3]}; \
        f32x2 a0 = S0[0] * kk_0, a1 = S1[0] * kk_0; a0 = S0[1] * kk_1 + a0; a1 = S1[1] * kk_1 + a1; a0 = S0[2] * kk_2 + a0; a1 = S1[2] * kk_2 + a1; a0 = S0[3] * kk_3 + a0; a1 = S1[3] * kk_3 + a1; \
        float sa0 = a0.x + a0.y, sa1 = a1.x + a1.y; \
        sa0 += dppf<0xB1>(sa0); sa1 += dppf<0xB1>(sa1); sa0 += dppf<0x4E>(sa0); sa1 += dppf<0x4E>(sa1); sa0 = -(sa0 + dppf<0x141>(sa0)); sa1 = -(sa1 + dppf<0x141>(sa1)); \
        if (HASV) { const f32x2 k_0 = {O.k0[0], O.k0[1]}, k_1 = {O.k0[2], O.k0[3]}, k_2 = {O.k1[0], O.k1[1]}, k_3 = {O.k1[2], O.k1[3]}; const float v0 = O.v.x, v1 = O.v.y; \
            S0[0] = S0[0] * w_0 + (bb_0 * sa0 + k_0 * v0); S1[0] = S1[0] * w_0 + (bb_0 * sa1 + k_0 * v1); S0[1] = S0[1] * w_1 + (bb_1 * sa0 + k_1 * v0); S1[1] = S1[1] * w_1 + (bb_1 * sa1 + k_1 * v1); \
            S0[2] = S0[2] * w_2 + (bb_2 * sa0 + k_2 * v0); S1[2] = S1[2] * w_2 + (bb_2 * sa1 + k_2 * v1); S0[3] = S0[3] * w_3 + (bb_3 * sa0 + k_3 * v0); S1[3] = S1[3] * w_3 + (bb_3 * sa1 + k_3 * v1); \
        } else { \
            S0[0] = S0[0] * w_0 + bb_0 * sa0; S1[0] = S1[0] * w_0 + bb_0 * sa1; S0[1] = S0[1] * w_1 + bb_1 * sa0; S1[1] = S1[1] * w_1 + bb_1 * sa1; \
            S0[2] = S0[2] * w_2 + bb_2 * sa0; S1[2] = S1[2] * w_2 + bb_2 * sa1; S0[3] = S0[3] * w_3 + bb_3 * sa0; S1[3] = S1[3] * w_3 + bb_3 * sa1; } \
        f32x2 y0 = S0[0] * r_0, y1 = S1[0] * r_0; y0 = S0[1] * r_1 + y0; y1 = S1[1] * r_1 + y1; y0 = S0[2] * r_2 + y0; y1 = S1[2] * r_2 + y1; y0 = S0[3] * r_3 + y0; y1 = S1[3] * r_3 + y1; \
        float ya = y0.x + y0.y, yb = y1.x + y1.y; \
        ya += dppf<0xB1>(ya); yb += dppf<0xB1>(yb); ya += dppf<0x4E>(ya); yb += dppf<0x4E>(yb); ya += dppf<0x141>(ya); yb += dppf<0x141>(yb); \
        { if (HASV) *(LAS f32x2*)(y0l + (t) * 64 + rowA) = (f32x2){ya, yb}; else *(LAS unsigned*)(qlds + (t) * 64 + posA) = pk2(ya, yb); } } while (0)
    Ops OA, OB;
    if (isH) {
        CK_LOAD(OA, 0, true);
        for (int t = 0; t < 64; t += 4) { CK_LOAD(OB, t + 1, true); CK_STEP(OA, t, true); CK_LOAD(OA, t + 2, true); CK_STEP(OB, t + 1, true); CK_LOAD(OB, t + 3, true); CK_STEP(OA, t + 2, true); if (t + 4 < 64) CK_LOAD(OA, t + 4, true); CK_STEP(OB, t + 3, true); }
    } else {
        CK_LOAD(OA, 0, false);
        for (int t = 0; t < 64; t += 4) { CK_LOAD(OB, t + 1, false); CK_STEP(OA, t, false); CK_LOAD(OA, t + 2, false); CK_STEP(OB, t + 1, false); CK_LOAD(OB, t + 3, false); CK_STEP(OA, t + 2, false); if (t + 4 < 64) CK_LOAD(OA, t + 4, false); CK_STEP(OB, t + 3, false); }
    }
#undef CK_LOAD
#undef CK_P
#undef CK_STEP
    if (isH) {
        bf16_t* hm = (bf16_t*)(p.ws + WS_HM) + (size_t)task * CH_ELEMS + ((kq & 1) * 2) * 16 + (kq >> 1) * 4;
        u32x2 w; w.x = pk2(S0[0].x, S0[0].y); w.y = pk2(S0[1].x, S0[1].y); *(u32x2*)(hm + (size_t)rowA * 64) = w;
        w.x = pk2(S0[2].x, S0[2].y); w.y = pk2(S0[3].x, S0[3].y); *(u32x2*)(hm + (size_t)rowA * 64 + 16) = w;
        w.x = pk2(S1[0].x, S1[0].y); w.y = pk2(S1[1].x, S1[1].y); *(u32x2*)(hm + (size_t)(rowA + 1) * 64) = w;
        w.x = pk2(S1[2].x, S1[2].y); w.y = pk2(S1[3].x, S1[3].y); *(u32x2*)(hm + (size_t)(rowA + 1) * 64 + 16) = w;
    } else {
        bf16_t* gt = (bf16_t*)(p.ws + WS_GT) + (size_t)task * CH_ELEMS + posA;
#pragma unroll
        for (int q = 0; q < 4; ++q) {
            *(unsigned*)(gt + (size_t)(8 * kq + 2 * q) * 64) = pk2(S0[q].x, S1[q].x);
            *(unsigned*)(gt + (size_t)(8 * kq + 2 * q + 1) * 64) = pk2(S0[q].y, S1[q].y);
        }
    }
    __syncthreads();
    {
        *(u32x4*)((bf16_t*)(p.ws + WS_QQ) + (size_t)task * CH_ELEMS + tid * 8) = *(const LAS u32x4*)(qlds + tid * 8);
        const f32x4 ya = *(const LAS f32x4*)(y0l + tid * 8), yb = *(const LAS f32x4*)(y0l + tid * 8 + 4);
        u32x4 w; w.x = pk2(ya[0], ya[1]); w.y = pk2(ya[2], ya[3]); w.z = pk2(yb[0], yb[1]); w.w = pk2(yb[2], yb[3]);
        *(u32x4*)((bf16_t*)(p.ws + WS_Y0) + (size_t)task * CH_ELEMS + tid * 8) = w;
    }
}

constexpr int RC_PITCH = 144, RC_IMG = 64 * RC_PITCH, RC_SLOT = 2 * RC_IMG;
__device__ __forceinline__ void recur_task(const Params& p, int l, int bh, LAS unsigned char* lds) {
    const int tid = tidx(), wave = tid >> 6, lane = tid & 63, lq = lane & 15, g = lane >> 4;
    const int v = (wave & 3) * 16 + lq;
    const bf16_t* GT = (const bf16_t*)(p.ws + WS_GT) + (size_t)bh * 64 * CH_ELEMS;
    const bf16_t* HM = (const bf16_t*)(p.ws + WS_HM) + (size_t)bh * 64 * CH_ELEMS;
    bf16_t* SC = (bf16_t*)(p.ws + WS_SC) + (size_t)bh * 64 * CH_ELEMS;
    const int srow = tid >> 3, spc = tid & 7;
    const int soff = srow * RC_PITCH + spc * 16;
    f32x4 sacc[4];
#pragma unroll
    for (int mt = 0; mt < 4; ++mt) sacc[mt] = (f32x4){0.f, 0.f, 0.f, 0.f};
    u32x4 bS[2] = {{0u, 0u, 0u, 0u}, {0u, 0u, 0u, 0u}};
    u32x4 sgA[4], shA[4], sgB[4], shB[4];
#define RC_LD(SG, SH, grpi) do { _Pragma("unroll") for (int i = 0; i < 4; ++i) { SG[i] = *(const u32x4*)(GT + (size_t)((grpi) * 4 + i) * CH_ELEMS + tid * 8); SH[i] = *(const u32x4*)(HM + (size_t)((grpi) * 4 + i) * CH_ELEMS + tid * 8); } } while (0)
#define RC_ST(SG, SH) do { _Pragma("unroll") for (int i = 0; i < 4; ++i) { *(LAS u32x4*)(lds + i * RC_SLOT + soff) = SG[i]; *(LAS u32x4*)(lds + i * RC_SLOT + RC_IMG + soff) = SH[i]; } } while (0)
    RC_LD(sgA, shA, 0); RC_LD(sgB, shB, 1);
    __syncthreads();
    for (int grp = 0; grp < 16; ++grp) {
        if (grp & 1) { RC_ST(sgB, shB); if (grp + 2 < 16) RC_LD(sgB, shB, grp + 2); }
        else         { RC_ST(sgA, shA); if (grp + 2 < 16) RC_LD(sgA, shA, grp + 2); }
        __syncthreads();
        if (wave < 4) {
#pragma unroll 1
            for (int i = 0; i < 4; ++i) {
                const int c = grp * 4 + i;
                const LAS unsigned char* G = lds + i * RC_SLOT;
                u32x4 w0, w1;
                w0.x = pk2(sacc[0][0], sacc[0][1]); w0.y = pk2(sacc[0][2], sacc[0][3]); w0.z = pk2(sacc[1][0], sacc[1][1]); w0.w = pk2(sacc[1][2], sacc[1][3]);
                w1.x = pk2(sacc[2][0], sacc[2][1]); w1.y = pk2(sacc[2][2], sacc[2][3]); w1.z = pk2(sacc[3][0], sacc[3][1]); w1.w = pk2(sacc[3][2], sacc[3][3]);
                *(u32x4*)(SC + (size_t)c * CH_ELEMS + v * 64 + 16 * g) = w0; *(u32x4*)(SC + (size_t)c * CH_ELEMS + v * 64 + 16 * g + 8) = w1;
                const u32x4 h0 = *(const LAS u32x4*)(G + RC_IMG + v * RC_PITCH + g * 32), h1 = *(const LAS u32x4*)(G + RC_IMG + v * RC_PITCH + g * 32 + 16);
                f32x4 D[4];
                D[0] = (f32x4){bflo(h0.x), bfhi(h0.x), bflo(h0.y), bfhi(h0.y)}; D[1] = (f32x4){bflo(h0.z), bfhi(h0.z), bflo(h0.w), bfhi(h0.w)};
                D[2] = (f32x4){bflo(h1.x), bfhi(h1.x), bflo(h1.y), bfhi(h1.y)}; D[3] = (f32x4){bflo(h1.z), bfhi(h1.z), bflo(h1.w), bfhi(h1.w)};
#pragma unroll
                for (int mt = 0; mt < 4; ++mt)
#pragma unroll
                    for (int ks = 0; ks < 2; ++ks) {
                        const bf16x8 a = *(const LAS bf16x8*)(G + (16 * mt + lq) * RC_PITCH + g * 32 + ks * 16);
                        D[mt] = __builtin_amdgcn_mfma_f32_16x16x32_bf16(a, __builtin_bit_cast(bf16x8, bS[ks]), D[mt], 0, 0, 0);
                    }
#pragma unroll
                for (int mt = 0; mt < 4; ++mt) sacc[mt] = D[mt];
#pragma unroll
                for (int ks = 0; ks < 2; ++ks) {
                    bS[ks].x = pk2(D[2 * ks][0], D[2 * ks][1]); bS[ks].y = pk2(D[2 * ks][2], D[2 * ks][3]);
                    bS[ks].z = pk2(D[2 * ks + 1][0], D[2 * ks + 1][1]); bS[ks].w = pk2(D[2 * ks + 1][2], D[2 * ks + 1][3]);
                }
            }
        }
        __syncthreads();
    }
}

__device__ __forceinline__ void rwkv_out_task(const Params& p, int l, int pairtask) {
    const int tid = tidx(), wave = tid >> 6, lane = tid & 63, lq = lane & 15, g = lane >> 4;
    const int chunk = pairtask * 2 + (wave >> 2), bh = chunk / 64, ch = chunk % 64, b = bh / 6, h = bh % 6;
    const int t = (wave & 3) * 16 + lq;
    const int tok = b * SEQ + ch * 64 + t;
    const bf16_t* SC = (const bf16_t*)(p.ws + WS_SC) + (size_t)chunk * CH_ELEMS;
    const bf16_t* QQ = (const bf16_t*)(p.ws + WS_QQ) + (size_t)chunk * CH_ELEMS;
    const bf16_t* Y0 = (const bf16_t*)(p.ws + WS_Y0) + (size_t)chunk * CH_ELEMS;
    const bf16_t* BV = (const bf16_t*)(p.ws + WS_BV) + (size_t)chunk * CH_ELEMS;
    const bf16_t* sg = (const bf16_t*)(p.ws + WS_GATE) + (size_t)tok * 1024 + h * 64;
    bf16_t* yg = (bf16_t*)(p.ws + WS_YG) + (size_t)tok * 1024 + h * 64;
    bf16x8 bQ[2], aS[4][2]; u32x2 y0[4], bv[4], gt[4]; f32x4 gg[4], gb[4];
#pragma unroll
    for (int ks = 0; ks < 2; ++ks) bQ[ks] = *(const bf16x8*)(QQ + t * 64 + 32 * ks + 8 * g);
#pragma unroll
    for (int vt = 0; vt < 4; ++vt) {
        const int vv = 16 * vt + 4 * g;
        y0[vt] = *(const u32x2*)(Y0 + t * 64 + vv);
#pragma unroll
        for (int ks = 0; ks < 2; ++ks) aS[vt][ks] = *(const bf16x8*)(SC + (16 * vt + lq) * 64 + 32 * ks + 8 * g);
        bv[vt] = *(const u32x2*)(BV + t * 64 + vv); gt[vt] = *(const u32x2*)(sg + vv);
        gg[vt] = *(const f32x4*)(p.in[I_LNG] + l * 384 + h * 64 + vv); gb[vt] = *(const f32x4*)(p.in[I_LNB] + l * 384 + h * 64 + vv);
    }
    f32x4 D[4];
#pragma unroll
    for (int vt = 0; vt < 4; ++vt) {
        D[vt] = (f32x4){bflo(y0[vt].x), bfhi(y0[vt].x), bflo(y0[vt].y), bfhi(y0[vt].y)};
#pragma unroll
        for (int ks = 0; ks < 2; ++ks) D[vt] = __builtin_amdgcn_mfma_f32_16x16x32_bf16(aS[vt][ks], bQ[ks], D[vt], 0, 0, 0);
    }
    float sm = 0.f;
#pragma unroll
    for (int vt = 0; vt < 4; ++vt) sm += (D[vt][0] + D[vt][1]) + (D[vt][2] + D[vt][3]);
    sm += __shfl_xor(sm, 16); sm += __shfl_xor(sm, 32);
    const float mean = sm * (1.0f / 64.0f);
    float vs = 0.f;
#pragma unroll
    for (int vt = 0; vt < 4; ++vt) { D[vt] -= mean; vs += (D[vt][0] * D[vt][0] + D[vt][1] * D[vt][1]) + (D[vt][2] * D[vt][2] + D[vt][3] * D[vt][3]); }
    vs += __shfl_xor(vs, 16); vs += __shfl_xor(vs, 32);
    const float rstd = rsqrtf(vs * (1.0f / 64.0f) + 64e-5f);
#pragma unroll
    for (int vt = 0; vt < 4; ++vt) {
        const float o0 = (D[vt][0] * rstd * gg[vt][0] + gb[vt][0] + bflo(bv[vt].x)) * bflo(gt[vt].x), o1 = (D[vt][1] * rstd * gg[vt][1] + gb[vt][1] + bfhi(bv[vt].x)) * bfhi(gt[vt].x);
        const float o2 = (D[vt][2] * rstd * gg[vt][2] + gb[vt][2] + bflo(bv[vt].y)) * bflo(gt[vt].y), o3 = (D[vt][3] * rstd * gg[vt][3] + gb[vt][3] + bfhi(bv[vt].y)) * bfhi(gt[vt].y);
        u32x2 w; w.x = pk2(o0, o1); w.y = pk2(o2, o3);
        *(u32x2*)(yg + 16 * vt + 4 * g) = w;
    }
}

constexpr int GT_AP = 64 * 144, GT_BP = 128 * 144, GT_BUF = GT_AP + GT_BP;
__device__ __forceinline__ void gate_tail_task(const Params& p, int l, int task, LAS unsigned char* lds) {
    const int tid = tidx(), wave = tid >> 6, lane = tid & 63, lq = lane & 15, g = lane >> 4;
    const int r0 = task * 64, nq = wave & 3, mh = wave >> 2;
    const bf16_t* xb = (const bf16_t*)(p.ws + WS_XB) + (size_t)r0 * 1024;
    const bf16_t* wt = (const bf16_t*)(p.ws + ((l & 1) ? WS_WIN1 : WS_WIN)) + (size_t)4096 * 1024;
    const int srow = tid >> 3, spc = tid & 7;
    const int tokrow = r0 + nq * 16 + lq;
    const float* sq = (const float*)(p.ws + WS_SSQ) + (size_t)tokrow * 16;
    const f32x4 q0 = *(const f32x4*)sq, q1 = *(const f32x4*)(sq + 4), q2 = *(const f32x4*)(sq + 8), q3 = *(const f32x4*)(sq + 12);
    f32x4 acc[4];
#pragma unroll
    for (int mt = 0; mt < 4; ++mt) acc[mt] = (f32x4){0.f, 0.f, 0.f, 0.f};
    u32x4 aA, bA0, bA1, aB, bB0, bB1;
#define GT_LOAD(kt, AR, BR0, BR1) do { AR = *(const u32x4*)(xb + (size_t)srow * 1024 + (kt) * 64 + spc * 8); \
        BR0 = *(const u32x4*)(wt + (size_t)srow * 1024 + (kt) * 64 + spc * 8); BR1 = *(const u32x4*)(wt + (size_t)(srow + 64) * 1024 + (kt) * 64 + spc * 8); } while (0)
#define GT_STORE(buf, AR, BR0, BR1) do { LAS unsigned char* _B = lds + (buf) * GT_BUF; *(LAS u32x4*)(_B + srow * 144 + spc * 16) = AR; \
        *(LAS u32x4*)(_B + GT_AP + srow * 144 + spc * 16) = BR0; *(LAS u32x4*)(_B + GT_AP + (srow + 64) * 144 + spc * 16) = BR1; } while (0)
#define GT_COMPUTE(buf) do { const LAS unsigned char* _B = lds + (buf) * GT_BUF; _Pragma("unroll") for (int ks = 0; ks < 2; ++ks) { \
        const bf16x8 xf = *(const LAS bf16x8*)(_B + (nq * 16 + lq) * 144 + ks * 64 + g * 16); \
        _Pragma("unroll") for (int mt = 0; mt < 4; ++mt) { const bf16x8 wf = *(const LAS bf16x8*)(_B + GT_AP + (mh * 64 + mt * 16 + lq) * 144 + ks * 64 + g * 16); \
            acc[mt] = __builtin_amdgcn_mfma_f32_16x16x32_bf16(wf, xf, acc[mt], 0, 0, 0); } } } while (0)
    GT_LOAD(0, aA, bA0, bA1);
    GT_LOAD(1, aB, bB0, bB1);
    __syncthreads();
    GT_STORE(0, aA, bA0, bA1);
    GT_LOAD(2, aA, bA0, bA1);
    __syncthreads();
    for (int kt = 0; kt < 16; kt += 2) {
        GT_COMPUTE(0);
        GT_STORE(1, aB, bB0, bB1);
        if (kt + 3 < 16) GT_LOAD(kt + 3, aB, bB0, bB1);
        __syncthreads();
        GT_COMPUTE(1);
        if (kt + 2 < 16) { GT_STORE(0, aA, bA0, bA1); if (kt + 4 < 16) GT_LOAD(kt + 4, aA, bA0, bA1); }
        __syncthreads();
    }
#undef GT_LOAD
#undef GT_STORE
#undef GT_COMPUTE
    const float ssum = ((q0[0] + q0[1]) + (q0[2] + q0[3])) + ((q1[0] + q1[1]) + (q1[2] + q1[3])) + ((q2[0] + q2[1]) + (q2[2] + q2[3])) + ((q3[0] + q3[1]) + (q3[2] + q3[3]));
    const float rs = rsqrtf(ssum * (1.0f / 1024.0f) + 1e-6f);
    bf16_t* gate = (bf16_t*)(p.ws + WS_GATE) + (size_t)tokrow * 1024 + 896 + mh * 64 + 4 * g;
#pragma unroll
    for (int mt = 0; mt < 4; ++mt) {
        f32x4 v = acc[mt] * rs;
#pragma unroll
        for (int j = 0; j < 4; ++j) v[j] = v[j] * __builtin_amdgcn_rcpf(1.0f + __expf(-v[j]));
        u32x2 w; w.x = pk2(v[0], v[1]); w.y = pk2(v[2], v[3]);
        *(u32x2*)(gate + mt * 16) = w;
    }
}

#define XB_TMO      128
#define XB_XCNT(j)  (256  + 64 * (j))
#define XB_XSUB(j)  (1280 + 64 * (j))
#define XB_XGEN(j)  (2304 + 64 * (j))
#define XB_TOP      3328
#define XB_TOPGEN   3392
#define XCD_BAR_WORDS 3456
#define XB_SPIN_CAP (1u << 18)

__device__ __forceinline__ unsigned xb_ld(unsigned* p)              { return __hip_atomic_load(p, __ATOMIC_RELAXED, __HIP_MEMORY_SCOPE_AGENT); }
__device__ __forceinline__ unsigned xb_add(unsigned* p, unsigned v) { return __hip_atomic_fetch_add(p, v, __ATOMIC_RELAXED, __HIP_MEMORY_SCOPE_AGENT); }
__device__ __forceinline__ unsigned xb_xcc_id() { return (unsigned)__builtin_amdgcn_s_getreg((3 << 11) | 20) & 0xFu; }
#define XB_SPIN(cond, bar) do { unsigned _sp = 0; while (cond) { __builtin_amdgcn_s_sleep(1); \
    if ((++_sp & 255u) == 0u) { if (xb_ld(&(bar)[XB_TMO])) break; if (_sp > XB_SPIN_CAP) { atomicAdd(&(bar)[XB_TMO], 1u); break; } } } } while (0)

struct XcdBarrier {
    unsigned* bar; unsigned x;
    volatile LAS unsigned* st;
};

__device__ __forceinline__ XcdBarrier xcd_barrier_post(unsigned* bar, volatile LAS unsigned* st) {
    XcdBarrier b; b.bar = bar; b.x = xb_xcc_id(); b.st = st;
    if (threadIdx.x == 0) (void)xb_add(&bar[XB_XCNT(b.x)], 1u);
    return b;
}
__device__ __forceinline__ void xcd_barrier_complete(unsigned* bar, unsigned x, unsigned& nloc, unsigned& nx) {
    const unsigned G = gridDim.x * gridDim.y * gridDim.z;
    unsigned sum, cnt, mine, sp = 0u;
    for (;;) {
        sum = 0u; cnt = 0u; mine = 0u;
#pragma unroll
        for (unsigned j = 0; j < 16; ++j) { const unsigned c = xb_ld(&bar[XB_XCNT(j)]); sum += c; cnt += (c > 0u) ? 1u : 0u; mine = (j == x) ? c : mine; }
        if (sum == G) break;
        __builtin_amdgcn_s_sleep(1);
        if ((++sp & 255u) == 0u) { if (xb_ld(&bar[XB_TMO])) break; if (sp > XB_SPIN_CAP) { atomicAdd(&bar[XB_TMO], 1u); break; } }
    }
    nloc = mine > 0u ? mine : 1u; nx = cnt > 0u ? cnt : 1u;
}

__device__ __forceinline__ void xcd_barrier(const XcdBarrier& b) {
    asm volatile("s_waitcnt vmcnt(0)" ::: "memory");
    __syncthreads();
    if (threadIdx.x == 0) {
        unsigned* bar = b.bar;
        __builtin_amdgcn_s_waitcnt(0);
        unsigned nloc = b.st[0], nx = b.st[1];
        if (nloc == 0u) { xcd_barrier_complete(bar, b.x, nloc, nx); b.st[0] = nloc; b.st[1] = nx; }
        const unsigned old = xb_add(&bar[XB_XSUB(b.x)], 1u);
        const unsigned gen = old / nloc;
        if (old + 1u == (gen + 1u) * nloc) {
            __builtin_amdgcn_fence(__ATOMIC_RELEASE, "agent");
            asm volatile("s_waitcnt vmcnt(0)" ::: "memory");
            const unsigned og = xb_add(&bar[XB_TOP], 1u);
            const unsigned tg = og / nx;
            if (og + 1u == (tg + 1u) * nx) xb_add(&bar[XB_TOPGEN], 1u);
            else XB_SPIN(xb_ld(&bar[XB_TOPGEN]) == tg, bar);
            __builtin_amdgcn_fence(__ATOMIC_ACQUIRE, "agent");
            xb_add(&bar[XB_XGEN(b.x)], 1u);
            asm volatile("s_waitcnt vmcnt(0)" ::: "memory");
        } else {
            XB_SPIN(xb_ld(&bar[XB_XGEN(b.x)]) == gen, bar);
            __builtin_amdgcn_fence(__ATOMIC_ACQUIRE, "agent");
            asm volatile("s_waitcnt vmcnt(0)" ::: "memory");
        }
    }
    __syncthreads();
}

__global__ void __launch_bounds__(512, 2) hymba_fwd(Params p) {
    extern __shared__ __attribute__((aligned(16))) unsigned char shm[];
    LAS unsigned char* lds = (LAS unsigned char*)shm;
    cg::grid_group grid = cg::this_grid();
    volatile LAS unsigned* xbst = (volatile LAS unsigned*)(lds + 131072);
    if (threadIdx.x < 4) xbst[threadIdx.x] = 0u;
    __syncthreads();
    XcdBarrier xb = xcd_barrier_post(p.bar, xbst);
    for (int ph = p.ph_lo; ph < p.ph_hi; ++ph) {
        if (ph > p.ph_lo) { if (ph > 1000) grid.sync(); else xcd_barrier(xb); }
#ifndef NO_P0
        if (ph == 0) { phase_prologue(p, lds); continue; }
#endif
        const int l = (ph - 1) / 5, sub = (ph - 1) % 5;
#ifdef REP_SUB
      for (int rep_i = 0; rep_i < ((sub == REP_SUB) ? 2 : 1); ++rep_i) {
        if (rep_i) xcd_barrier(xb);
#endif
        if (sub == 0) {
            pg8::Gemm g; g.A = (const bf16_t*)(p.ws + WS_XB); g.Bt = (const bf16_t*)(p.ws + ((l & 1) ? WS_WIN1 : WS_WIN)); g.M = T_TOK; g.N = 4096; g.K = 1024;
            pg8::StaticOrder S; S.init(g.M, g.N, (int)gridDim.x, (int)blockIdx.x);
            LAS float* rsl = (LAS float*)(lds + 131072 + 16);
            {
                pg8::Unit u0; S.next(0, u0);
                const int tid = tidx(), r = tid >> 1, hf = tid & 1;
                const float* q = (const float*)(p.ws + WS_SSQ) + (size_t)(u0.pm * 256 + r) * 16 + hf * 8;
                const f32x4 a = *(const f32x4*)q, bq4 = *(const f32x4*)(q + 4);
                float sm = ((a[0] + a[1]) + (a[2] + a[3])) + ((bq4[0] + bq4[1]) + (bq4[2] + bq4[3]));
                sm += __shfl_xor(sm, 1);
                if (hf == 0) rsl[r] = rsqrtf(sm * (1.0f / 1024.0f) + 1e-6f);
                __syncthreads();
            }
            EpiIn E; E.pa = (bf16_t*)(p.ws + WS_PA); E.pbc = (bf16_t*)(p.ws + WS_PBC); E.gate = (bf16_t*)(p.ws + WS_GATE); E.rsl = rsl;
            pg8::gemm_phase<EpiIn, pg8::StaticOrder, false>(lds, g, S, E, nullptr);
        } else if (sub == 1) {
            const int nconv = 64 + (l < 3 ? 4 * 68 : 0);
            const int ntask = 1536 + 1536 + 256 + 256 + nconv + 256;
            {
                ChunkPre cpre;
                if ((int)blockIdx.x < 1536) rwkv_chunk_load(p, blockIdx.x, cpre);
                for (int t = blockIdx.x; t < 1536; t += gridDim.x) rwkv_chunk_task(p, l, t, (t + (int)gridDim.x < 1536) ? t + (int)gridDim.x : -1, cpre, lds);
            }
            for (int t = 1536 + blockIdx.x; t < ntask; t += gridDim.x) {
                if (t < 2304) dil_run(p, l, (t - 1536) / 384, (t - 1536) % 384, lds);
                else if (t < 3072) {}
                else if (t < 3328) kmean_task(p, l, t - 3072, lds);
                else if (t < 3584) gate_tail_task(p, l, t - 3328, lds);
                else if (t >= 3584 + nconv) moba_route_task(p, l, t - 3584 - nconv, lds);
                else { const int c = t - 3584;
                    if (c < 64) convert_strip4(p.in[I_WOUT] + (size_t)l * 1024 * 1024, 1024, 1024, nullptr, (bf16_t*)(p.ws + WS_WOUT), (c & 3) * 4, c >> 2, lds);
                    else { const int u = c - 64; convert_strip4(p.in[I_WIN] + (size_t)(l + 1) * 1024 * 4224, 4224, 4224, p.in[I_NORMG] + (l + 1) * 1024, (bf16_t*)(p.ws + (((l + 1) & 1) ? WS_WIN1 : WS_WIN)), (u & 3) * 4, u >> 2, lds); }
                }
            }
        } else if (sub == 2) {
            if (blockIdx.x < 24) recur_task(p, l, blockIdx.x, lds);
            {
                LAS int* tnum = (LAS int*)(lds + 98304); LAS int* tstart = tnum + 256;
                const unsigned* cnt = (const unsigned*)(p.ws + WS_CNT) + l * 256;
                __syncthreads();
                if (threadIdx.x < 256) tnum[threadIdx.x] = (int)((cnt[threadIdx.x] + 127u) >> 7);
                __syncthreads();
                if (threadIdx.x < 64) {
                    const int a0 = tnum[4 * threadIdx.x], a1 = tnum[4 * threadIdx.x + 1], a2 = tnum[4 * threadIdx.x + 2], a3 = tnum[4 * threadIdx.x + 3];
                    const int sl = a0 + a1 + a2 + a3; int inc = sl;
#pragma unroll
                    for (int d = 1; d < 64; d <<= 1) { const int o = __shfl_up(inc, d); if ((int)threadIdx.x >= d) inc += o; }
                    const int ex = inc - sl;
                    tstart[4 * threadIdx.x] = ex; tstart[4 * threadIdx.x + 1] = ex + a0; tstart[4 * threadIdx.x + 2] = ex + a0 + a1; tstart[4 * threadIdx.x + 3] = ex + a0 + a1 + a2;
                    if (threadIdx.x == 63) tstart[256] = inc;
                }
                __syncthreads();
                const int total = tstart[256];
                auto lookup = [&](int t, int& e, int& i) { int lo = 0, hi = 256;
                    while (hi - lo > 1) { const int mid = (lo + hi) >> 1; if (tstart[mid] <= t) lo = mid; else hi = mid; }
                    e = lo; i = t - tstart[lo]; };
                auto cumw = [&](int w) -> long long { if (gridDim.x != 256u) return (long long)w * 28808ll / (long long)gridDim.x;
                    return w < 24 ? 82ll * w : (w < 176 ? 1968ll + 95ll * (w - 24) : 16408ll + 155ll * (w - 176)); };
                int t = (int)(((long long)total * cumw((int)blockIdx.x)) / 28808ll);
                const int t1 = (int)(((long long)total * cumw((int)blockIdx.x + 1)) / 28808ll);
                while (t < t1) {
                    int e, i; lookup(t, e, i);
                    const int iend = (tnum[e] - i < t1 - t) ? tnum[e] : i + (t1 - t);
                    moba_gather_run(p, l, e, i, iend, (int)cnt[e], lds);
                    t += iend - i;
                }
            }
            if (blockIdx.x >= 24) for (int t = blockIdx.x - 24; t < 384; t += gridDim.x - 24) dil_run(p, l, 2, t, lds);
        } else if (sub == 3) {
            for (int t = blockIdx.x; t < 256; t += gridDim.x) moba_own_run(p, l, t, lds);
            for (int t = blockIdx.x; t < 768; t += gridDim.x) rwkv_out_task(p, l, t);
        } else {
            pg8::Gemm g; g.A = (const bf16_t*)(p.ws + WS_YG); g.Bt = (const bf16_t*)(p.ws + WS_WOUT); g.M = T_TOK; g.N = 1024; g.K = 1024;
            pg8::StaticOrder S; S.init(g.M, g.N, (int)gridDim.x, (int)blockIdx.x);
            EpiOut E; E.out = p.out; E.xb = (bf16_t*)(p.ws + WS_XB); E.ssq = (float*)(p.ws + WS_SSQ); E.last = (l == 3) ? 1 : 0;
#ifndef NO_G2
            pg8::gemm_phase<EpiOut, pg8::StaticOrder, false>(lds, g, S, E, nullptr);
#endif
        }
#ifdef REP_SUB
      }
#endif
    }
}

#ifndef MK_MULTI
#define MK_MULTI 0
#endif
extern "C" void kernel_launch(void* const* d_in, const int* in_sizes, int n_in, void* d_out, int out_size, void* d_ws, size_t ws_size, hipStream_t stream) {
    static int grid = 0;
    if (grid == 0) {
        int dev = 0, cus = 0, per_cu = 0;
        hipGetDevice(&dev);
        hipDeviceGetAttribute(&cus, hipDeviceAttributeMultiprocessorCount, dev);
        if (hipFuncSetAttribute((const void*)hymba_fwd, hipFuncAttributeMaxDynamicSharedMemorySize, LDS_BYTES) != hipSuccess) fprintf(stderr, "kernel_launch: hipFuncSetAttribute failed\n");
        if (hipOccupancyMaxActiveBlocksPerMultiprocessor(&per_cu, (const void*)hymba_fwd, NTHR, LDS_BYTES) != hipSuccess || per_cu < 1) { fprintf(stderr, "kernel_launch: occupancy query gave %d\n", per_cu); per_cu = 1; }
        (void)hipGetLastError();
        if (cus <= 0) cus = 256;
        grid = cus;
        if (ws_size < WS_END) fprintf(stderr, "kernel_launch: workspace too small: %zu < %zu\n", ws_size, (size_t)WS_END);
    }
    Params p{};
    for (int i = 0; i < 18; ++i) p.in[i] = (const float*)d_in[i];
    p.out = (float*)d_out; p.ws = (unsigned char*)d_ws; p.bar = (unsigned*)((unsigned char*)d_ws + WS_BAR);
    (void)hipMemsetAsync((unsigned char*)d_ws + WS_BAR, 0, (size_t)XCD_BAR_WORDS_C * 4 + 256 + 4096 + 256, stream);
#if MK_MULTI
    for (int ph = 0; ph < 21; ++ph) {
        p.ph_lo = ph; p.ph_hi = ph + 1;
        hipLaunchKernelGGL(hymba_fwd, dim3(grid), dim3(NTHR), LDS_BYTES, stream, p);
    }
#else
    p.ph_lo = 0; p.ph_hi = 21;
    void* args[] = {&p};
    hipError_t e = hipLaunchCooperativeKernel((const void*)hymba_fwd, dim3(grid), dim3(NTHR), args, LDS_BYTES, stream);
    if (e != hipSuccess) fprintf(stderr, "cooperative launch failed: %s (grid %d)\n", hipGetErrorString(e), grid);
#endif
}
```
